# Optimizing an MI355X kernel written in HIP

```python
import numpy as np
import jax
import jax.numpy as jnp
from jax import lax

D_MODEL = 1024
BATCH = 8
SEQ = 2048
DEPTH = 4

HEAD_DIM = 64
ROT_DIM = HEAD_DIM // 4
ROPE_THETA = 500000.0
NORM_EPS = 1e-6
NEG_INF = -1e30
Q_BLOCK = 128

NSA_HEADS = 8
NSA_GROUPS = 2
NSA_HPG = NSA_HEADS // NSA_GROUPS
CMP_LEN = 32
CMP_STRIDE = 16
CMP_HIDDEN = 256
SLC_LEN = 64
SLC_TOPN = 8
WINDOW = 256
SB_HEADS = 8
GLA_HEADS = 4
GLA_DK = 64
GLA_DV = 128
GLA_RANK = 16
GLA_TAU = 16.0
GLA_CHUNK = 64
FOX_HEADS = 8

BRANCH_WIDTH = 512
N_BRANCH = 4
D_FF = 4 * D_MODEL

NSA_QW = NSA_HEADS * HEAD_DIM
NSA_KVW = NSA_GROUPS * HEAD_DIM
SB_W = SB_HEADS * HEAD_DIM
FOX_W = FOX_HEADS * HEAD_DIM
SPLITS = (NSA_QW, NSA_KVW, NSA_KVW, NSA_KVW, NSA_KVW, NSA_KVW, NSA_KVW, NSA_HEADS * 3,
          SB_W, SB_W, SB_W,
          GLA_HEADS * GLA_DK, GLA_HEADS * GLA_DK, GLA_HEADS * GLA_DV, GLA_RANK, GLA_HEADS * GLA_DV,
          FOX_W, FOX_W, FOX_W, FOX_HEADS,
          N_BRANCH * D_MODEL)
D_IN = sum(SPLITS)

kernel_name = 'hybrid_nsa_sb_gla_fox_block'


def rms_norm(x, g):
    xf = x.astype(jnp.float32)
    xf = xf * lax.rsqrt(jnp.mean(xf * xf, axis=-1, keepdims=True) + NORM_EPS)
    return (xf * g.astype(jnp.float32)).astype(x.dtype)


def masked_softmax(logits, mask):
    logits = jnp.where(mask, logits.astype(jnp.float32), NEG_INF)
    return jax.nn.softmax(logits, axis=-1) * mask


def rope_partial(x, pos):
    half = ROT_DIM // 2
    inv = ROPE_THETA ** (-jnp.arange(0, ROT_DIM, 2, dtype=jnp.float32) / ROT_DIM)
    ang = pos.astype(jnp.float32)[..., None] * inv
    ang = ang.reshape(ang.shape[:2] + (1,) * (x.ndim - 3) + (half,))
    cos = jnp.cos(ang).astype(x.dtype)
    sin = jnp.sin(ang).astype(x.dtype)
    x1, x2, xp = x[..., :half], x[..., half:ROT_DIM], x[..., ROT_DIM:]
    return jnp.concatenate([x1 * cos - x2 * sin, x2 * cos + x1 * sin, xp], axis=-1)


def nsa_mixer(q, k_cmp, v_cmp, k_slc, v_slc, k_win, v_win, gate_logits, pos,
              cmp_pos_k, cmp_pos_v, cmp_wk1, cmp_wk2, cmp_wv1, cmp_wv2):
    B, S = q.shape[:2]
    G, HPG, D = NSA_GROUPS, NSA_HPG, HEAD_DIM
    scale = D ** -0.5
    q = rope_partial(q.reshape(B, S, G, HPG, D), pos)
    k_cmp, v_cmp, k_slc, v_slc, k_win, v_win = [t.reshape(B, S, G, D) for t in (k_cmp, v_cmp, k_slc, v_slc, k_win, v_win)]
    k_slc = rope_partial(k_slc, pos)
    k_win = rope_partial(k_win, pos)
    tok = np.arange(S)

    n_cmp = (S - CMP_LEN) // CMP_STRIDE + 1
    cmp_start = np.arange(n_cmp) * CMP_STRIDE
    cmp_end = cmp_start + CMP_LEN - 1
    cmp_idx = cmp_start[:, None] + np.arange(CMP_LEN)[None, :]

    def compress(t, pe, w1, w2):
        blk = t[:, cmp_idx] + pe[:, None, :]
        blk = jnp.moveaxis(blk, 3, 2).reshape(B, n_cmp, G, CMP_LEN * D)
        return jax.nn.gelu(blk @ w1) @ w2

    kc = rope_partial(compress(k_cmp, cmp_pos_k, cmp_wk1, cmp_wk2), pos[:, cmp_end])
    vc = compress(v_cmp, cmp_pos_v, cmp_wv1, cmp_wv2)
    s_cmp = jnp.einsum('bsghd,bcgd->bghsc', q, kc) * scale
    p_cmp = masked_softmax(s_cmp, cmp_end[None, :] <= tok[:, None])
    o_cmp = jnp.einsum('bghsc,bcgd->bsghd', p_cmp.astype(vc.dtype), vc)

    n_sel = S // SLC_LEN
    top_n = min(SLC_TOPN, n_sel)
    sel_start = np.arange(n_sel) * SLC_LEN
    overlap = np.clip(np.minimum(cmp_start[:, None] + CMP_LEN, sel_start[None, :] + SLC_LEN)
                      - np.maximum(cmp_start[:, None], sel_start[None, :]), 0, None) / CMP_LEN
    imp = jnp.einsum('bghsc,cj->bgsj', p_cmp, jnp.asarray(overlap, jnp.float32))
    forced = (sel_start[None, :] == 0) | (np.arange(n_sel)[None, :] == (tok // SLC_LEN)[:, None])
    imp = jnp.where(forced, jnp.inf, jnp.where(sel_start[None, :] <= tok[:, None], imp, -jnp.inf))
    _, sel = lax.top_k(imp, top_n)
    n_qb = S // Q_BLOCK

    def to_blocks(t):
        return jnp.moveaxis(t.reshape(B, n_sel, SLC_LEN, G, D), 3, 1).reshape(B, G, n_sel, SLC_LEN * D)

    ks_blk = to_blocks(k_slc)
    vs_blk = to_blocks(v_slc)
    q_blk = jnp.moveaxis(q.reshape(B, n_qb, Q_BLOCK, G, HPG, D), 1, 0)
    sel_blk = jnp.moveaxis(sel.reshape(B, G, n_qb, Q_BLOCK, top_n), 2, 0)

    def select_block(args):
        qc, ic, t_start = args
        flat = ic.reshape(B, G, Q_BLOCK * top_n, 1)
        kg = jnp.take_along_axis(ks_blk, flat, axis=2).reshape(B, G, Q_BLOCK, top_n * SLC_LEN, D)
        vg = jnp.take_along_axis(vs_blk, flat, axis=2).reshape(B, G, Q_BLOCK, top_n * SLC_LEN, D)
        key_tok = (ic[..., None] * SLC_LEN + jnp.arange(SLC_LEN)).reshape(B, G, Q_BLOCK, top_n * SLC_LEN)
        t = t_start + jnp.arange(Q_BLOCK)
        s = jnp.einsum('bqghd,bgqkd->bghqk', qc, kg) * scale
        p = masked_softmax(s, (key_tok <= t[:, None])[:, :, None])
        return jnp.einsum('bghqk,bgqkd->bqghd', p.astype(vg.dtype), vg)

    o_slc = lax.map(select_block, (q_blk, sel_blk, jnp.arange(n_qb) * Q_BLOCK))
    o_slc = jnp.moveaxis(o_slc, 0, 1).reshape(B, S, G, HPG, D)

    n_band = Q_BLOCK + WINDOW
    band_idx = np.arange(n_qb)[:, None] * Q_BLOCK + np.arange(n_band)[None, :]
    band_tok = band_idx - WINDOW
    pad = ((0, 0), (WINDOW, 0), (0, 0), (0, 0))
    kb = jnp.pad(k_win, pad)[:, band_idx]
    vb = jnp.pad(v_win, pad)[:, band_idx]
    tq = tok.reshape(n_qb, Q_BLOCK)
    win_mask = ((band_tok[:, None, :] <= tq[:, :, None]) & (band_tok[:, None, :] > tq[:, :, None] - WINDOW)
                & (band_tok[:, None, :] >= 0))
    s_win = jnp.einsum('bnqghd,bnkgd->bnghqk', q.reshape(B, n_qb, Q_BLOCK, G, HPG, D), kb) * scale
    p_win = masked_softmax(s_win, win_mask[None, :, None, None])
    o_win = jnp.einsum('bnghqk,bnkgd->bnqghd', p_win.astype(vb.dtype), vb).reshape(B, S, G, HPG, D)

    g = jax.nn.sigmoid(gate_logits.astype(jnp.float32)).reshape(B, S, G, HPG, 3).astype(q.dtype)
    o = g[..., 0:1] * o_cmp + g[..., 1:2] * o_slc + g[..., 2:3] * o_win
    return o.reshape(B, S, NSA_HEADS * D)


def stick_breaking_mixer(q, k, v):
    B, S = q.shape[:2]
    H, D = SB_HEADS, HEAD_DIM
    scale = D ** -0.5
    n_qb = S // Q_BLOCK
    kT = jnp.moveaxis(k.reshape(B, S, H, D), 1, 2)
    vT = jnp.moveaxis(v.reshape(B, S, H, D), 1, 2)
    qb = q.reshape(B, n_qb, Q_BLOCK, H, D).transpose(1, 0, 3, 2, 4)
    key_pos = jnp.arange(S)

    def block(args):
        qc, t_start = args
        z = jnp.einsum('bhqd,bhkd->bhqk', qc, kT).astype(jnp.float32) * scale
        t = t_start + jnp.arange(Q_BLOCK)
        valid = key_pos[None, :] < t[:, None]
        sp = jnp.where(valid, jax.nn.softplus(z), 0.0)
        later = lax.cumsum(sp, axis=3, reverse=True) - sp
        a = jnp.where(valid, jnp.exp(jax.nn.log_sigmoid(z) - later), 0.0)
        return jnp.einsum('bhqk,bhkd->bhqd', a.astype(vT.dtype), vT)

    o = lax.map(block, (qb, jnp.arange(n_qb) * Q_BLOCK))
    return o.transpose(1, 0, 3, 2, 4).reshape(B, S, H * D)


def gla_mixer(q, k, v, a_lr, gate, w_alpha, b_alpha, norm_g):
    B, S = q.shape[:2]
    H, DK, DV, C = GLA_HEADS, GLA_DK, GLA_DV, GLA_CHUNK
    n_ch = S // C
    log_a = jax.nn.log_sigmoid((a_lr @ w_alpha + b_alpha).astype(jnp.float32)) / GLA_TAU

    def chunks(t, f):
        return t.reshape(B, n_ch, C, H, f).transpose(1, 0, 3, 2, 4)

    qc_all = chunks(q * DK ** -0.5, DK)
    kc_all = chunks(k, DK)
    vc_all = chunks(v, DV)
    la_all = chunks(log_a, DK)
    causal = np.tril(np.ones((C, C), dtype=bool))

    def step(state, inp):
        qc, kc, vc, lac = inp
        b = jnp.cumsum(lac, axis=2)
        o_inter = jnp.einsum('bhtk,bhkv->bhtv', qc * jnp.exp(b), state)
        diff = jnp.where(causal[:, :, None], b[:, :, :, None, :] - b[:, :, None, :, :], -jnp.inf)
        att = jnp.einsum('bhtk,bhsk,bhtsk->bhts', qc, kc, jnp.exp(diff))
        o_intra = jnp.einsum('bhts,bhsv->bhtv', att, vc)
        b_last = b[:, :, -1:, :]
        state = (jnp.exp(b_last[:, :, 0])[..., None] * state
                 + jnp.einsum('bhsk,bhsv->bhkv', kc * jnp.exp(b_last - b), vc))
        return state, o_inter + o_intra

    state0 = jnp.zeros((B, H, DK, DV), jnp.float32)
    _, o = lax.scan(step, state0, (qc_all, kc_all, vc_all, la_all))
    o = o.transpose(1, 0, 3, 2, 4).reshape(B, S, H, DV)
    o = o * lax.rsqrt(jnp.mean(o * o, axis=-1, keepdims=True) + NORM_EPS) * norm_g.astype(jnp.float32)
    y = o.astype(v.dtype) * jax.nn.silu(gate).reshape(B, S, H, DV)
    return y.reshape(B, S, H * DV)


def forgetting_mixer(q, k, v, f_logit, b_f):
    B, S = q.shape[:2]
    H, D = FOX_HEADS, HEAD_DIM
    scale = D ** -0.5
    n_qb = S // Q_BLOCK
    log_f = jax.nn.log_sigmoid(f_logit.astype(jnp.float32) + b_f.astype(jnp.float32))
    cumT = jnp.moveaxis(jnp.cumsum(log_f, axis=1), 1, 2)
    kT = jnp.moveaxis(k.reshape(B, S, H, D), 1, 2)
    vT = jnp.moveaxis(v.reshape(B, S, H, D), 1, 2)
    qb = q.reshape(B, n_qb, Q_BLOCK, H, D).transpose(1, 0, 3, 2, 4)
    cb = cumT.reshape(B, H, n_qb, Q_BLOCK).transpose(2, 0, 1, 3)
    key_pos = jnp.arange(S)

    def block(args):
        qc, ct, t_start = args
        s = jnp.einsum('bhqd,bhkd->bhqk', qc, kT).astype(jnp.float32) * scale
        s = s + ct[..., None] - cumT[:, :, None, :]
        t = t_start + jnp.arange(Q_BLOCK)
        p = masked_softmax(s, key_pos[None, :] <= t[:, None])
        return jnp.einsum('bhqk,bhkd->bhqd', p.astype(vT.dtype), vT)

    o = lax.map(block, (qb, cb, jnp.arange(n_qb) * Q_BLOCK))
    return o.transpose(1, 0, 3, 2, 4).reshape(B, S, H * D)


def hybrid_layer(x, positions, norm_mix, w_in, b_gate, cmp_pos_k, cmp_pos_v, cmp_wk1, cmp_wk2,
                 cmp_wv1, cmp_wv2, gla_w_alpha, gla_b_alpha, gla_norm, fox_b_f, w_branch, w_out,
                 norm_ff, w_ff1, w_ff2):
    B, S, _ = x.shape
    h = rms_norm(x, norm_mix)
    proj = h @ w_in
    offsets = np.cumsum(SPLITS)[:-1].tolist()
    (nsa_q, nsa_kc, nsa_vc, nsa_ks, nsa_vs, nsa_kw, nsa_vw, nsa_g,
     sb_q, sb_k, sb_v,
     gla_q, gla_k, gla_v, gla_a, gla_g,
     fox_q, fox_k, fox_v, fox_f,
     gate_logits) = jnp.split(proj, offsets, axis=-1)

    y_nsa = nsa_mixer(nsa_q, nsa_kc, nsa_vc, nsa_ks, nsa_vs, nsa_kw, nsa_vw, nsa_g, positions,
                      cmp_pos_k, cmp_pos_v, cmp_wk1, cmp_wk2, cmp_wv1, cmp_wv2)
    y_sb = stick_breaking_mixer(sb_q, sb_k, sb_v)
    y_gla = gla_mixer(gla_q.reshape(B, S, GLA_HEADS, GLA_DK), gla_k.reshape(B, S, GLA_HEADS, GLA_DK),
                      gla_v.reshape(B, S, GLA_HEADS, GLA_DV), gla_a, gla_g, gla_w_alpha, gla_b_alpha, gla_norm)
    y_fox = forgetting_mixer(fox_q, fox_k, fox_v, fox_f, fox_b_f)

    ys = jnp.stack([y_nsa, y_sb, y_gla, y_fox], axis=2)
    branch = jnp.einsum('bsnc,ncd->bsnd', ys, w_branch)
    gates = jax.nn.sigmoid((gate_logits + b_gate).astype(jnp.float32)).astype(x.dtype)
    mixed = jnp.sum(gates.reshape(B, S, N_BRANCH, D_MODEL) * branch, axis=2)
    x = x + mixed @ w_out
    h2 = rms_norm(x, norm_ff)
    return x + jnp.square(jax.nn.relu(h2 @ w_ff1)) @ w_ff2


def setup_inputs(seed: int = 0) -> dict:
    key = jax.random.key(seed)
    ks = jax.random.split(key, 21)
    L = DEPTH

    def nrm(k, shape, scale):
        return jax.random.normal(k, shape, jnp.float32) * scale

    x = nrm(ks[0], (BATCH, SEQ, D_MODEL), 1.0)
    offset = jax.random.randint(ks[1], (BATCH, 1), 0, 4096, dtype=jnp.int32)
    positions = jnp.arange(SEQ, dtype=jnp.int32)[None, :] + offset
    return {
        'x': x,
        'positions': positions,
        'norm_mix': 1.0 + nrm(ks[2], (L, D_MODEL), 0.02),
        'w_in': nrm(ks[3], (L, D_MODEL, D_IN), D_MODEL ** -0.5),
        'b_gate': nrm(ks[4], (L, N_BRANCH * D_MODEL), 0.02),
        'nsa_cmp_pos_k': nrm(ks[5], (L, CMP_LEN, HEAD_DIM), 0.1),
        'nsa_cmp_pos_v': nrm(ks[6], (L, CMP_LEN, HEAD_DIM), 0.1),
        'nsa_cmp_wk1': nrm(ks[7], (L, CMP_LEN * HEAD_DIM, CMP_HIDDEN), (CMP_LEN * HEAD_DIM) ** -0.5),
        'nsa_cmp_wk2': nrm(ks[8], (L, CMP_HIDDEN, HEAD_DIM), CMP_HIDDEN ** -0.5),
        'nsa_cmp_wv1': nrm(ks[9], (L, CMP_LEN * HEAD_DIM, CMP_HIDDEN), (CMP_LEN * HEAD_DIM) ** -0.5),
        'nsa_cmp_wv2': nrm(ks[10], (L, CMP_HIDDEN, HEAD_DIM), CMP_HIDDEN ** -0.5),
        'gla_w_alpha': nrm(ks[11], (L, GLA_RANK, GLA_HEADS * GLA_DK), GLA_RANK ** -0.5),
        'gla_b_alpha': nrm(ks[12], (L, GLA_HEADS * GLA_DK), 0.1),
        'gla_norm': 1.0 + nrm(ks[13], (L, GLA_DV), 0.02),
        'fox_b_f': 2.0 + nrm(ks[14], (L, FOX_HEADS), 0.1),
        'w_branch': nrm(ks[15], (L, N_BRANCH, BRANCH_WIDTH, D_MODEL), BRANCH_WIDTH ** -0.5),
        'w_out': nrm(ks[16], (L, D_MODEL, D_MODEL), D_MODEL ** -0.5),
        'norm_ff': 1.0 + nrm(ks[17], (L, D_MODEL), 0.02),
        'w_ff1': nrm(ks[18], (L, D_MODEL, D_FF), D_MODEL ** -0.5),
        'w_ff2': nrm(ks[19], (L, D_FF, D_MODEL), D_FF ** -0.5),
        'norm_final': 1.0 + nrm(ks[20], (D_MODEL,), 0.02),
    }


def reference(x, positions, norm_mix, w_in, b_gate, nsa_cmp_pos_k, nsa_cmp_pos_v, nsa_cmp_wk1,
              nsa_cmp_wk2, nsa_cmp_wv1, nsa_cmp_wv2, gla_w_alpha, gla_b_alpha, gla_norm, fox_b_f,
              w_branch, w_out, norm_ff, w_ff1, w_ff2, norm_final):
    for l in range(DEPTH):
        x = hybrid_layer(x, positions, norm_mix[l], w_in[l], b_gate[l], nsa_cmp_pos_k[l], nsa_cmp_pos_v[l],
                         nsa_cmp_wk1[l], nsa_cmp_wk2[l], nsa_cmp_wv1[l], nsa_cmp_wv2[l], gla_w_alpha[l],
                         gla_b_alpha[l], gla_norm[l], fox_b_f[l], w_branch[l], w_out[l], norm_ff[l],
                         w_ff1[l], w_ff2[l])
    return rms_norm(x, norm_final)
```

```cpp
#include <hip/hip_runtime.h>
#include <cstdio>
#include <cstdint>

#ifndef MK_ONE_LAUNCH
#define MK_ONE_LAUNCH 0
#endif

#define GAS __attribute__((address_space(1)))
#define LAS __attribute__((address_space(3)))
typedef unsigned short bf16_t;
typedef short bf16x8 __attribute__((ext_vector_type(8)));
typedef float f32x4 __attribute__((ext_vector_type(4)));
typedef float f32x2 __attribute__((ext_vector_type(2)));
typedef unsigned u32x4 __attribute__((ext_vector_type(4)));
typedef unsigned u32x2 __attribute__((ext_vector_type(2)));

constexpr int NB = 8, SEQ = 2048, M = NB * SEQ, DM = 1024, NL = 4, DIN = 10032, LDP = 10240, DFF = 4096;
constexpr float EPS = 1e-6f;
constexpr int P_NQ = 0, P_KC = 512, P_VC = 640, P_KS = 768, P_VS = 896, P_KW = 1024, P_VW = 1152;
constexpr int P_SQ = 1280, P_SK = 1792, P_SV = 2304;
constexpr int P_GQ = 2816, P_GK = 3072, P_GV = 3328, P_GG = 3840;
constexpr int P_FQ = 4352, P_FK = 4864, P_FV = 5376;
constexpr int P_GATE = 5888, P_NG = 9984, P_GA = 10008, P_FF = 10024;
__host__ __device__ __forceinline__ int win_src_col(int n) {
    if (n < 1280) return n;
    if (n < 3840) return n + 24;
    if (n < 5888) return n + 40;
    if (n < 9984) return n + 48;
    if (n < 10008) return n - 9984 + 1280;
    if (n < 10024) return n - 10008 + 3864;
    if (n < 10032) return n - 10024 + 5928;
    return -1;
}

constexpr size_t MiB = 1u << 20;
constexpr size_t WS_CTL = 0, CTL_BYTES = 1 * MiB;
constexpr size_t WS_WIN = 1 * MiB;
constexpr size_t WS_WB = 21 * MiB;
constexpr size_t WS_WO = 25 * MiB;
constexpr size_t WS_WF1 = 27 * MiB;
constexpr size_t WS_WF2 = 35 * MiB;
constexpr size_t WS_CW1 = 43 * MiB;
constexpr size_t WS_KC = 45 * MiB;
constexpr size_t WS_CUM = 46 * MiB;
constexpr size_t WS_CH = 47 * MiB;
constexpr size_t WS_HB = 52 * MiB;
constexpr size_t WS_MIX = 84 * MiB;
constexpr size_t WS_YS = 116 * MiB;
constexpr size_t WS_GQP = 180 * MiB;
constexpr size_t WS_GKP = 188 * MiB;
constexpr size_t WS_GKPP = 196 * MiB;
constexpr size_t WS_GDS = 204 * MiB;
constexpr size_t WS_GOI = 236 * MiB;
constexpr size_t WS_MIXF = WS_GDS;
constexpr size_t WS_PROJ = 268 * MiB;
constexpr size_t WS_HID = WS_PROJ;
constexpr size_t WS_END = 588 * MiB;

constexpr int CW_BAR = 4096;

constexpr int RING_BYTES = 131072;
constexpr int MISC_OFF = RING_BYTES;
constexpr int LDS_BYTES = 147456;
constexpr int NWAVES = 8, NTHR = 512;

__device__ __forceinline__ unsigned f2bf(float f) { unsigned u = __builtin_bit_cast(unsigned, f); return (u + 0x7fffu + ((u >> 16) & 1u)) >> 16; }
__device__ __forceinline__ unsigned pk2(float lo, float hi) { return f2bf(lo) | (f2bf(hi) << 16); }
__device__ __forceinline__ float bf2f(unsigned short b) { return __builtin_bit_cast(float, ((unsigned)b) << 16); }
__device__ __forceinline__ float bflo(unsigned w) { return __builtin_bit_cast(float, w << 16); }
__device__ __forceinline__ float bfhi(unsigned w) { return __builtin_bit_cast(float, w & 0xffff0000u); }
__device__ __forceinline__ float wave_sum(float v) {
#pragma unroll
    for (int o = 1; o < 64; o <<= 1) v += __shfl_xor(v, o);
    return v;
}
__device__ __forceinline__ float sigmoidf_(float x) { return 1.0f / (1.0f + __expf(-x)); }
__device__ __forceinline__ float softplusf_(float x) { return fmaxf(x, 0.f) + log1pf(__expf(-fabsf(x))); }
__device__ __forceinline__ float logsigmoidf_(float x) { return fminf(x, 0.f) - log1pf(__expf(-fabsf(x))); }

#define XB_TMO      128
#define XB_XCNT(j)  (256  + 64 * (j))
#define XB_XSUB(j)  (1280 + 64 * (j))
#define XB_XGEN(j)  (2304 + 64 * (j))
#define XB_TOP      3328
#define XB_TOPGEN   3392
#define XCD_BAR_WORDS 3456
#define XB_SPIN_CAP (1u << 18)
__device__ __forceinline__ unsigned xb_ld(unsigned* p)              { return __hip_atomic_load(p, __ATOMIC_RELAXED, __HIP_MEMORY_SCOPE_AGENT); }
__device__ __forceinline__ unsigned xb_add(unsigned* p, unsigned v) { return __hip_atomic_fetch_add(p, v, __ATOMIC_RELAXED, __HIP_MEMORY_SCOPE_AGENT); }
__device__ __forceinline__ unsigned xb_xcc_id() { return (unsigned)__builtin_amdgcn_s_getreg((3 << 11) | 20) & 0xFu; }
#define XB_SPIN(cond, bar) do { unsigned _sp = 0; while (cond) { __builtin_amdgcn_s_sleep(1); \
    if ((++_sp & 255u) == 0u) { if (xb_ld(&(bar)[XB_TMO])) break; if (_sp > XB_SPIN_CAP) { atomicAdd(&(bar)[XB_TMO], 1u); break; } } } } while (0)
struct XcdBarrier { unsigned* bar; unsigned x; volatile LAS unsigned* st; };
__device__ __forceinline__ XcdBarrier xcd_barrier_post(unsigned* bar, volatile LAS unsigned* st) {
    XcdBarrier b; b.bar = bar; b.x = xb_xcc_id(); b.st = st;
    if (threadIdx.x == 0) (void)xb_add(&bar[XB_XCNT(b.x)], 1u);
    return b;
}
__device__ __forceinline__ void xcd_barrier_complete(unsigned* bar, unsigned x, unsigned& nloc, unsigned& nx) {
    const unsigned G = gridDim.x * gridDim.y * gridDim.z;
    unsigned sum, cnt, mine, sp = 0u;
    for (;;) {
        sum = 0u; cnt = 0u; mine = 0u;
#pragma unroll
        for (unsigned j = 0; j < 16; ++j) { const unsigned c = xb_ld(&bar[XB_XCNT(j)]); sum += c; cnt += (c > 0u) ? 1u : 0u; mine = (j == x) ? c : mine; }
        if (sum == G) break;
        __builtin_amdgcn_s_sleep(1);
        if ((++sp & 255u) == 0u) { if (xb_ld(&bar[XB_TMO])) break; if (sp > XB_SPIN_CAP) { atomicAdd(&bar[XB_TMO], 1u); break; } }
    }
    nloc = mine > 0u ? mine : 1u; nx = cnt > 0u ? cnt : 1u;
}
__device__ __forceinline__ void xcd_barrier(const XcdBarrier& b) {
    asm volatile("s_waitcnt vmcnt(0)" ::: "memory");
    __syncthreads();
    if (threadIdx.x == 0) {
        unsigned* bar = b.bar;
        __builtin_amdgcn_s_waitcnt(0);
        unsigned nloc = b.st[0], nx = b.st[1];
        if (nloc == 0u) { xcd_barrier_complete(bar, b.x, nloc, nx); b.st[0] = nloc; b.st[1] = nx; }
        const unsigned old = xb_add(&bar[XB_XSUB(b.x)], 1u);
        const unsigned gen = old / nloc;
        if (old + 1u == (gen + 1u) * nloc) {
            __builtin_amdgcn_fence(__ATOMIC_RELEASE, "agent");
            asm volatile("s_waitcnt vmcnt(0)" ::: "memory");
            const unsigned og = xb_add(&bar[XB_TOP], 1u);
            const unsigned tg = og / nx;
            if (og + 1u == (tg + 1u) * nx) xb_add(&bar[XB_TOPGEN], 1u);
            else XB_SPIN(xb_ld(&bar[XB_TOPGEN]) == tg, bar);
            __builtin_amdgcn_fence(__ATOMIC_ACQUIRE, "agent");
            xb_add(&bar[XB_XGEN(b.x)], 1u);
            asm volatile("s_waitcnt vmcnt(0)" ::: "memory");
        } else {
            XB_SPIN(xb_ld(&bar[XB_XGEN(b.x)]) == gen, bar);
            __builtin_amdgcn_fence(__ATOMIC_ACQUIRE, "agent");
            asm volatile("s_waitcnt vmcnt(0)" ::: "memory");
        }
    }
    __syncthreads();
}

namespace pg8 {
constexpr int BM = 256, BK = 64, HALF = 128, HTB = HALF * BK * 2, STAGE_BYTES = 8 * HTB, NXCD = 8, WGM = 8;
__host__ __device__ __forceinline__ int lds_byte(int r, int c) { const int st = (r >> 4) * 2 + (c >> 5), rr = r & 15, cc = c & 31, ob = rr * 64 + cc * 2; return st * 1024 + (ob ^ (((ob >> 9) & 1) << 5)); }
__host__ __device__ __forceinline__ void stage_rc(int b, int& R, int& C) { const int st = b / 1024, sb = b % 1024, swz = sb ^ (((sb >> 9) & 1) << 5); R = (st >> 1) * 16 + swz / 64; C = (st & 1) * 32 + (swz % 64) / 2; }
__host__ __device__ __forceinline__ int perm32(int rho) { const int n = rho >> 4, i = rho & 15; return 8 * (i >> 2) + 4 * n + (i & 3); }

struct Unit { int pm, pn, z; };
struct Gemm { const bf16_t* A; const bf16_t* Bt; int lda, ldb, K; size_t zA, zB; };

struct StaticOrder {
    int nM, nN, nwg, G, c;
    __host__ __device__ void init(int M_, int N_, int G_, int c_) { nM = M_ / BM; nN = N_ / BM; nwg = nM * nN; G = G_; c = c_; }
    __host__ __device__ bool tile(long L, Unit& u) const {
        if (L >= nwg) return false;
        int wgid = (int)L; { const int q = nwg / NXCD, r = nwg % NXCD, xcd = wgid % NXCD, off = wgid / NXCD; wgid = (xcd < r ? xcd * (q + 1) : r * (q + 1) + (xcd - r) * q) + off; }
        const int nig = WGM * nN, gid = wgid / nig, fm = gid * WGM, gsz = (nM - fm) < WGM ? (nM - fm) : WGM;
        u.pm = fm + ((wgid % nig) % gsz); u.pn = (wgid % nig) / gsz; u.z = 0; return true;
    }
    __host__ __device__ bool next(int i, Unit& u) const { return tile((long)i * G + c, u); }
};
struct ZOrder : StaticOrder {
    int NZ;
    __host__ __device__ bool next(int i, Unit& u) const { const int ti = i / NZ; if (!tile((long)ti * G + c, u)) return false; u.z = i - ti * NZ; return true; }
};

__device__ __forceinline__ unsigned cvt_pk_bf16(float lo, float hi) { unsigned r; asm volatile("v_cvt_pk_bf16_f32 %0, %1, %2" : "=v"(r) : "v"(lo), "v"(hi)); return r; }

template <int ACT  > struct EpiBf16 {
    static constexpr bool PERM = true;
    bf16_t* O; int ldc;
    __device__ __forceinline__ void operator()(const f32x4 (&acc)[2][2][4][2], const Unit& u, int wr, int wc, int fr, int fq) const {
        const int row0 = u.pm * BM + wr * 64 + fr; const int col0 = u.pn * BM + wc * 32 + 8 * fq;
#pragma unroll
        for (int ai = 0; ai < 2; ++ai)
#pragma unroll
            for (int m = 0; m < 4; ++m) { bf16_t* rowp = O + (size_t)(row0 + ai * HALF + m * 16) * ldc + col0;
#pragma unroll
                for (int bj = 0; bj < 2; ++bj) { f32x4 v0 = acc[ai][bj][m][0], v1 = acc[ai][bj][m][1];
                    if (ACT == 1) {
#pragma unroll
                        for (int j = 0; j < 4; ++j) { const float a = fmaxf(v0[j], 0.f), b = fmaxf(v1[j], 0.f); v0[j] = a * a; v1[j] = b * b; } }
                    u32x4 w; w.x = cvt_pk_bf16(v0[0], v0[1]); w.y = cvt_pk_bf16(v0[2], v0[3]); w.z = cvt_pk_bf16(v1[0], v1[1]); w.w = cvt_pk_bf16(v1[2], v1[3]);
                    *(u32x4*)(rowp + bj * HALF) = w; } }
    }
};
struct EpiRes {
    static constexpr bool PERM = false;
    const float* base; float* out; int ldc;
    __device__ __forceinline__ void operator()(const f32x4 (&acc)[2][2][4][2], const Unit& u, int wr, int wc, int fr, int fq) const {
        const int row0 = u.pm * BM + wr * 64 + fr, col0 = u.pn * BM + wc * 32 + 4 * fq;
#pragma unroll
        for (int ai = 0; ai < 2; ++ai)
#pragma unroll
            for (int m = 0; m < 4; ++m) { const size_t off = (size_t)(row0 + ai * HALF + m * 16) * ldc + col0;
#pragma unroll
                for (int bj = 0; bj < 2; ++bj)
#pragma unroll
                    for (int n = 0; n < 2; ++n) { const f32x4 bs = *(const f32x4*)(base + off + bj * HALF + n * 16); *(f32x4*)(out + off + bj * HALF + n * 16) = bs + acc[ai][bj][m][n]; } }
    }
};
struct EpiGate {
    static constexpr bool PERM = false;
    const bf16_t* proj; const float* b_gate; float* mixf; bf16_t* mix;
    __device__ __forceinline__ void operator()(const f32x4 (&acc)[2][2][4][2], const Unit& u, int wr, int wc, int fr, int fq) const {
        const int row0 = u.pm * BM + wr * 64 + fr, col0 = u.pn * BM + wc * 32 + 4 * fq; const int z = u.z;
#pragma unroll
        for (int ai = 0; ai < 2; ++ai)
#pragma unroll
            for (int m = 0; m < 4; ++m) { const int row = row0 + ai * HALF + m * 16;
#pragma unroll
                for (int bj = 0; bj < 2; ++bj)
#pragma unroll
                    for (int n = 0; n < 2; ++n) { const int col = col0 + bj * HALF + n * 16;
                        const u32x2 gl = *(const u32x2*)(proj + (size_t)row * LDP + P_GATE + z * DM + col);
                        const f32x4 bg = *(const f32x4*)(b_gate + z * DM + col);
                        f32x4 t; t[0] = sigmoidf_(bflo(gl.x) + bg[0]) * acc[ai][bj][m][n][0]; t[1] = sigmoidf_(bfhi(gl.x) + bg[1]) * acc[ai][bj][m][n][1];
                        t[2] = sigmoidf_(bflo(gl.y) + bg[2]) * acc[ai][bj][m][n][2]; t[3] = sigmoidf_(bfhi(gl.y) + bg[3]) * acc[ai][bj][m][n][3];
                        float* mp = mixf + (size_t)row * DM + col;
                        if (z > 0) t += *(const f32x4*)mp;
                        if (z < 3) *(f32x4*)mp = t;
                        else { u32x2 w; w.x = cvt_pk_bf16(t[0], t[1]); w.y = cvt_pk_bf16(t[2], t[3]); *(u32x2*)(mix + (size_t)row * DM + col) = w; } } }
    }
};

template <class Epi, class Sched>
__device__ __forceinline__ void gemm_phase(LAS unsigned char* lds, const Gemm g, const Sched& S, const Epi& E) {
    int tid_ = threadIdx.x; asm volatile("" : "+v"(tid_));
    const int tid = tid_, wid = __builtin_amdgcn_readfirstlane(tid >> 6), lane = tid & 63, wr = wid >> 2, wc = wid & 3, fr = lane & 15, fq = lane >> 4;
    const int K = g.K, nt = K / BK;
    unsigned voffA[2], voffB[2];
#pragma unroll
    for (int i = 0; i < 2; ++i) { int R, C; stage_rc(tid * 16 + i * 8192, R, C); const int Rb = Epi::PERM ? ((R & ~31) + perm32(R & 31)) : R;
        voffA[i] = (unsigned)(R * g.lda + C) * 2u; voffB[i] = (unsigned)(Rb * g.ldb + C) * 2u; }
    const size_t kstep = (size_t)(BK * 2);
    const size_t hstepA = (size_t)HALF * g.lda * 2, hstepB = (size_t)HALF * g.ldb * 2;
    const unsigned ldsw = (unsigned)wid * 1024u;
    const int aoff = lds_byte(wr * 64 + fr, fq * 8), boff = lds_byte(wc * 32 + fr, fq * 8);
#define PG8_SA(b, h) (((b) * 2 + (h)) * HTB)
#define PG8_SB(b, h) ((4 + (b) * 2 + (h)) * HTB)
#define PG8_STAGE(bufoff, gbase, voff) do { _Pragma("unroll") for (int _i = 0; _i < 2; ++_i) \
        __builtin_amdgcn_global_load_lds((const unsigned*)((const char*)(gbase) + (voff)[_i]), (LAS unsigned*)(lds + (bufoff) + ldsw + _i * 8192), 16, 0, 0); } while (0)
#define PG8_LDA(dst, b, h) do { _Pragma("unroll") for (int m = 0; m < 4; ++m) _Pragma("unroll") for (int k = 0; k < 2; ++k) dst[m][k] = *(const LAS bf16x8*)(lds + PG8_SA(b, h) + aoff + m * 2048 + k * 1024); } while (0)
#define PG8_LDB(dst, b, h) do { _Pragma("unroll") for (int n = 0; n < 2; ++n) _Pragma("unroll") for (int k = 0; k < 2; ++k) dst[n][k] = *(const LAS bf16x8*)(lds + PG8_SB(b, h) + boff + n * 2048 + k * 1024); } while (0)
#define PG8_MMA(ai, bj, At, Bt) do { __builtin_amdgcn_s_setprio(1); _Pragma("unroll") for (int m = 0; m < 4; ++m) _Pragma("unroll") for (int n = 0; n < 2; ++n) _Pragma("unroll") for (int k = 0; k < 2; ++k) \
        acc[ai][bj][m][n] = __builtin_amdgcn_mfma_f32_16x16x32_bf16(Bt[n][k], At[m][k], acc[ai][bj][m][n], 0, 0, 0); __builtin_amdgcn_s_setprio(0); } while (0)
#define PG8_WAIT_V(n) asm volatile("s_waitcnt vmcnt(" #n ")" ::: "memory")
#define PG8_WAIT_L(n) asm volatile("s_waitcnt lgkmcnt(" #n ")" ::: "memory")
#define PG8_BAR __builtin_amdgcn_s_barrier()
#define PG8_SCHED __builtin_amdgcn_sched_barrier(0)
#define PG8_APTR(u) ((const char*)g.A + ((size_t)(u).z * g.zA) * 2 + (size_t)(u).pm * 2 * hstepA)
#define PG8_BPTR(u) ((const char*)g.Bt + ((size_t)(u).z * g.zB) * 2 + (size_t)(u).pn * 2 * hstepB)
    Unit cur, nxt; int ui = 0;
    if (!S.next(0, cur)) return;
    f32x4 acc[2][2][4][2];
#pragma unroll
    for (int a = 0; a < 2; ++a)
#pragma unroll
        for (int b = 0; b < 2; ++b)
#pragma unroll
            for (int m = 0; m < 4; ++m)
#pragma unroll
                for (int n = 0; n < 2; ++n) acc[a][b][m][n] = (f32x4){0.f, 0.f, 0.f, 0.f};
    bf16x8 At[4][2], B0[2][2], B1[2][2];
    const char* cA = PG8_APTR(cur); const char* cB = PG8_BPTR(cur);
    PG8_STAGE(PG8_SB(0, 0), cB, voffB); PG8_STAGE(PG8_SA(0, 0), cA, voffA); PG8_STAGE(PG8_SB(0, 1), cB + hstepB, voffB); PG8_STAGE(PG8_SA(0, 1), cA + hstepA, voffA);
    if (wr == 1) PG8_BAR;
    PG8_WAIT_V(4); PG8_BAR;
    PG8_STAGE(PG8_SB(1, 0), cB + kstep, voffB); PG8_STAGE(PG8_SA(1, 0), cA + kstep, voffA); PG8_STAGE(PG8_SB(1, 1), cB + hstepB + kstep, voffB);
    PG8_WAIT_V(6); PG8_BAR;
    for (;;) {
        const bool has_next = S.next(ui + 1, nxt);
        const char* nA = has_next ? PG8_APTR(nxt) : cA; const char* nB = has_next ? PG8_BPTR(nxt) : cB;
        for (int t = 0; t < nt; t += 2) {
            const bool last = (t == nt - 2);
            const char* a1 = cA + (size_t)(t + 1) * kstep;
            const char* a2 = last ? nA : cA + (size_t)(t + 2) * kstep; const char* b2 = last ? nB : cB + (size_t)(t + 2) * kstep;
            const char* a3 = a2 + kstep; const char* b3 = b2 + kstep;
            PG8_LDB(B0, 0, 0); PG8_SCHED; PG8_LDA(At, 0, 0); PG8_STAGE(PG8_SA(1, 1), a1 + hstepA, voffA);
            PG8_WAIT_L(8); PG8_BAR; PG8_WAIT_L(0); PG8_MMA(0, 0, At, B0); PG8_BAR; PG8_SCHED;
            PG8_LDB(B1, 0, 1); PG8_STAGE(PG8_SB(0, 0), b2, voffB);
            PG8_BAR; PG8_WAIT_L(0); PG8_MMA(0, 1, At, B1); PG8_BAR;
            PG8_LDA(At, 0, 1); PG8_STAGE(PG8_SA(0, 0), a2, voffA);
            PG8_BAR; PG8_WAIT_L(0); PG8_MMA(1, 0, At, B0); PG8_BAR; PG8_SCHED;
            PG8_STAGE(PG8_SB(0, 1), b2 + hstepB, voffB);
            PG8_WAIT_V(6); PG8_BAR; PG8_MMA(1, 1, At, B1); PG8_BAR;
            PG8_LDB(B0, 1, 0); PG8_SCHED; PG8_LDA(At, 1, 0); PG8_STAGE(PG8_SA(0, 1), a2 + hstepA, voffA);
            PG8_WAIT_L(8); PG8_BAR; PG8_WAIT_L(0); PG8_MMA(0, 0, At, B0); PG8_BAR; PG8_SCHED;
            PG8_LDB(B1, 1, 1); PG8_STAGE(PG8_SB(1, 0), b3, voffB);
            PG8_BAR; PG8_WAIT_L(0); PG8_MMA(0, 1, At, B1); PG8_BAR;
            PG8_LDA(At, 1, 1); PG8_STAGE(PG8_SA(1, 0), a3, voffA);
            PG8_BAR; PG8_WAIT_L(0); PG8_MMA(1, 0, At, B0); PG8_BAR; PG8_SCHED;
            PG8_STAGE(PG8_SB(1, 1), b3 + hstepB, voffB);
            PG8_WAIT_V(6); PG8_BAR; PG8_MMA(1, 1, At, B1); PG8_BAR;
        }
        E(acc, cur, wr, wc, fr, fq);
        if (!has_next) break;
#pragma unroll
        for (int a = 0; a < 2; ++a)
#pragma unroll
            for (int b = 0; b < 2; ++b)
#pragma unroll
                for (int m = 0; m < 4; ++m)
#pragma unroll
                    for (int n = 0; n < 2; ++n) acc[a][b][m][n] = (f32x4){0.f, 0.f, 0.f, 0.f};
        cur = nxt; cA = nA; cB = nB; ++ui;
    }
    PG8_WAIT_V(0);
    if (wr == 0) PG8_BAR;
    PG8_BAR;
#undef PG8_SA
#undef PG8_SB
#undef PG8_STAGE
#undef PG8_LDA
#undef PG8_LDB
#undef PG8_MMA
#undef PG8_WAIT_V
#undef PG8_WAIT_L
#undef PG8_BAR
#undef PG8_SCHED
#undef PG8_APTR
#undef PG8_BPTR
}
}

struct Args {
    const float* x; const int* pos; const float* norm_mix; const float* w_in; const float* b_gate;
    const float* cmp_pos_k; const float* cmp_pos_v; const float* cmp_wk1; const float* cmp_wk2; const float* cmp_wv1; const float* cmp_wv2;
    const float* gla_w_alpha; const float* gla_b_alpha; const float* gla_norm; const float* fox_b_f;
    const float* w_branch; const float* w_out; const float* norm_ff; const float* w_ff1; const float* w_ff2; const float* norm_final;
    float* out; unsigned char* ws;
    int l_lo, l_hi, p_lo, p_hi, do_final, pad;
};

struct Ctx { LAS unsigned char* lds; int tid, lane, wave, G, bid, gw, NGW; };
__device__ __forceinline__ Ctx make_ctx(LAS unsigned char* lds) {
    Ctx C; int t = threadIdx.x; asm volatile("" : "+v"(t));
    C.lds = lds; C.tid = t; C.lane = t & 63; C.wave = __builtin_amdgcn_readfirstlane(t >> 6); C.G = gridDim.x; C.bid = blockIdx.x; C.gw = C.bid * NWAVES + C.wave; C.NGW = C.G * NWAVES; return C;
}

template <bool MAP>
__device__ __forceinline__ void transpose_item(const float* W, int Nsrc, int Kdim, bf16_t* WT, LAS float* scr, int k0, int n0, int lane) {
    const int nn = n0 + (lane & 31); const int sc = MAP ? win_src_col(nn) : nn;
#pragma unroll 8
    for (int i = 0; i < 32; ++i) { const int kk = 2 * i + (lane >> 5); scr[kk * 33 + (lane & 31)] = (sc >= 0) ? W[(size_t)(k0 + kk) * Nsrc + sc] : 0.f; }
    asm volatile("s_waitcnt lgkmcnt(0)" ::: "memory");
    const int c = lane & 7;
#pragma unroll
    for (int j = 0; j < 4; ++j) { const int n = (lane >> 3) + 8 * j; const LAS float* s = scr + (8 * c) * 33 + n;
        u32x4 o; o.x = pk2(s[0 * 33], s[1 * 33]); o.y = pk2(s[2 * 33], s[3 * 33]); o.z = pk2(s[4 * 33], s[5 * 33]); o.w = pk2(s[6 * 33], s[7 * 33]);
        *(u32x4*)(WT + (size_t)(n0 + n) * Kdim + k0 + 8 * c) = o; }
    asm volatile("s_waitcnt lgkmcnt(0)" ::: "memory");
}
template <bool MAP>
__device__ __forceinline__ void transpose_matrix(const Ctx& C, const float* W, int Kdim, int Nsrc, int Ndst, bf16_t* WT, int& base) {
    LAS float* scr = (LAS float*)(C.lds + C.wave * 16384);
    const int nblk = Ndst / 32, items = (Kdim / 64) * nblk;
    int first = (C.gw - base % C.NGW + C.NGW) % C.NGW;
    for (int it = first; it < items; it += C.NGW) { const int kb = it / nblk, nb = it % nblk; transpose_item<MAP>(W, Nsrc, Kdim, WT, scr, 64 * kb, 32 * nb, C.lane); }
    base += items;
}
__device__ __forceinline__ void rms_row_bf16(const float* xrow, const float* g, bf16_t* orow, int lane) {
    const f32x4* xr = (const f32x4*)xrow + lane; const f32x4* gr = (const f32x4*)g + lane;
    f32x4 v[4]; float s = 0.f;
#pragma unroll
    for (int j = 0; j < 4; ++j) { v[j] = xr[64 * j]; s += (v[j].x * v[j].x + v[j].y * v[j].y) + (v[j].z * v[j].z + v[j].w * v[j].w); }
    const float r = rsqrtf(wave_sum(s) * (1.f / DM) + EPS);
    unsigned long long* o8 = (unsigned long long*)orow + lane;
#pragma unroll
    for (int j = 0; j < 4; ++j) { const f32x4 gg = gr[64 * j];
        o8[64 * j] = (unsigned long long)pk2(v[j].x * r * gg.x, v[j].y * r * gg.y) | ((unsigned long long)pk2(v[j].z * r * gg.z, v[j].w * r * gg.w) << 32); }
}
__device__ __forceinline__ void rms_rows_phase(const Ctx& C, const float* x, const float* g, bf16_t* hb) {
    for (int m = C.gw; m < M; m += C.NGW) rms_row_bf16(x + (size_t)m * DM, g, hb + (size_t)m * DM, C.lane);
}
__device__ __forceinline__ void final_norm_phase(const Ctx& C, float* x, const float* g) {
    for (int m = C.gw; m < M; m += C.NGW) {
        f32x4* xr = (f32x4*)(x + (size_t)m * DM) + C.lane; const f32x4* gr = (const f32x4*)g + C.lane;
        f32x4 v[4]; float s = 0.f;
#pragma unroll
        for (int j = 0; j < 4; ++j) { v[j] = xr[64 * j]; s += (v[j].x * v[j].x + v[j].y * v[j].y) + (v[j].z * v[j].z + v[j].w * v[j].w); }
        const float r = rsqrtf(wave_sum(s) * (1.f / DM) + EPS);
#pragma unroll
        for (int j = 0; j < 4; ++j) xr[64 * j] = v[j] * r * gr[64 * j];
    }
}

__device__ __forceinline__ void ld8(const bf16_t* p, float (&o)[8]) {
    const u32x4 w = *(const u32x4*)p;
    o[0] = bflo(w.x); o[1] = bfhi(w.x); o[2] = bflo(w.y); o[3] = bfhi(w.y); o[4] = bflo(w.z); o[5] = bfhi(w.z); o[6] = bflo(w.w); o[7] = bfhi(w.w);
}
__device__ __forceinline__ float dot64(const float (&q)[64], const bf16_t* k) {
    float s = 0.f;
#pragma unroll
    for (int c = 0; c < 8; ++c) { float kv[8]; ld8(k + 8 * c, kv);
#pragma unroll
        for (int j = 0; j < 8; ++j) s += q[8 * c + j] * kv[j]; }
    return s;
}
__device__ __forceinline__ void axpy64(float (&acc)[64], float p, const bf16_t* v) {
#pragma unroll
    for (int c = 0; c < 8; ++c) { float vv[8]; ld8(v + 8 * c, vv);
#pragma unroll
        for (int j = 0; j < 8; ++j) acc[8 * c + j] += p * vv[j]; }
}
__device__ __forceinline__ void ldq64(float (&q)[64], const bf16_t* p, float scale) {
#pragma unroll
    for (int c = 0; c < 8; ++c) { float t[8]; ld8(p + 8 * c, t);
#pragma unroll
        for (int j = 0; j < 8; ++j) q[8 * c + j] = t[j] * scale; }
}
struct OS { float m, l; };
#define OS_STEP(sc) do { const float mn_ = fmaxf(st.m, (sc)); const float al_ = __expf(st.m - mn_); const float p_ = __expf((sc) - mn_); st.l = st.l * al_ + p_; \
    _Pragma("unroll") for (int d_ = 0; d_ < 64; ++d_) acc[d_] *= al_; axpy64(acc, p_, vrow); st.m = mn_; } while (0)

__device__ __forceinline__ void rope_rotate(bf16_t* p, int posv) {
    u32x4 a = *(u32x4*)p, b = *(u32x4*)(p + 8);
    float x1[8] = {bflo(a.x), bfhi(a.x), bflo(a.y), bfhi(a.y), bflo(a.z), bfhi(a.z), bflo(a.w), bfhi(a.w)};
    float x2[8] = {bflo(b.x), bfhi(b.x), bflo(b.y), bfhi(b.y), bflo(b.z), bfhi(b.z), bflo(b.w), bfhi(b.w)};
    float o1[8], o2[8];
#pragma unroll
    for (int i = 0; i < 8; ++i) { const float inv = powf(500000.0f, -(float)(2 * i) / 16.0f); const float ang = (float)posv * inv; float sn, cs; sincosf(ang, &sn, &cs);
        o1[i] = x1[i] * cs - x2[i] * sn; o2[i] = x2[i] * cs + x1[i] * sn; }
    a.x = pk2(o1[0], o1[1]); a.y = pk2(o1[2], o1[3]); a.z = pk2(o1[4], o1[5]); a.w = pk2(o1[6], o1[7]);
    b.x = pk2(o2[0], o2[1]); b.y = pk2(o2[2], o2[3]); b.z = pk2(o2[4], o2[5]); b.w = pk2(o2[6], o2[7]);
    *(u32x4*)p = a; *(u32x4*)(p + 8) = b;
}
__device__ __forceinline__ float gelu_tanh(float x) { const float u = 0.7978845608028654f * (x + 0.044715f * x * x * x); return 0.5f * x * (1.0f + tanhf(u)); }

__device__ __forceinline__ void naive_prepA(const Ctx& C, const Args& a, int l, bf16_t* proj, float* cum, float* ch) {
    const int gt = C.bid * NTHR + C.tid, NT = C.G * NTHR;
    for (int i = gt; i < M * 12; i += NT) { const int tok = i / 12, j = i % 12; const int col = j < 8 ? P_NQ + j * 64 : (j < 10 ? P_KS + (j - 8) * 64 : P_KW + (j - 10) * 64);
        rope_rotate(proj + (size_t)tok * LDP + col, a.pos[tok]); }
    for (int bh = C.gw; bh < NB * 8; bh += C.NGW) { const int b = bh >> 3, h = bh & 7; const float bf = a.fox_b_f[l * 8 + h];
        float loc[32]; float run = 0.f;
#pragma unroll
        for (int i = 0; i < 32; ++i) { const int s = C.lane * 32 + i; const float f = bf2f(proj[(size_t)(b * SEQ + s) * LDP + P_FF + h]); run += logsigmoidf_(f + bf); loc[i] = run; }
        float incl = run;
#pragma unroll
        for (int o = 1; o < 64; o <<= 1) { const float t = __shfl_up(incl, o); if (C.lane >= o) incl += t; }
        const float excl = incl - run;
#pragma unroll
        for (int i = 0; i < 32; ++i) cum[(size_t)bh * SEQ + C.lane * 32 + i] = excl + loc[i]; }
    const int NCH = 2 * NB * 127 * 2 * 256;
    for (int i = gt; i < NCH; i += NT) { const int j = i & 255; int r = i >> 8; const int g = r & 1; r >>= 1; const int c = r % 127; r /= 127; const int b = r % NB; const int kv = r / NB;
        const float* w1 = (kv ? a.cmp_wv1 : a.cmp_wk1) + (size_t)l * 2048 * 256; const float* pe = (kv ? a.cmp_pos_v : a.cmp_pos_k) + (size_t)l * 32 * 64;
        const int col = (kv ? P_VC : P_KC) + g * 64; float s = 0.f;
        for (int ll = 0; ll < 32; ++ll) { const bf16_t* xr = proj + (size_t)(b * SEQ + 16 * c + ll) * LDP + col;
            for (int d8 = 0; d8 < 8; ++d8) { float xv[8]; ld8(xr + 8 * d8, xv);
#pragma unroll
                for (int d = 0; d < 8; ++d) s += (xv[d] + pe[ll * 64 + d8 * 8 + d]) * w1[(size_t)(ll * 64 + d8 * 8 + d) * 256 + j]; } }
        ch[i] = gelu_tanh(s); }
}
__device__ __forceinline__ void naive_prepB(const Ctx& C, const Args& a, int l, const float* ch, bf16_t* kcvc) {
    const int gt = C.bid * NTHR + C.tid, NT = C.G * NTHR; const int NO = 2 * NB * 127 * 2 * 64;
    for (int i = gt; i < NO; i += NT) { const int d = i & 63; int r = i >> 6; const int g = r & 1; r >>= 1; const int c = r % 127; r /= 127; const int b = r % NB; const int kv = r / NB;
        const float* w2 = (kv ? a.cmp_wv2 : a.cmp_wk2) + (size_t)l * 256 * 64; const float* hrow = ch + ((((size_t)kv * NB + b) * 127 + c) * 2 + g) * 256;
        float v = 0.f, vp = 0.f; const int dp = (d < 8) ? d + 8 : d - 8;
        for (int j = 0; j < 256; ++j) { const float hv = hrow[j]; v += hv * w2[j * 64 + d]; if (d < 16) vp += hv * w2[j * 64 + dp]; }
        if (kv == 0 && d < 16) { const int i8 = d & 7; const float inv = powf(500000.0f, -(float)(2 * i8) / 16.0f); const float ang = (float)a.pos[b * SEQ + 16 * c + 31] * inv; float sn, cs; sincosf(ang, &sn, &cs);
            v = (d < 8) ? (v * cs - vp * sn) : (v * cs + vp * sn); }
        kcvc[((((size_t)kv * NB + b) * 128 + c) * 2 + g) * 64 + d] = (bf16_t)f2bf(v); }
}

__device__ __forceinline__ void naive_fox(const Ctx& C, const bf16_t* proj, const float* cum, bf16_t* ys) {
    for (int blk = C.bid; blk < NB * 8 * 4; blk += C.G) { const int bh = blk >> 2, b = bh >> 3, h = bh & 7; const int t = (blk & 3) * 512 + C.tid;
        const size_t rowb = (size_t)b * SEQ; float q[64]; ldq64(q, proj + (rowb + t) * LDP + P_FQ + h * 64, 0.125f);
        const float ct = cum[(size_t)bh * SEQ + t]; float acc[64];
#pragma unroll
        for (int d = 0; d < 64; ++d) acc[d] = 0.f;
        OS st; st.m = -1e30f; st.l = 0.f; const int tmax = t | 63;
        for (int s = 0; s <= tmax; ++s) { const bf16_t* krow = proj + (rowb + s) * LDP + P_FK + h * 64; const bf16_t* vrow = proj + (rowb + s) * LDP + P_FV + h * 64;
            if (s <= t) { const float sc = dot64(q, krow) + ct - cum[(size_t)bh * SEQ + s]; OS_STEP(sc); } }
        const float il = 1.f / st.l; bf16_t* o = ys + ((size_t)3 * M + rowb + t) * 512 + h * 64;
#pragma unroll
        for (int d = 0; d < 64; d += 2) *(unsigned*)(o + d) = pk2(acc[d] * il, acc[d + 1] * il); }
}
__device__ __forceinline__ void naive_sb(const Ctx& C, const bf16_t* proj, bf16_t* ys) {
    for (int blk = C.bid; blk < NB * 8 * 4; blk += C.G) { const int bh = blk >> 2, b = bh >> 3, h = bh & 7; const int t = (blk & 3) * 512 + C.tid;
        const size_t rowb = (size_t)b * SEQ; float q[64]; ldq64(q, proj + (rowb + t) * LDP + P_SQ + h * 64, 0.125f);
        float acc[64];
#pragma unroll
        for (int d = 0; d < 64; ++d) acc[d] = 0.f;
        float R = 0.f; const int tmax = t | 63;
        for (int s = tmax - 1; s >= 0; --s) { const bf16_t* krow = proj + (rowb + s) * LDP + P_SK + h * 64; const bf16_t* vrow = proj + (rowb + s) * LDP + P_SV + h * 64;
            if (s < t) { const float z = dot64(q, krow); const float sp = softplusf_(z); const float av = __expf(z - sp - R); axpy64(acc, av, vrow); R += sp; } }
        bf16_t* o = ys + ((size_t)1 * M + rowb + t) * 512 + h * 64;
#pragma unroll
        for (int d = 0; d < 64; d += 2) *(unsigned*)(o + d) = pk2(acc[d], acc[d + 1]); }
}
__device__ __forceinline__ void naive_gla(const Ctx& C, const Args& a, int l, const bf16_t* proj, float* obuf, bf16_t* ys) {
    LAS float* red = (LAS float*)C.lds;
    for (int bh = C.bid; bh < NB * 4; bh += C.G) { const int b = bh >> 2, h = bh & 3; const int kk = C.tid >> 3, vs = C.tid & 7; const size_t rowb = (size_t)b * SEQ;
        float wa[16];
#pragma unroll
        for (int r = 0; r < 16; ++r) wa[r] = a.gla_w_alpha[(size_t)l * 16 * 256 + r * 256 + h * 64 + kk];
        const float ba = a.gla_b_alpha[l * 256 + h * 64 + kk];
        float stt[16];
#pragma unroll
        for (int i = 0; i < 16; ++i) stt[i] = 0.f;
        for (int t = 0; t < SEQ; ++t) { const bf16_t* pr = proj + (rowb + t) * LDP;
            float al[16]; { float t0[8], t1[8]; ld8(pr + P_GA, t0); ld8(pr + P_GA + 8, t1);
#pragma unroll
                for (int r = 0; r < 8; ++r) { al[r] = t0[r]; al[8 + r] = t1[r]; } }
            float xa = ba;
#pragma unroll
            for (int r = 0; r < 16; ++r) xa += al[r] * wa[r];
            const float dec = __expf(logsigmoidf_(xa) * (1.0f / 16.0f));
            const float kv = bf2f(pr[P_GK + h * 64 + kk]), qv = bf2f(pr[P_GQ + h * 64 + kk]) * 0.125f;
            float vv[16]; { float t0[8], t1[8]; ld8(pr + P_GV + h * 128 + vs * 16, t0); ld8(pr + P_GV + h * 128 + vs * 16 + 8, t1);
#pragma unroll
                for (int r = 0; r < 8; ++r) { vv[r] = t0[r]; vv[8 + r] = t1[r]; } }
            float po[16];
#pragma unroll
            for (int i = 0; i < 16; ++i) { stt[i] = dec * stt[i] + kv * vv[i]; po[i] = qv * stt[i]; }
#pragma unroll
            for (int i = 0; i < 16; ++i) { po[i] += __shfl_xor(po[i], 8); po[i] += __shfl_xor(po[i], 16); po[i] += __shfl_xor(po[i], 32); }
            LAS float* rb = red + (t & 1) * 1024 + C.wave * 128;
            if (C.lane < 8) {
#pragma unroll
                for (int i = 0; i < 16; ++i) rb[C.lane * 16 + i] = po[i]; }
            __syncthreads();
            if (C.tid < 128) { float s = 0.f;
#pragma unroll
                for (int w = 0; w < 8; ++w) s += red[(t & 1) * 1024 + w * 128 + C.tid];
                obuf[(rowb + t) * 512 + h * 128 + C.tid] = s; } }
        __syncthreads();
        for (int t = C.wave; t < SEQ; t += NWAVES) { const float* orow = obuf + (rowb + t) * 512 + h * 128; const float o0 = orow[C.lane], o1 = orow[C.lane + 64];
            const float ss = wave_sum(o0 * o0 + o1 * o1); const float r = rsqrtf(ss * (1.f / 128.f) + EPS);
            const bf16_t* gp = proj + (rowb + t) * LDP + P_GG + h * 128; const float g0 = bf2f(gp[C.lane]), g1 = bf2f(gp[C.lane + 64]);
            const float n0 = a.gla_norm[l * 128 + C.lane], n1 = a.gla_norm[l * 128 + C.lane + 64];
            bf16_t* yo = ys + ((size_t)2 * M + rowb + t) * 512 + h * 128;
            yo[C.lane] = (bf16_t)f2bf(o0 * r * n0 * (g0 * sigmoidf_(g0))); yo[C.lane + 64] = (bf16_t)f2bf(o1 * r * n1 * (g1 * sigmoidf_(g1))); }
        __syncthreads(); }
}
__device__ __forceinline__ void naive_nsa(const Ctx& C, const bf16_t* proj, const bf16_t* kcvc, float* yf, bf16_t* ys) {
    LAS float* imp = (LAS float*)C.lds;
    for (int blk = C.bid; blk < NB * 2 * 4; blk += C.G) { const int bg = blk >> 2, b = bg >> 1, g = bg & 1; const int t = (blk & 3) * 512 + C.tid; const size_t rowb = (size_t)b * SEQ;
        const bf16_t* prow = proj + (rowb + t) * LDP;
#pragma unroll
        for (int j = 0; j < 32; ++j) imp[j * 512 + C.tid] = 0.f;
        const int ncv = (t >= 31) ? ((t - 31) / 16 + 1) : 0; const int tw = t | 63; const int ncv_w = (tw >= 31) ? ((tw - 31) / 16 + 1) : 0;
        const bf16_t* kc = kcvc + (((size_t)0 * NB + b) * 128 * 2 + g) * 64; const bf16_t* vc = kcvc + (((size_t)1 * NB + b) * 128 * 2 + g) * 64;
        for (int hp = 0; hp < 4; ++hp) { const int h = g * 4 + hp; float q[64]; ldq64(q, prow + P_NQ + h * 64, 0.125f);
            float m = -1e30f, lsum = 0.f;
            for (int c = 0; c < ncv_w; ++c) if (c < ncv) { const float sc = dot64(q, kc + (size_t)c * 128); const float mn = fmaxf(m, sc); lsum = lsum * __expf(m - mn) + __expf(sc - mn); m = mn; }
            float acc[64];
#pragma unroll
            for (int d = 0; d < 64; ++d) acc[d] = 0.f;
            const float il = (ncv > 0) ? 1.f / lsum : 0.f;
            for (int c = 0; c < ncv_w; ++c) if (c < ncv) { const float sc = dot64(q, kc + (size_t)c * 128); const float p = __expf(sc - m) * il; axpy64(acc, p, vc + (size_t)c * 128);
                const int j = c >> 2, r = c & 3;
                if (r < 3) imp[j * 512 + C.tid] += p; else { imp[j * 512 + C.tid] += 0.5f * p; imp[(j + 1) * 512 + C.tid] += 0.5f * p; } }
            const float gc = sigmoidf_(bf2f(prow[P_NG + h * 3 + 0])); float* yo = yf + (rowb + t) * 512 + h * 64;
#pragma unroll
            for (int d = 0; d < 64; ++d) yo[d] = gc * acc[d]; }
        const int jt = t >> 6;
#pragma unroll
        for (int j = 0; j < 32; ++j) { float v = imp[j * 512 + C.tid]; if (j == 0 || j == jt) v = __builtin_inff(); else if (64 * j > t) v = -__builtin_inff(); imp[j * 512 + C.tid] = v; }
        unsigned sel = 0u;
        for (int j = 0; j < 32; ++j) { const float vj = imp[j * 512 + C.tid]; int rank = 0;
            for (int j2 = 0; j2 < 32; ++j2) { const float v2 = imp[j2 * 512 + C.tid]; rank += (v2 > vj || (v2 == vj && j2 < j)) ? 1 : 0; }
            if (rank < 8) sel |= (1u << j); }
        const int twmin = t & ~63;
        for (int hp = 0; hp < 4; ++hp) { const int h = g * 4 + hp; float q[64]; ldq64(q, prow + P_NQ + h * 64, 0.125f);
            float* yo = yf + (rowb + t) * 512 + h * 64;
            { float acc[64];
#pragma unroll
              for (int d = 0; d < 64; ++d) acc[d] = 0.f;
              OS st; st.m = -1e30f; st.l = 0.f;
              for (int s = 0; s <= tw; ++s) { if (s <= t && ((sel >> (s >> 6)) & 1u)) { const bf16_t* krow = proj + (rowb + s) * LDP + P_KS + g * 64; const bf16_t* vrow = proj + (rowb + s) * LDP + P_VS + g * 64;
                    const float sc = dot64(q, krow); OS_STEP(sc); } }
              const float gs = sigmoidf_(bf2f(prow[P_NG + h * 3 + 1])) / st.l;
#pragma unroll
              for (int d = 0; d < 64; ++d) yo[d] += gs * acc[d]; }
            { float acc[64];
#pragma unroll
              for (int d = 0; d < 64; ++d) acc[d] = 0.f;
              OS st; st.m = -1e30f; st.l = 0.f; const int slo = (twmin - 255) > 0 ? (twmin - 255) : 0;
              for (int s = slo; s <= tw; ++s) { if (s <= t && s > t - 256) { const bf16_t* krow = proj + (rowb + s) * LDP + P_KW + g * 64; const bf16_t* vrow = proj + (rowb + s) * LDP + P_VW + g * 64;
                    const float sc = dot64(q, krow); OS_STEP(sc); } }
              const float gw = sigmoidf_(bf2f(prow[P_NG + h * 3 + 2])) / st.l; bf16_t* o = ys + ((size_t)0 * M + rowb + t) * 512 + h * 64;
#pragma unroll
              for (int d = 0; d < 64; d += 2) *(unsigned*)(o + d) = pk2(yo[d] + gw * acc[d], yo[d + 1] + gw * acc[d + 1]); } }
        __syncthreads(); }
}

__global__ void __launch_bounds__(NTHR, 2) hybrid_fwd(Args a) {
    extern __shared__ __attribute__((aligned(16))) unsigned char lds_raw[];
    LAS unsigned char* lds = (LAS unsigned char*)lds_raw;
    volatile LAS unsigned* MISC = (volatile LAS unsigned*)(lds + MISC_OFF);
    if (threadIdx.x < 64) MISC[threadIdx.x] = 0u;
    const int G_ = gridDim.x, bid_ = blockIdx.x;
    __syncthreads();
    unsigned char* ws = a.ws;
    unsigned* ctl = (unsigned*)(ws + WS_CTL);
#if MK_ONE_LAUNCH
    XcdBarrier bar = xcd_barrier_post(ctl + CW_BAR, MISC + 8);
#define GRID_BAR() xcd_barrier(bar)
#else
#define GRID_BAR() do {} while (0)
#endif
    bf16_t* win_t = (bf16_t*)(ws + WS_WIN); bf16_t* wb_t = (bf16_t*)(ws + WS_WB); bf16_t* wo_t = (bf16_t*)(ws + WS_WO); bf16_t* wf1_t = (bf16_t*)(ws + WS_WF1); bf16_t* wf2_t = (bf16_t*)(ws + WS_WF2);
    bf16_t* hb = (bf16_t*)(ws + WS_HB); bf16_t* mix = (bf16_t*)(ws + WS_MIX); bf16_t* ys = (bf16_t*)(ws + WS_YS); bf16_t* proj = (bf16_t*)(ws + WS_PROJ); bf16_t* hid = (bf16_t*)(ws + WS_HID);
    float* mixf = (float*)(ws + WS_MIXF); float* cum = (float*)(ws + WS_CUM); float* ch = (float*)(ws + WS_CH); bf16_t* kcvc = (bf16_t*)(ws + WS_KC);
    float* gds = (float*)(ws + WS_GDS); float* goi = (float*)(ws + WS_GOI);
    float* xbuf = a.out;

#ifndef PH_MASK
#define PH_MASK 0xFFFF
#endif
#define IN(k) (((PH_MASK >> (k)) & 1) && a.p_lo <= (k) && (k) < a.p_hi)
    for (int l = a.l_lo; l < a.l_hi; ++l) {
        const float* xin = (l == 0) ? a.x : xbuf;
        if (IN(0)) {
            const Ctx C = make_ctx(lds); int base = 0;
            transpose_matrix<true>(C, a.w_in + (size_t)l * DM * DIN, DM, DIN, LDP, win_t, base);
            for (int z = 0; z < 4; ++z) transpose_matrix<false>(C, a.w_branch + ((size_t)l * 4 + z) * 512 * DM, 512, DM, DM, wb_t + (size_t)z * DM * 512, base);
            transpose_matrix<false>(C, a.w_out + (size_t)l * DM * DM, DM, DM, DM, wo_t, base);
            transpose_matrix<false>(C, a.w_ff1 + (size_t)l * DM * DFF, DM, DFF, DFF, wf1_t, base);
            transpose_matrix<false>(C, a.w_ff2 + (size_t)l * DFF * DM, DFF, DM, DM, wf2_t, base);
            rms_rows_phase(C, xin, a.norm_mix + l * DM, hb);
            GRID_BAR();
        }
        if (IN(1)) {
            pg8::Gemm g{hb, win_t, DM, DM, DM, 0, 0}; pg8::StaticOrder S; S.init(M, LDP, G_, bid_);
            pg8::EpiBf16<0> E{proj, LDP};
            pg8::gemm_phase(lds, g, S, E);
            GRID_BAR();
        }
        if (IN(5)) {
            pg8::Gemm g{ys, wb_t, 512, 512, 512, (size_t)M * 512, (size_t)DM * 512}; pg8::ZOrder S; S.init(M, DM, G_, bid_); S.NZ = 4;
            pg8::EpiGate E{proj, a.b_gate + (size_t)l * 4 * DM, mixf, mix};
            pg8::gemm_phase(lds, g, S, E);
            GRID_BAR();
        }
        if (IN(6)) {
            pg8::Gemm g{mix, wo_t, DM, DM, DM, 0, 0}; pg8::StaticOrder S; S.init(M, DM, G_, bid_);
            pg8::EpiRes E{xin, xbuf, DM};
            pg8::gemm_phase(lds, g, S, E);
            GRID_BAR();
        }
        if (IN(7)) { const Ctx C = make_ctx(lds); rms_rows_phase(C, xbuf, a.norm_ff + l * DM, hb); GRID_BAR(); }
        if (IN(8)) {
            pg8::Gemm g{hb, wf1_t, DM, DM, DM, 0, 0}; pg8::StaticOrder S; S.init(M, DFF, G_, bid_);
            pg8::EpiBf16<1> E{hid, DFF};
            pg8::gemm_phase(lds, g, S, E);
            GRID_BAR();
        }
        if (IN(9)) {
            pg8::Gemm g{hid, wf2_t, DFF, DFF, DFF, 0, 0}; pg8::StaticOrder S; S.init(M, DM, G_, bid_);
            pg8::EpiRes E{xbuf, xbuf, DM};
            pg8::gemm_phase(lds, g, S, E);
            GRID_BAR();
        }
    }
    if (a.do_final) { const Ctx C = make_ctx(lds); final_norm_phase(C, xbuf, a.norm_final); }
#undef IN
}


#define NAIVE_CTX() extern __shared__ __attribute__((aligned(16))) unsigned char lds_raw[]; Ctx C; C.lds = (LAS unsigned char*)lds_raw; C.tid = threadIdx.x; C.lane = C.tid & 63; \
    C.wave = __builtin_amdgcn_readfirstlane(C.tid >> 6); C.G = gridDim.x; C.bid = blockIdx.x; C.gw = C.bid * NWAVES + C.wave; C.NGW = C.G * NWAVES; unsigned char* ws = a.ws; \
    bf16_t* ys = (bf16_t*)(ws + WS_YS); bf16_t* proj = (bf16_t*)(ws + WS_PROJ); float* cum = (float*)(ws + WS_CUM); float* ch = (float*)(ws + WS_CH); bf16_t* kcvc = (bf16_t*)(ws + WS_KC); \
    float* gds = (float*)(ws + WS_GDS); float* goi = (float*)(ws + WS_GOI); (void)ys; (void)proj; (void)cum; (void)ch; (void)kcvc; (void)gds; (void)goi;
__global__ void __launch_bounds__(NTHR, 2) k_prepA(Args a) { NAIVE_CTX(); naive_prepA(C, a, a.l_lo, proj, cum, ch); }
__global__ void __launch_bounds__(NTHR, 2) k_prepB(Args a) { NAIVE_CTX(); naive_prepB(C, a, a.l_lo, ch, kcvc); }
__global__ void __launch_bounds__(NTHR, 2) k_gla(Args a) { NAIVE_CTX(); naive_gla(C, a, a.l_lo, proj, goi, ys); }
__global__ void __launch_bounds__(NTHR, 2) k_nsa(Args a) { NAIVE_CTX(); naive_nsa(C, proj, kcvc, gds, ys); }
__global__ void __launch_bounds__(NTHR, 2) k_fox(Args a) { NAIVE_CTX(); naive_fox(C, proj, cum, ys); }
__global__ void __launch_bounds__(NTHR, 2) k_sb(Args a) { NAIVE_CTX(); naive_sb(C, proj, ys); }

extern "C" void kernel_launch(void* const* d_in, const int* in_sizes, int n_in, void* d_out, int out_size, void* d_ws, size_t ws_size, hipStream_t stream) {
    static int grid = 0;
    if (grid == 0) {
        if (n_in != 21 || in_sizes[0] != M * DM || out_size != M * DM || ws_size < WS_END) { fprintf(stderr, "kernel_launch: shape/ws mismatch (n_in %d, ws %zu, need %zu)\n", n_in, ws_size, (size_t)WS_END); grid = -1; return; }
        int dev = 0, cus = 0, per_cu = 0;
        if (hipGetDevice(&dev) != hipSuccess || hipDeviceGetAttribute(&cus, hipDeviceAttributeMultiprocessorCount, dev) != hipSuccess) { grid = -1; return; }
        if (hipFuncSetAttribute((const void*)hybrid_fwd, hipFuncAttributeMaxDynamicSharedMemorySize, LDS_BYTES) != hipSuccess) { grid = -1; return; }
        if (hipOccupancyMaxActiveBlocksPerMultiprocessor(&per_cu, (const void*)hybrid_fwd, NTHR, LDS_BYTES) != hipSuccess || per_cu < 1) { fprintf(stderr, "kernel_launch: occupancy query says %d\n", per_cu); }
        (void)hipGetLastError();
        grid = cus;
    }
    if (grid < 0) return;
    (void)hipMemsetAsync((char*)d_ws + WS_CTL, 0, CTL_BYTES, stream);
    Args a{};
    a.x = (const float*)d_in[0]; a.pos = (const int*)d_in[1]; a.norm_mix = (const float*)d_in[2]; a.w_in = (const float*)d_in[3]; a.b_gate = (const float*)d_in[4];
    a.cmp_pos_k = (const float*)d_in[5]; a.cmp_pos_v = (const float*)d_in[6]; a.cmp_wk1 = (const float*)d_in[7]; a.cmp_wk2 = (const float*)d_in[8]; a.cmp_wv1 = (const float*)d_in[9]; a.cmp_wv2 = (const float*)d_in[10];
    a.gla_w_alpha = (const float*)d_in[11]; a.gla_b_alpha = (const float*)d_in[12]; a.gla_norm = (const float*)d_in[13]; a.fox_b_f = (const float*)d_in[14];
    a.w_branch = (const float*)d_in[15]; a.w_out = (const float*)d_in[16]; a.norm_ff = (const float*)d_in[17]; a.w_ff1 = (const float*)d_in[18]; a.w_ff2 = (const float*)d_in[19]; a.norm_final = (const float*)d_in[20];
    a.out = (float*)d_out; a.ws = (unsigned char*)d_ws; a.pad = 0;
#if MK_ONE_LAUNCH
    a.l_lo = 0; a.l_hi = NL; a.p_lo = 0; a.p_hi = 10; a.do_final = 1;
    hipLaunchKernelGGL(hybrid_fwd, dim3(grid), dim3(NTHR), LDS_BYTES, stream, a);
#else
    for (int l = 0; l < NL; ++l)
        for (int p = 0; p < 10; ++p) { a.l_lo = l; a.l_hi = l + 1; a.p_lo = p; a.p_hi = p + 1; a.do_final = 0;
            if (p == 2) hipLaunchKernelGGL(k_prepA, dim3(grid), dim3(NTHR), 0, stream, a);
            else if (p == 3) hipLaunchKernelGGL(k_prepB, dim3(grid), dim3(NTHR), 0, stream, a);
            else if (p == 4) { hipLaunchKernelGGL(k_gla, dim3(32), dim3(NTHR), 8192, stream, a); hipLaunchKernelGGL(k_nsa, dim3(64), dim3(NTHR), 65536, stream, a);
                               hipLaunchKernelGGL(k_fox, dim3(grid), dim3(NTHR), 0, stream, a); hipLaunchKernelGGL(k_sb, dim3(grid), dim3(NTHR), 0, stream, a); }
            else hipLaunchKernelGGL(hybrid_fwd, dim3(grid), dim3(NTHR), LDS_BYTES, stream, a); }
    a.l_lo = 0; a.l_hi = 0; a.p_lo = 0; a.p_hi = 0; a.do_final = 1;
    hipLaunchKernelGGL(hybrid_fwd, dim3(grid), dim3(NTHR), LDS_BYTES, stream, a);
#endif
}
```

```cpp
#include <hip/hip_runtime.h>
#include <cstdio>
#include <cstdint>

#ifndef MK_ONE_LAUNCH
#define MK_ONE_LAUNCH 1
#endif

#define GAS __attribute__((address_space(1)))
#define LAS __attribute__((address_space(3)))
typedef unsigned short bf16_t;
typedef short bf16x8 __attribute__((ext_vector_type(8)));
typedef float f32x4 __attribute__((ext_vector_type(4)));
typedef float f32x2 __attribute__((ext_vector_type(2)));
typedef unsigned u32x4 __attribute__((ext_vector_type(4)));
typedef unsigned u32x2 __attribute__((ext_vector_type(2)));

constexpr int NB = 8, SEQ = 2048, M = NB * SEQ, DM = 1024, NL = 4, DIN = 10032, LDP = 10240, DFF = 4096;
constexpr float EPS = 1e-6f;
constexpr int P_NQ = 0, P_KC = 512, P_VC = 640, P_KS = 768, P_VS = 896, P_KW = 1024, P_VW = 1152;
constexpr int P_SQ = 1280, P_SK = 1792, P_SV = 2304;
constexpr int P_GQ = 2816, P_GK = 3072, P_GV = 3328, P_GG = 3840;
constexpr int P_FQ = 4352, P_FK = 4864, P_FV = 5376;
constexpr int P_GATE = 5888, P_NG = 9984, P_GA = 10008, P_FF = 10024;
__host__ __device__ __forceinline__ int win_src_col(int n) {
    if (n < 1280) return n;
    if (n < 3840) return n + 24;
    if (n < 5888) return n + 40;
    if (n < 9984) return n + 48;
    if (n < 10008) return n - 9984 + 1280;
    if (n < 10024) return n - 10008 + 3864;
    if (n < 10032) return n - 10024 + 5928;
    return -1;
}

constexpr size_t MiB = 1u << 20;
constexpr size_t WS_CTL = 0, CTL_BYTES = 1 * MiB;
constexpr size_t WS_WIN = 1 * MiB;
constexpr size_t WS_WB = 21 * MiB;
constexpr size_t WS_WO = 25 * MiB;
constexpr size_t WS_WF1 = 27 * MiB;
constexpr size_t WS_WF2 = 35 * MiB;
constexpr size_t WS_CW1 = 43 * MiB;
constexpr size_t WS_KC = 45 * MiB;
constexpr size_t WS_CUM = 46 * MiB;
constexpr size_t WS_CH = 47 * MiB;
constexpr size_t WS_HB = 52 * MiB;
constexpr size_t WS_MIX = 84 * MiB;
constexpr size_t WS_YS = 116 * MiB;
constexpr size_t WS_GQP = 180 * MiB;
constexpr size_t WS_GKP = 188 * MiB;
constexpr size_t WS_GKPP = 196 * MiB;
constexpr size_t WS_GDS = 204 * MiB;
constexpr size_t WS_GOI = 236 * MiB;
constexpr size_t WS_MIXF = WS_GDS;
constexpr size_t WS_PROJ = 268 * MiB;
constexpr size_t WS_HID = WS_PROJ;
constexpr size_t WS_END = 588 * MiB;

constexpr int CW_BAR = 4096;

constexpr int RING_BYTES = 131072;
constexpr int MISC_OFF = RING_BYTES;
constexpr int LDS_BYTES = 147456;
constexpr int NWAVES = 8, NTHR = 512;

__device__ __forceinline__ unsigned f2bf(float f) { unsigned u = __builtin_bit_cast(unsigned, f); return (u + 0x7fffu + ((u >> 16) & 1u)) >> 16; }
__device__ __forceinline__ unsigned pk2(float lo, float hi) { return f2bf(lo) | (f2bf(hi) << 16); }
__device__ __forceinline__ float bf2f(unsigned short b) { return __builtin_bit_cast(float, ((unsigned)b) << 16); }
__device__ __forceinline__ float bflo(unsigned w) { return __builtin_bit_cast(float, w << 16); }
__device__ __forceinline__ float bfhi(unsigned w) { return __builtin_bit_cast(float, w & 0xffff0000u); }
__device__ __forceinline__ float wave_sum(float v) {
#pragma unroll
    for (int o = 1; o < 64; o <<= 1) v += __shfl_xor(v, o);
    return v;
}
__device__ __forceinline__ float sigmoidf_(float x) { return 1.0f / (1.0f + __expf(-x)); }
__device__ __forceinline__ float softplusf_(float x) { return fmaxf(x, 0.f) + log1pf(__expf(-fabsf(x))); }
__device__ __forceinline__ float logsigmoidf_(float x) { return fminf(x, 0.f) - log1pf(__expf(-fabsf(x))); }

#define XB_TMO      128
#define XB_XCNT(j)  (256  + 64 * (j))
#define XB_XSUB(j)  (1280 + 64 * (j))
#define XB_XGEN(j)  (2304 + 64 * (j))
#define XB_TOP      3328
#define XB_TOPGEN   3392
#define XCD_BAR_WORDS 3456
#define XB_SPIN_CAP (1u << 18)
__device__ __forceinline__ unsigned xb_ld(unsigned* p)              { return __hip_atomic_load(p, __ATOMIC_RELAXED, __HIP_MEMORY_SCOPE_AGENT); }
__device__ __forceinline__ unsigned xb_add(unsigned* p, unsigned v) { return __hip_atomic_fetch_add(p, v, __ATOMIC_RELAXED, __HIP_MEMORY_SCOPE_AGENT); }
__device__ __forceinline__ unsigned xb_xcc_id() { return (unsigned)__builtin_amdgcn_s_getreg((3 << 11) | 20) & 0xFu; }
#define XB_SPIN(cond, bar) do { unsigned _sp = 0; while (cond) { __builtin_amdgcn_s_sleep(1); \
    if ((++_sp & 255u) == 0u) { if (xb_ld(&(bar)[XB_TMO])) break; if (_sp > XB_SPIN_CAP) { atomicAdd(&(bar)[XB_TMO], 1u); break; } } } } while (0)
struct XcdBarrier { unsigned* bar; unsigned x; volatile LAS unsigned* st; };
__device__ __forceinline__ XcdBarrier xcd_barrier_post(unsigned* bar, volatile LAS unsigned* st) {
    XcdBarrier b; b.bar = bar; b.x = xb_xcc_id(); b.st = st;
    if (threadIdx.x == 0) (void)xb_add(&bar[XB_XCNT(b.x)], 1u);
    return b;
}
__device__ __forceinline__ void xcd_barrier_complete(unsigned* bar, unsigned x, unsigned& nloc, unsigned& nx) {
    const unsigned G = gridDim.x * gridDim.y * gridDim.z;
    unsigned sum, cnt, mine, sp = 0u;
    for (;;) {
        sum = 0u; cnt = 0u; mine = 0u;
#pragma unroll
        for (unsigned j = 0; j < 16; ++j) { const unsigned c = xb_ld(&bar[XB_XCNT(j)]); sum += c; cnt += (c > 0u) ? 1u : 0u; mine = (j == x) ? c : mine; }
        if (sum == G) break;
        __builtin_amdgcn_s_sleep(1);
        if ((++sp & 255u) == 0u) { if (xb_ld(&bar[XB_TMO])) break; if (sp > XB_SPIN_CAP) { atomicAdd(&bar[XB_TMO], 1u); break; } }
    }
    nloc = mine > 0u ? mine : 1u; nx = cnt > 0u ? cnt : 1u;
}
__device__ __forceinline__ void xcd_barrier(const XcdBarrier& b) {
    asm volatile("s_waitcnt vmcnt(0)" ::: "memory");
    __syncthreads();
    if (threadIdx.x == 0) {
        unsigned* bar = b.bar;
        __builtin_amdgcn_s_waitcnt(0);
        unsigned nloc = b.st[0], nx = b.st[1];
        if (nloc == 0u) { xcd_barrier_complete(bar, b.x, nloc, nx); b.st[0] = nloc; b.st[1] = nx; }
        const unsigned old = xb_add(&bar[XB_XSUB(b.x)], 1u);
        const unsigned gen = old / nloc;
        if (old + 1u == (gen + 1u) * nloc) {
            __builtin_amdgcn_fence(__ATOMIC_RELEASE, "agent");
            asm volatile("s_waitcnt vmcnt(0)" ::: "memory");
            const unsigned og = xb_add(&bar[XB_TOP], 1u);
            const unsigned tg = og / nx;
            if (og + 1u == (tg + 1u) * nx) xb_add(&bar[XB_TOPGEN], 1u);
            else XB_SPIN(xb_ld(&bar[XB_TOPGEN]) == tg, bar);
            __builtin_amdgcn_fence(__ATOMIC_ACQUIRE, "agent");
            xb_add(&bar[XB_XGEN(b.x)], 1u);
            asm volatile("s_waitcnt vmcnt(0)" ::: "memory");
        } else {
            XB_SPIN(xb_ld(&bar[XB_XGEN(b.x)]) == gen, bar);
            __builtin_amdgcn_fence(__ATOMIC_ACQUIRE, "agent");
            asm volatile("s_waitcnt vmcnt(0)" ::: "memory");
        }
    }
    __syncthreads();
}

namespace pg8 {
constexpr int BM = 256, BK = 64, HALF = 128, HTB = HALF * BK * 2, STAGE_BYTES = 8 * HTB, NXCD = 8, WGM = 8;
__host__ __device__ __forceinline__ int lds_byte(int r, int c) { const int st = (r >> 4) * 2 + (c >> 5), rr = r & 15, cc = c & 31, ob = rr * 64 + cc * 2; return st * 1024 + (ob ^ (((ob >> 9) & 1) << 5)); }
__host__ __device__ __forceinline__ void stage_rc(int b, int& R, int& C) { const int st = b / 1024, sb = b % 1024, swz = sb ^ (((sb >> 9) & 1) << 5); R = (st >> 1) * 16 + swz / 64; C = (st & 1) * 32 + (swz % 64) / 2; }
__host__ __device__ __forceinline__ int perm32(int rho) { const int n = rho >> 4, i = rho & 15; return 8 * (i >> 2) + 4 * n + (i & 3); }

struct Unit { int pm, pn, z; };
struct Gemm { const bf16_t* A; const bf16_t* Bt; int lda, ldb, K; size_t zA, zB; };

struct StaticOrder {
    int nM, nN, nwg, G, c;
    __host__ __device__ void init(int M_, int N_, int G_, int c_) { nM = M_ / BM; nN = N_ / BM; nwg = nM * nN; G = G_; c = c_; }
    __host__ __device__ bool tile(long L, Unit& u) const {
        if (L >= nwg) return false;
        int wgid = (int)L; { const int q = nwg / NXCD, r = nwg % NXCD, xcd = wgid % NXCD, off = wgid / NXCD; wgid = (xcd < r ? xcd * (q + 1) : r * (q + 1) + (xcd - r) * q) + off; }
        const int nig = WGM * nN, gid = wgid / nig, fm = gid * WGM, gsz = (nM - fm) < WGM ? (nM - fm) : WGM;
        u.pm = fm + ((wgid % nig) % gsz); u.pn = (wgid % nig) / gsz; u.z = 0; return true;
    }
    __host__ __device__ bool next(int i, Unit& u) const { return tile((long)i * G + c, u); }
};
struct ZOrder : StaticOrder {
    int NZ;
    __host__ __device__ bool next(int i, Unit& u) const { const int ti = i / NZ; if (!tile((long)ti * G + c, u)) return false; u.z = i - ti * NZ; return true; }
};

__device__ __forceinline__ unsigned cvt_pk_bf16(float lo, float hi) { unsigned r; asm volatile("v_cvt_pk_bf16_f32 %0, %1, %2" : "=v"(r) : "v"(lo), "v"(hi)); return r; }

template <int ACT  > struct EpiBf16 {
    static constexpr bool PERM = true;
    bf16_t* O; int ldc;
    __device__ __forceinline__ void operator()(const f32x4 (&acc)[2][2][4][2], const Unit& u, int wr, int wc, int fr, int fq) const {
        const int row0 = u.pm * BM + wr * 64 + fr; const int col0 = u.pn * BM + wc * 32 + 8 * fq;
#pragma unroll
        for (int ai = 0; ai < 2; ++ai)
#pragma unroll
            for (int m = 0; m < 4; ++m) { bf16_t* rowp = O + (size_t)(row0 + ai * HALF + m * 16) * ldc + col0;
#pragma unroll
                for (int bj = 0; bj < 2; ++bj) { f32x4 v0 = acc[ai][bj][m][0], v1 = acc[ai][bj][m][1];
                    if (ACT == 1) {
#pragma unroll
                        for (int j = 0; j < 4; ++j) { const float a = fmaxf(v0[j], 0.f), b = fmaxf(v1[j], 0.f); v0[j] = a * a; v1[j] = b * b; } }
                    u32x4 w; w.x = cvt_pk_bf16(v0[0], v0[1]); w.y = cvt_pk_bf16(v0[2], v0[3]); w.z = cvt_pk_bf16(v1[0], v1[1]); w.w = cvt_pk_bf16(v1[2], v1[3]);
                    *(u32x4*)(rowp + bj * HALF) = w; } }
    }
};
struct EpiRes {
    static constexpr bool PERM = false;
    const float* base; float* out; int ldc;
    __device__ __forceinline__ void operator()(const f32x4 (&acc)[2][2][4][2], const Unit& u, int wr, int wc, int fr, int fq) const {
        const int row0 = u.pm * BM + wr * 64 + fr, col0 = u.pn * BM + wc * 32 + 4 * fq;
#pragma unroll
        for (int ai = 0; ai < 2; ++ai)
#pragma unroll
            for (int m = 0; m < 4; ++m) { const size_t off = (size_t)(row0 + ai * HALF + m * 16) * ldc + col0;
#pragma unroll
                for (int bj = 0; bj < 2; ++bj)
#pragma unroll
                    for (int n = 0; n < 2; ++n) { const f32x4 bs = *(const f32x4*)(base + off + bj * HALF + n * 16); *(f32x4*)(out + off + bj * HALF + n * 16) = bs + acc[ai][bj][m][n]; } }
    }
};
struct EpiGate {
    static constexpr bool PERM = false;
    const bf16_t* proj; const float* b_gate; float* mixf; bf16_t* mix;
    __device__ __forceinline__ void operator()(const f32x4 (&acc)[2][2][4][2], const Unit& u, int wr, int wc, int fr, int fq) const {
        const int row0 = u.pm * BM + wr * 64 + fr, col0 = u.pn * BM + wc * 32 + 4 * fq; const int z = u.z;
#pragma unroll
        for (int ai = 0; ai < 2; ++ai)
#pragma unroll
            for (int m = 0; m < 4; ++m) { const int row = row0 + ai * HALF + m * 16;
#pragma unroll
                for (int bj = 0; bj < 2; ++bj)
#pragma unroll
                    for (int n = 0; n < 2; ++n) { const int col = col0 + bj * HALF + n * 16;
                        const u32x2 gl = *(const u32x2*)(proj + (size_t)row * LDP + P_GATE + z * DM + col);
                        const f32x4 bg = *(const f32x4*)(b_gate + z * DM + col);
                        f32x4 t; t[0] = sigmoidf_(bflo(gl.x) + bg[0]) * acc[ai][bj][m][n][0]; t[1] = sigmoidf_(bfhi(gl.x) + bg[1]) * acc[ai][bj][m][n][1];
                        t[2] = sigmoidf_(bflo(gl.y) + bg[2]) * acc[ai][bj][m][n][2]; t[3] = sigmoidf_(bfhi(gl.y) + bg[3]) * acc[ai][bj][m][n][3];
                        float* mp = mixf + (size_t)row * DM + col;
                        if (z > 0) t += *(const f32x4*)mp;
                        if (z < 3) *(f32x4*)mp = t;
                        else { u32x2 w; w.x = cvt_pk_bf16(t[0], t[1]); w.y = cvt_pk_bf16(t[2], t[3]); *(u32x2*)(mix + (size_t)row * DM + col) = w; } } }
    }
};

template <class Epi, class Sched>
__device__ __forceinline__ void gemm_phase(LAS unsigned char* lds, const Gemm g, const Sched& S, const Epi& E) {
    int tid_ = threadIdx.x; asm volatile("" : "+v"(tid_));
    const int tid = tid_, wid = __builtin_amdgcn_readfirstlane(tid >> 6), lane = tid & 63, wr = wid >> 2, wc = wid & 3, fr = lane & 15, fq = lane >> 4;
    const int K = g.K, nt = K / BK;
    unsigned voffA[2], voffB[2];
#pragma unroll
    for (int i = 0; i < 2; ++i) { int R, C; stage_rc(tid * 16 + i * 8192, R, C); const int Rb = Epi::PERM ? ((R & ~31) + perm32(R & 31)) : R;
        voffA[i] = (unsigned)(R * g.lda + C) * 2u; voffB[i] = (unsigned)(Rb * g.ldb + C) * 2u; }
    const size_t kstep = (size_t)(BK * 2);
    const size_t hstepA = (size_t)HALF * g.lda * 2, hstepB = (size_t)HALF * g.ldb * 2;
    const unsigned ldsw = (unsigned)wid * 1024u;
    const int aoff = lds_byte(wr * 64 + fr, fq * 8), boff = lds_byte(wc * 32 + fr, fq * 8);
#define PG8_SA(b, h) (((b) * 2 + (h)) * HTB)
#define PG8_SB(b, h) ((4 + (b) * 2 + (h)) * HTB)
#define PG8_STAGE(bufoff, gbase, voff) do { _Pragma("unroll") for (int _i = 0; _i < 2; ++_i) \
        __builtin_amdgcn_global_load_lds((const unsigned*)((const char*)(gbase) + (voff)[_i]), (LAS unsigned*)(lds + (bufoff) + ldsw + _i * 8192), 16, 0, 0); } while (0)
#define PG8_LDA(dst, b, h) do { _Pragma("unroll") for (int m = 0; m < 4; ++m) _Pragma("unroll") for (int k = 0; k < 2; ++k) dst[m][k] = *(const LAS bf16x8*)(lds + PG8_SA(b, h) + aoff + m * 2048 + k * 1024); } while (0)
#define PG8_LDB(dst, b, h) do { _Pragma("unroll") for (int n = 0; n < 2; ++n) _Pragma("unroll") for (int k = 0; k < 2; ++k) dst[n][k] = *(const LAS bf16x8*)(lds + PG8_SB(b, h) + boff + n * 2048 + k * 1024); } while (0)
#define PG8_MMA(ai, bj, At, Bt) do { __builtin_amdgcn_s_setprio(1); _Pragma("unroll") for (int m = 0; m < 4; ++m) _Pragma("unroll") for (int n = 0; n < 2; ++n) _Pragma("unroll") for (int k = 0; k < 2; ++k) \
        acc[ai][bj][m][n] = __builtin_amdgcn_mfma_f32_16x16x32_bf16(Bt[n][k], At[m][k], acc[ai][bj][m][n], 0, 0, 0); __builtin_amdgcn_s_setprio(0); } while (0)
#define PG8_WAIT_V(n) asm volatile("s_waitcnt vmcnt(" #n ")" ::: "memory")
#define PG8_WAIT_L(n) asm volatile("s_waitcnt lgkmcnt(" #n ")" ::: "memory")
#define PG8_BAR __builtin_amdgcn_s_barrier()
#define PG8_SCHED __builtin_amdgcn_sched_barrier(0)
#define PG8_APTR(u) ((const char*)g.A + ((size_t)(u).z * g.zA) * 2 + (size_t)(u).pm * 2 * hstepA)
#define PG8_BPTR(u) ((const char*)g.Bt + ((size_t)(u).z * g.zB) * 2 + (size_t)(u).pn * 2 * hstepB)
    Unit cur, nxt; int ui = 0;
    if (!S.next(0, cur)) return;
    f32x4 acc[2][2][4][2];
#pragma unroll
    for (int a = 0; a < 2; ++a)
#pragma unroll
        for (int b = 0; b < 2; ++b)
#pragma unroll
            for (int m = 0; m < 4; ++m)
#pragma unroll
                for (int n = 0; n < 2; ++n) acc[a][b][m][n] = (f32x4){0.f, 0.f, 0.f, 0.f};
    bf16x8 At[4][2], B0[2][2], B1[2][2];
    const char* cA = PG8_APTR(cur); const char* cB = PG8_BPTR(cur);
    PG8_STAGE(PG8_SB(0, 0), cB, voffB); PG8_STAGE(PG8_SA(0, 0), cA, voffA); PG8_STAGE(PG8_SB(0, 1), cB + hstepB, voffB); PG8_STAGE(PG8_SA(0, 1), cA + hstepA, voffA);
    if (wr == 1) PG8_BAR;
    PG8_WAIT_V(4); PG8_BAR;
    PG8_STAGE(PG8_SB(1, 0), cB + kstep, voffB); PG8_STAGE(PG8_SA(1, 0), cA + kstep, voffA); PG8_STAGE(PG8_SB(1, 1), cB + hstepB + kstep, voffB);
    PG8_WAIT_V(6); PG8_BAR;
    for (;;) {
        const bool has_next = S.next(ui + 1, nxt);
        const char* nA = has_next ? PG8_APTR(nxt) : cA; const char* nB = has_next ? PG8_BPTR(nxt) : cB;
        for (int t = 0; t < nt; t += 2) {
            const bool last = (t == nt - 2);
            const char* a1 = cA + (size_t)(t + 1) * kstep;
            const char* a2 = last ? nA : cA + (size_t)(t + 2) * kstep; const char* b2 = last ? nB : cB + (size_t)(t + 2) * kstep;
            const char* a3 = a2 + kstep; const char* b3 = b2 + kstep;
            PG8_LDB(B0, 0, 0); PG8_SCHED; PG8_LDA(At, 0, 0); PG8_STAGE(PG8_SA(1, 1), a1 + hstepA, voffA);
            PG8_WAIT_L(8); PG8_BAR; PG8_WAIT_L(0); PG8_MMA(0, 0, At, B0); PG8_BAR; PG8_SCHED;
            PG8_LDB(B1, 0, 1); PG8_STAGE(PG8_SB(0, 0), b2, voffB);
            PG8_BAR; PG8_WAIT_L(0); PG8_MMA(0, 1, At, B1); PG8_BAR;
            PG8_LDA(At, 0, 1); PG8_STAGE(PG8_SA(0, 0), a2, voffA);
            PG8_BAR; PG8_WAIT_L(0); PG8_MMA(1, 0, At, B0); PG8_BAR; PG8_SCHED;
            PG8_STAGE(PG8_SB(0, 1), b2 + hstepB, voffB);
            PG8_WAIT_V(6); PG8_BAR; PG8_MMA(1, 1, At, B1); PG8_BAR;
            PG8_LDB(B0, 1, 0); PG8_SCHED; PG8_LDA(At, 1, 0); PG8_STAGE(PG8_SA(0, 1), a2 + hstepA, voffA);
            PG8_WAIT_L(8); PG8_BAR; PG8_WAIT_L(0); PG8_MMA(0, 0, At, B0); PG8_BAR; PG8_SCHED;
            PG8_LDB(B1, 1, 1); PG8_STAGE(PG8_SB(1, 0), b3, voffB);
            PG8_BAR; PG8_WAIT_L(0); PG8_MMA(0, 1, At, B1); PG8_BAR;
            PG8_LDA(At, 1, 1); PG8_STAGE(PG8_SA(1, 0), a3, voffA);
            PG8_BAR; PG8_WAIT_L(0); PG8_MMA(1, 0, At, B0); PG8_BAR; PG8_SCHED;
            PG8_STAGE(PG8_SB(1, 1), b3 + hstepB, voffB);
            PG8_WAIT_V(6); PG8_BAR; PG8_MMA(1, 1, At, B1); PG8_BAR;
        }
        E(acc, cur, wr, wc, fr, fq);
        if (!has_next) break;
#pragma unroll
        for (int a = 0; a < 2; ++a)
#pragma unroll
            for (int b = 0; b < 2; ++b)
#pragma unroll
                for (int m = 0; m < 4; ++m)
#pragma unroll
                    for (int n = 0; n < 2; ++n) acc[a][b][m][n] = (f32x4){0.f, 0.f, 0.f, 0.f};
        cur = nxt; cA = nA; cB = nB; ++ui;
    }
    PG8_WAIT_V(0);
    if (wr == 0) PG8_BAR;
    PG8_BAR;
#undef PG8_SA
#undef PG8_SB
#undef PG8_STAGE
#undef PG8_LDA
#undef PG8_LDB
#undef PG8_MMA
#undef PG8_WAIT_V
#undef PG8_WAIT_L
#undef PG8_BAR
#undef PG8_SCHED
#undef PG8_APTR
#undef PG8_BPTR
}
}

struct Args {
    const float* x; const int* pos; const float* norm_mix; const float* w_in; const float* b_gate;
    const float* cmp_pos_k; const float* cmp_pos_v; const float* cmp_wk1; const float* cmp_wk2; const float* cmp_wv1; const float* cmp_wv2;
    const float* gla_w_alpha; const float* gla_b_alpha; const float* gla_norm; const float* fox_b_f;
    const float* w_branch; const float* w_out; const float* norm_ff; const float* w_ff1; const float* w_ff2; const float* norm_final;
    float* out; unsigned char* ws;
    int l_lo, l_hi, p_lo, p_hi, do_final, pad;
};

struct Ctx { LAS unsigned char* lds; int tid, lane, wave, G, bid, gw, NGW; };
__device__ __forceinline__ Ctx make_ctx(LAS unsigned char* lds) {
    Ctx C; int t = threadIdx.x; asm volatile("" : "+v"(t));
    C.lds = lds; C.tid = t; C.lane = t & 63; C.wave = __builtin_amdgcn_readfirstlane(t >> 6); C.G = gridDim.x; C.bid = blockIdx.x; C.gw = C.bid * NWAVES + C.wave; C.NGW = C.G * NWAVES; return C;
}

template <bool MAP>
__device__ __forceinline__ void transpose_item(const float* W, int Nsrc, int Kdim, bf16_t* WT, LAS float* scr, int k0, int n0, int lane) {
    const int nn = n0 + (lane & 31); const int sc = MAP ? win_src_col(nn) : nn;
#pragma unroll 8
    for (int i = 0; i < 32; ++i) { const int kk = 2 * i + (lane >> 5); scr[kk * 33 + (lane & 31)] = (sc >= 0) ? W[(size_t)(k0 + kk) * Nsrc + sc] : 0.f; }
    asm volatile("s_waitcnt lgkmcnt(0)" ::: "memory");
    const int c = lane & 7;
#pragma unroll
    for (int j = 0; j < 4; ++j) { const int n = (lane >> 3) + 8 * j; const LAS float* s = scr + (8 * c) * 33 + n;
        u32x4 o; o.x = pk2(s[0 * 33], s[1 * 33]); o.y = pk2(s[2 * 33], s[3 * 33]); o.z = pk2(s[4 * 33], s[5 * 33]); o.w = pk2(s[6 * 33], s[7 * 33]);
        *(u32x4*)(WT + (size_t)(n0 + n) * Kdim + k0 + 8 * c) = o; }
    asm volatile("s_waitcnt lgkmcnt(0)" ::: "memory");
}
template <bool MAP>
__device__ __forceinline__ void transpose_matrix(const Ctx& C, const float* W, int Kdim, int Nsrc, int Ndst, bf16_t* WT, int& base) {
    LAS float* scr = (LAS float*)(C.lds + C.wave * 16384);
    const int nblk = Ndst / 32, items = (Kdim / 64) * nblk;
    int first = (C.gw - base % C.NGW + C.NGW) % C.NGW;
    for (int it = first; it < items; it += C.NGW) { const int kb = it / nblk, nb = it % nblk; transpose_item<MAP>(W, Nsrc, Kdim, WT, scr, 64 * kb, 32 * nb, C.lane); }
    base += items;
}
__device__ __forceinline__ void rms_row_bf16(const float* xrow, const float* g, bf16_t* orow, int lane) {
    const f32x4* xr = (const f32x4*)xrow + lane; const f32x4* gr = (const f32x4*)g + lane;
    f32x4 v[4]; float s = 0.f;
#pragma unroll
    for (int j = 0; j < 4; ++j) { v[j] = xr[64 * j]; s += (v[j].x * v[j].x + v[j].y * v[j].y) + (v[j].z * v[j].z + v[j].w * v[j].w); }
    const float r = rsqrtf(wave_sum(s) * (1.f / DM) + EPS);
    unsigned long long* o8 = (unsigned long long*)orow + lane;
#pragma unroll
    for (int j = 0; j < 4; ++j) { const f32x4 gg = gr[64 * j];
        o8[64 * j] = (unsigned long long)pk2(v[j].x * r * gg.x, v[j].y * r * gg.y) | ((unsigned long long)pk2(v[j].z * r * gg.z, v[j].w * r * gg.w) << 32); }
}
__device__ __forceinline__ void rms_rows_phase(const Ctx& C, const float* x, const float* g, bf16_t* hb) {
    for (int m = C.gw; m < M; m += C.NGW) rms_row_bf16(x + (size_t)m * DM, g, hb + (size_t)m * DM, C.lane);
}
__device__ __forceinline__ void final_norm_phase(const Ctx& C, float* x, const float* g) {
    for (int m = C.gw; m < M; m += C.NGW) {
        f32x4* xr = (f32x4*)(x + (size_t)m * DM) + C.lane; const f32x4* gr = (const f32x4*)g + C.lane;
        f32x4 v[4]; float s = 0.f;
#pragma unroll
        for (int j = 0; j < 4; ++j) { v[j] = xr[64 * j]; s += (v[j].x * v[j].x + v[j].y * v[j].y) + (v[j].z * v[j].z + v[j].w * v[j].w); }
        const float r = rsqrtf(wave_sum(s) * (1.f / DM) + EPS);
#pragma unroll
        for (int j = 0; j < 4; ++j) xr[64 * j] = v[j] * r * gr[64 * j];
    }
}

__device__ __forceinline__ void ld8(const bf16_t* p, float (&o)[8]) {
    const u32x4 w = *(const u32x4*)p;
    o[0] = bflo(w.x); o[1] = bfhi(w.x); o[2] = bflo(w.y); o[3] = bfhi(w.y); o[4] = bflo(w.z); o[5] = bfhi(w.z); o[6] = bflo(w.w); o[7] = bfhi(w.w);
}
__device__ __forceinline__ float dot64(const float (&q)[64], const bf16_t* k) {
    float s = 0.f;
#pragma unroll
    for (int c = 0; c < 8; ++c) { float kv[8]; ld8(k + 8 * c, kv);
#pragma unroll
        for (int j = 0; j < 8; ++j) s += q[8 * c + j] * kv[j]; }
    return s;
}
__device__ __forceinline__ void axpy64(float (&acc)[64], float p, const bf16_t* v) {
#pragma unroll
    for (int c = 0; c < 8; ++c) { float vv[8]; ld8(v + 8 * c, vv);
#pragma unroll
        for (int j = 0; j < 8; ++j) acc[8 * c + j] += p * vv[j]; }
}
__device__ __forceinline__ void ldq64(float (&q)[64], const bf16_t* p, float scale) {
#pragma unroll
    for (int c = 0; c < 8; ++c) { float t[8]; ld8(p + 8 * c, t);
#pragma unroll
        for (int j = 0; j < 8; ++j) q[8 * c + j] = t[j] * scale; }
}
struct OS { float m, l; };
#define OS_STEP(sc) do { const float mn_ = fmaxf(st.m, (sc)); const float al_ = __expf(st.m - mn_); const float p_ = __expf((sc) - mn_); st.l = st.l * al_ + p_; \
    _Pragma("unroll") for (int d_ = 0; d_ < 64; ++d_) acc[d_] *= al_; axpy64(acc, p_, vrow); st.m = mn_; } while (0)

__device__ __forceinline__ void rope_rotate(bf16_t* p, int posv) {
    u32x4 a = *(u32x4*)p, b = *(u32x4*)(p + 8);
    float x1[8] = {bflo(a.x), bfhi(a.x), bflo(a.y), bfhi(a.y), bflo(a.z), bfhi(a.z), bflo(a.w), bfhi(a.w)};
    float x2[8] = {bflo(b.x), bfhi(b.x), bflo(b.y), bfhi(b.y), bflo(b.z), bfhi(b.z), bflo(b.w), bfhi(b.w)};
    float o1[8], o2[8];
#pragma unroll
    for (int i = 0; i < 8; ++i) { const float inv = powf(500000.0f, -(float)(2 * i) / 16.0f); const float ang = (float)posv * inv; float sn, cs; sincosf(ang, &sn, &cs);
        o1[i] = x1[i] * cs - x2[i] * sn; o2[i] = x2[i] * cs + x1[i] * sn; }
    a.x = pk2(o1[0], o1[1]); a.y = pk2(o1[2], o1[3]); a.z = pk2(o1[4], o1[5]); a.w = pk2(o1[6], o1[7]);
    b.x = pk2(o2[0], o2[1]); b.y = pk2(o2[2], o2[3]); b.z = pk2(o2[4], o2[5]); b.w = pk2(o2[6], o2[7]);
    *(u32x4*)p = a; *(u32x4*)(p + 8) = b;
}
__device__ __forceinline__ float gelu_tanh(float x) { const float u = 0.7978845608028654f * (x + 0.044715f * x * x * x); return 0.5f * x * (1.0f + tanhf(u)); }

__device__ __forceinline__ void naive_prepA(const Ctx& C, const Args& a, int l, bf16_t* proj, float* cum, float* ch) {
    const int gt = C.bid * NTHR + C.tid, NT = C.G * NTHR;
    for (int i = gt; i < M * 12; i += NT) { const int tok = i / 12, j = i % 12; const int col = j < 8 ? P_NQ + j * 64 : (j < 10 ? P_KS + (j - 8) * 64 : P_KW + (j - 10) * 64);
        rope_rotate(proj + (size_t)tok * LDP + col, a.pos[tok]); }
    for (int bh = C.gw; bh < NB * 8; bh += C.NGW) { const int b = bh >> 3, h = bh & 7; const float bf = a.fox_b_f[l * 8 + h];
        float loc[32]; float run = 0.f;
#pragma unroll
        for (int i = 0; i < 32; ++i) { const int s = C.lane * 32 + i; const float f = bf2f(proj[(size_t)(b * SEQ + s) * LDP + P_FF + h]); run += logsigmoidf_(f + bf); loc[i] = run; }
        float incl = run;
#pragma unroll
        for (int o = 1; o < 64; o <<= 1) { const float t = __shfl_up(incl, o); if (C.lane >= o) incl += t; }
        const float excl = incl - run;
#pragma unroll
        for (int i = 0; i < 32; ++i) cum[(size_t)bh * SEQ + C.lane * 32 + i] = excl + loc[i]; }
    const int NCH = 2 * NB * 127 * 2 * 256;
    for (int i = gt; i < NCH; i += NT) { const int j = i & 255; int r = i >> 8; const int g = r & 1; r >>= 1; const int c = r % 127; r /= 127; const int b = r % NB; const int kv = r / NB;
        const float* w1 = (kv ? a.cmp_wv1 : a.cmp_wk1) + (size_t)l * 2048 * 256; const float* pe = (kv ? a.cmp_pos_v : a.cmp_pos_k) + (size_t)l * 32 * 64;
        const int col = (kv ? P_VC : P_KC) + g * 64; float s = 0.f;
        for (int ll = 0; ll < 32; ++ll) { const bf16_t* xr = proj + (size_t)(b * SEQ + 16 * c + ll) * LDP + col;
            for (int d8 = 0; d8 < 8; ++d8) { float xv[8]; ld8(xr + 8 * d8, xv);
#pragma unroll
                for (int d = 0; d < 8; ++d) s += (xv[d] + pe[ll * 64 + d8 * 8 + d]) * w1[(size_t)(ll * 64 + d8 * 8 + d) * 256 + j]; } }
        ch[i] = gelu_tanh(s); }
}
__device__ __forceinline__ void naive_prepB(const Ctx& C, const Args& a, int l, const float* ch, bf16_t* kcvc) {
    const int gt = C.bid * NTHR + C.tid, NT = C.G * NTHR; const int NO = 2 * NB * 127 * 2 * 64;
    for (int i = gt; i < 2 * NB * 128; i += NT) { const int kv = i / (NB * 128), b = (i / 128) % NB, e = i % 128; kcvc[((((size_t)kv * NB + b) * 128 + 127) * 2) * 64 + e] = 0; }
    for (int i = gt; i < NO; i += NT) { const int d = i & 63; int r = i >> 6; const int g = r & 1; r >>= 1; const int c = r % 127; r /= 127; const int b = r % NB; const int kv = r / NB;
        const float* w2 = (kv ? a.cmp_wv2 : a.cmp_wk2) + (size_t)l * 256 * 64; const float* hrow = ch + ((((size_t)kv * NB + b) * 127 + c) * 2 + g) * 256;
        float v = 0.f, vp = 0.f; const int dp = (d < 8) ? d + 8 : d - 8;
        for (int j = 0; j < 256; ++j) { const float hv = hrow[j]; v += hv * w2[j * 64 + d]; if (d < 16) vp += hv * w2[j * 64 + dp]; }
        if (kv == 0 && d < 16) { const int i8 = d & 7; const float inv = powf(500000.0f, -(float)(2 * i8) / 16.0f); const float ang = (float)a.pos[b * SEQ + 16 * c + 31] * inv; float sn, cs; sincosf(ang, &sn, &cs);
            v = (d < 8) ? (v * cs - vp * sn) : (v * cs + vp * sn); }
        kcvc[((((size_t)kv * NB + b) * 128 + c) * 2 + g) * 64 + d] = (bf16_t)f2bf(v); }
}

__device__ __forceinline__ void naive_fox(const Ctx& C, const bf16_t* proj, const float* cum, bf16_t* ys) {
    for (int blk = C.bid; blk < NB * 8 * 4; blk += C.G) { const int bh = blk >> 2, b = bh >> 3, h = bh & 7; const int t = (blk & 3) * 512 + C.tid;
        const size_t rowb = (size_t)b * SEQ; float q[64]; ldq64(q, proj + (rowb + t) * LDP + P_FQ + h * 64, 0.125f);
        const float ct = cum[(size_t)bh * SEQ + t]; float acc[64];
#pragma unroll
        for (int d = 0; d < 64; ++d) acc[d] = 0.f;
        OS st; st.m = -1e30f; st.l = 0.f; const int tmax = t | 63;
        for (int s = 0; s <= tmax; ++s) { const bf16_t* krow = proj + (rowb + s) * LDP + P_FK + h * 64; const bf16_t* vrow = proj + (rowb + s) * LDP + P_FV + h * 64;
            if (s <= t) { const float sc = dot64(q, krow) + ct - cum[(size_t)bh * SEQ + s]; OS_STEP(sc); } }
        const float il = 1.f / st.l; bf16_t* o = ys + ((size_t)3 * M + rowb + t) * 512 + h * 64;
#pragma unroll
        for (int d = 0; d < 64; d += 2) *(unsigned*)(o + d) = pk2(acc[d] * il, acc[d + 1] * il); }
}
__device__ __forceinline__ void naive_sb(const Ctx& C, const bf16_t* proj, bf16_t* ys) {
    for (int blk = C.bid; blk < NB * 8 * 4; blk += C.G) { const int bh = blk >> 2, b = bh >> 3, h = bh & 7; const int t = (blk & 3) * 512 + C.tid;
        const size_t rowb = (size_t)b * SEQ; float q[64]; ldq64(q, proj + (rowb + t) * LDP + P_SQ + h * 64, 0.125f);
        float acc[64];
#pragma unroll
        for (int d = 0; d < 64; ++d) acc[d] = 0.f;
        float R = 0.f; const int tmax = t | 63;
        for (int s = tmax - 1; s >= 0; --s) { const bf16_t* krow = proj + (rowb + s) * LDP + P_SK + h * 64; const bf16_t* vrow = proj + (rowb + s) * LDP + P_SV + h * 64;
            if (s < t) { const float z = dot64(q, krow); const float sp = softplusf_(z); const float av = __expf(z - sp - R); axpy64(acc, av, vrow); R += sp; } }
        bf16_t* o = ys + ((size_t)1 * M + rowb + t) * 512 + h * 64;
#pragma unroll
        for (int d = 0; d < 64; d += 2) *(unsigned*)(o + d) = pk2(acc[d], acc[d + 1]); }
}
__device__ __forceinline__ void naive_gla(const Ctx& C, const Args& a, int l, const bf16_t* proj, float* obuf, bf16_t* ys) {
    LAS float* red = (LAS float*)C.lds;
    for (int bh = C.bid; bh < NB * 4; bh += C.G) { const int b = bh >> 2, h = bh & 3; const int kk = C.tid >> 3, vs = C.tid & 7; const size_t rowb = (size_t)b * SEQ;
        float wa[16];
#pragma unroll
        for (int r = 0; r < 16; ++r) wa[r] = a.gla_w_alpha[(size_t)l * 16 * 256 + r * 256 + h * 64 + kk];
        const float ba = a.gla_b_alpha[l * 256 + h * 64 + kk];
        float stt[16];
#pragma unroll
        for (int i = 0; i < 16; ++i) stt[i] = 0.f;
        for (int t = 0; t < SEQ; ++t) { const bf16_t* pr = proj + (rowb + t) * LDP;
            float al[16]; { float t0[8], t1[8]; ld8(pr + P_GA, t0); ld8(pr + P_GA + 8, t1);
#pragma unroll
                for (int r = 0; r < 8; ++r) { al[r] = t0[r]; al[8 + r] = t1[r]; } }
            float xa = ba;
#pragma unroll
            for (int r = 0; r < 16; ++r) xa += al[r] * wa[r];
            const float dec = __expf(logsigmoidf_(xa) * (1.0f / 16.0f));
            const float kv = bf2f(pr[P_GK + h * 64 + kk]), qv = bf2f(pr[P_GQ + h * 64 + kk]) * 0.125f;
            float vv[16]; { float t0[8], t1[8]; ld8(pr + P_GV + h * 128 + vs * 16, t0); ld8(pr + P_GV + h * 128 + vs * 16 + 8, t1);
#pragma unroll
                for (int r = 0; r < 8; ++r) { vv[r] = t0[r]; vv[8 + r] = t1[r]; } }
            float po[16];
#pragma unroll
            for (int i = 0; i < 16; ++i) { stt[i] = dec * stt[i] + kv * vv[i]; po[i] = qv * stt[i]; }
#pragma unroll
            for (int i = 0; i < 16; ++i) { po[i] += __shfl_xor(po[i], 8); po[i] += __shfl_xor(po[i], 16); po[i] += __shfl_xor(po[i], 32); }
            LAS float* rb = red + (t & 1) * 1024 + C.wave * 128;
            if (C.lane < 8) {
#pragma unroll
                for (int i = 0; i < 16; ++i) rb[C.lane * 16 + i] = po[i]; }
            __syncthreads();
            if (C.tid < 128) { float s = 0.f;
#pragma unroll
                for (int w = 0; w < 8; ++w) s += red[(t & 1) * 1024 + w * 128 + C.tid];
                obuf[(rowb + t) * 512 + h * 128 + C.tid] = s; } }
        __syncthreads();
        for (int t = C.wave; t < SEQ; t += NWAVES) { const float* orow = obuf + (rowb + t) * 512 + h * 128; const float o0 = orow[C.lane], o1 = orow[C.lane + 64];
            const float ss = wave_sum(o0 * o0 + o1 * o1); const float r = rsqrtf(ss * (1.f / 128.f) + EPS);
            const bf16_t* gp = proj + (rowb + t) * LDP + P_GG + h * 128; const float g0 = bf2f(gp[C.lane]), g1 = bf2f(gp[C.lane + 64]);
            const float n0 = a.gla_norm[l * 128 + C.lane], n1 = a.gla_norm[l * 128 + C.lane + 64];
            bf16_t* yo = ys + ((size_t)2 * M + rowb + t) * 512 + h * 128;
            yo[C.lane] = (bf16_t)f2bf(o0 * r * n0 * (g0 * sigmoidf_(g0))); yo[C.lane + 64] = (bf16_t)f2bf(o1 * r * n1 * (g1 * sigmoidf_(g1))); }
        __syncthreads(); }
}
__device__ __forceinline__ void naive_nsa(const Ctx& C, const bf16_t* proj, const bf16_t* kcvc, float* yf, bf16_t* ys) {
    LAS float* imp = (LAS float*)C.lds;
    for (int blk = C.bid; blk < NB * 2 * 4; blk += C.G) { const int bg = blk >> 2, b = bg >> 1, g = bg & 1; const int t = (blk & 3) * 512 + C.tid; const size_t rowb = (size_t)b * SEQ;
        const bf16_t* prow = proj + (rowb + t) * LDP;
#pragma unroll
        for (int j = 0; j < 32; ++j) imp[j * 512 + C.tid] = 0.f;
        const int ncv = (t >= 31) ? ((t - 31) / 16 + 1) : 0; const int tw = t | 63; const int ncv_w = (tw >= 31) ? ((tw - 31) / 16 + 1) : 0;
        const bf16_t* kc = kcvc + (((size_t)0 * NB + b) * 128 * 2 + g) * 64; const bf16_t* vc = kcvc + (((size_t)1 * NB + b) * 128 * 2 + g) * 64;
        for (int hp = 0; hp < 4; ++hp) { const int h = g * 4 + hp; float q[64]; ldq64(q, prow + P_NQ + h * 64, 0.125f);
            float m = -1e30f, lsum = 0.f;
            for (int c = 0; c < ncv_w; ++c) if (c < ncv) { const float sc = dot64(q, kc + (size_t)c * 128); const float mn = fmaxf(m, sc); lsum = lsum * __expf(m - mn) + __expf(sc - mn); m = mn; }
            float acc[64];
#pragma unroll
            for (int d = 0; d < 64; ++d) acc[d] = 0.f;
            const float il = (ncv > 0) ? 1.f / lsum : 0.f;
            for (int c = 0; c < ncv_w; ++c) if (c < ncv) { const float sc = dot64(q, kc + (size_t)c * 128); const float p = __expf(sc - m) * il; axpy64(acc, p, vc + (size_t)c * 128);
                const int j = c >> 2, r = c & 3;
                if (r < 3) imp[j * 512 + C.tid] += p; else { imp[j * 512 + C.tid] += 0.5f * p; imp[(j + 1) * 512 + C.tid] += 0.5f * p; } }
            const float gc = sigmoidf_(bf2f(prow[P_NG + h * 3 + 0])); float* yo = yf + (rowb + t) * 512 + h * 64;
#pragma unroll
            for (int d = 0; d < 64; ++d) yo[d] = gc * acc[d]; }
        const int jt = t >> 6;
#pragma unroll
        for (int j = 0; j < 32; ++j) { float v = imp[j * 512 + C.tid]; if (j == 0 || j == jt) v = __builtin_inff(); else if (64 * j > t) v = -__builtin_inff(); imp[j * 512 + C.tid] = v; }
        unsigned sel = 0u;
        for (int j = 0; j < 32; ++j) { const float vj = imp[j * 512 + C.tid]; int rank = 0;
            for (int j2 = 0; j2 < 32; ++j2) { const float v2 = imp[j2 * 512 + C.tid]; rank += (v2 > vj || (v2 == vj && j2 < j)) ? 1 : 0; }
            if (rank < 8) sel |= (1u << j); }
        const int twmin = t & ~63;
        for (int hp = 0; hp < 4; ++hp) { const int h = g * 4 + hp; float q[64]; ldq64(q, prow + P_NQ + h * 64, 0.125f);
            float* yo = yf + (rowb + t) * 512 + h * 64;
            { float acc[64];
#pragma unroll
              for (int d = 0; d < 64; ++d) acc[d] = 0.f;
              OS st; st.m = -1e30f; st.l = 0.f;
              for (int s = 0; s <= tw; ++s) { if (s <= t && ((sel >> (s >> 6)) & 1u)) { const bf16_t* krow = proj + (rowb + s) * LDP + P_KS + g * 64; const bf16_t* vrow = proj + (rowb + s) * LDP + P_VS + g * 64;
                    const float sc = dot64(q, krow); OS_STEP(sc); } }
              const float gs = sigmoidf_(bf2f(prow[P_NG + h * 3 + 1])) / st.l;
#pragma unroll
              for (int d = 0; d < 64; ++d) yo[d] += gs * acc[d]; }
            { float acc[64];
#pragma unroll
              for (int d = 0; d < 64; ++d) acc[d] = 0.f;
              OS st; st.m = -1e30f; st.l = 0.f; const int slo = (twmin - 255) > 0 ? (twmin - 255) : 0;
              for (int s = slo; s <= tw; ++s) { if (s <= t && s > t - 256) { const bf16_t* krow = proj + (rowb + s) * LDP + P_KW + g * 64; const bf16_t* vrow = proj + (rowb + s) * LDP + P_VW + g * 64;
                    const float sc = dot64(q, krow); OS_STEP(sc); } }
              const float gw = sigmoidf_(bf2f(prow[P_NG + h * 3 + 2])) / st.l; bf16_t* o = ys + ((size_t)0 * M + rowb + t) * 512 + h * 64;
#pragma unroll
              for (int d = 0; d < 64; d += 2) *(unsigned*)(o + d) = pk2(yo[d] + gw * acc[d], yo[d + 1] + gw * acc[d + 1]); } }
        __syncthreads(); }
}

namespace att {
typedef float f32x16 __attribute__((ext_vector_type(16)));
typedef short s16x4 __attribute__((ext_vector_type(4)));
constexpr float LOG2E = 1.4426950408889634f;
constexpr float CS = 0.125f * LOG2E;
constexpr int SLOT = 16384;
constexpr int L_RING = 0, L_WSF = 32768, L_OST = 34816, L_X = 67584;
__device__ __forceinline__ int crow(int r, int hi) { return (r & 3) + 8 * (r >> 2) + 4 * hi; }
__device__ __forceinline__ unsigned cvtpk(float lo, float hi) { unsigned r; asm volatile("v_cvt_pk_bf16_f32 %0, %1, %2" : "=v"(r) : "v"(lo), "v"(hi)); return r; }
__device__ __forceinline__ float swap_half(float v) { return __shfl_xor(v, 32); }

__device__ __forceinline__ void dma_kv(LAS unsigned char* slot, const bf16_t* kbase, const bf16_t* vbase, int pitch, int wid, int lane) {
    const bf16_t* ks = kbase + (size_t)lane * pitch + wid * 8;
    const bf16_t* vs = vbase + (size_t)(16 * (wid & 3) + (lane >> 2)) * pitch + (wid >> 2) * 32 + (lane & 3) * 8;
    __builtin_amdgcn_global_load_lds((const unsigned*)ks, (LAS unsigned*)(slot + wid * 1024), 16, 0, 0);
    __builtin_amdgcn_global_load_lds((const unsigned*)vs, (LAS unsigned*)(slot + 8192 + wid * 1024), 16, 0, 0);
}
__device__ __forceinline__ void qkt(f32x16& p0, f32x16& p1, const LAS unsigned char* kslot, const bf16x8 (&qr)[4], int r32, int hi) {
    const LAS unsigned char* kb = kslot + hi * 1024 + r32 * 16;
    const f32x16 z = {0.f, 0.f, 0.f, 0.f, 0.f, 0.f, 0.f, 0.f, 0.f, 0.f, 0.f, 0.f, 0.f, 0.f, 0.f, 0.f};
    p0 = z; p1 = z;
#pragma unroll
    for (int d0 = 0; d0 < 4; ++d0) {
        const bf16x8 b0 = *(const LAS bf16x8*)(kb + d0 * 2048);
        const bf16x8 b1 = *(const LAS bf16x8*)(kb + d0 * 2048 + 512);
        p0 = __builtin_amdgcn_mfma_f32_32x32x16_bf16(b0, qr[d0], p0, 0, 0, 0);
        p1 = __builtin_amdgcn_mfma_f32_32x32x16_bf16(b1, qr[d0], p1, 0, 0, 0);
    }
}
typedef short v4i16_t __attribute__((ext_vector_type(4)));
__device__ __forceinline__ s16x4 vtr(const LAS unsigned char* p) { return __builtin_bit_cast(s16x4, __builtin_amdgcn_ds_read_tr16_b64_v4i16((LAS v4i16_t*)p)); }
__device__ __forceinline__ bf16x8 vfrag(const LAS unsigned char* vslot, int dh, int ks, int lane) {
    const int hi = lane >> 5;
    const LAS unsigned char* p = vslot + dh * 4096 + ks * 1024 + ((lane >> 4) & 1) * 32 + (lane & 3) * 8 + (4 * hi + ((lane & 15) >> 2)) * 64;
    const s16x4 lo = vtr(p), hh = vtr(p + 512);
    return (bf16x8){lo[0], lo[1], lo[2], lo[3], hh[0], hh[1], hh[2], hh[3]};
}
__device__ __forceinline__ void pack_p(const f32x16& p0, const f32x16& p1, bf16x8 (&pa)[4]) {
    u32x4 w;
    w.x = cvtpk(p0[0], p0[1]); w.y = cvtpk(p0[2], p0[3]); w.z = cvtpk(p0[4], p0[5]); w.w = cvtpk(p0[6], p0[7]); pa[0] = __builtin_bit_cast(bf16x8, w);
    w.x = cvtpk(p0[8], p0[9]); w.y = cvtpk(p0[10], p0[11]); w.z = cvtpk(p0[12], p0[13]); w.w = cvtpk(p0[14], p0[15]); pa[1] = __builtin_bit_cast(bf16x8, w);
    w.x = cvtpk(p1[0], p1[1]); w.y = cvtpk(p1[2], p1[3]); w.z = cvtpk(p1[4], p1[5]); w.w = cvtpk(p1[6], p1[7]); pa[2] = __builtin_bit_cast(bf16x8, w);
    w.x = cvtpk(p1[8], p1[9]); w.y = cvtpk(p1[10], p1[11]); w.z = cvtpk(p1[12], p1[13]); w.w = cvtpk(p1[14], p1[15]); pa[3] = __builtin_bit_cast(bf16x8, w);
}
__device__ __forceinline__ void pv(f32x16 (&o)[2], const LAS unsigned char* vslot, const bf16x8 (&pa)[4], int lane) {
#pragma unroll
    for (int d0 = 0; d0 < 2; ++d0)
#pragma unroll
        for (int ks = 0; ks < 4; ++ks) o[d0] = __builtin_amdgcn_mfma_f32_32x32x16_bf16(pa[ks], vfrag(vslot, d0, ks, lane), o[d0], 0, 0, 0);
}
__device__ __forceinline__ float rowmax32(const f32x16& p0, const f32x16& p1) {
    float a = fmaxf(p0[0], p1[0]);
#pragma unroll
    for (int r = 1; r < 16; ++r) a = fmaxf(a, fmaxf(p0[r], p1[r]));
    return fmaxf(a, swap_half(a));
}
__device__ __forceinline__ void scale_rows(f32x16 (&o)[2], float f, LAS float* wsf, int r32, int hi) {
    if (hi == 0) wsf[r32] = f;
    asm volatile("s_waitcnt lgkmcnt(0)" ::: "memory");
#pragma unroll
    for (int g4 = 0; g4 < 4; ++g4) { const f32x4 fv = *(const LAS f32x4*)(wsf + 8 * g4 + 4 * hi);
#pragma unroll
        for (int j = 0; j < 4; ++j) { o[0][4 * g4 + j] *= fv[j]; o[1][4 * g4 + j] *= fv[j]; } }
    asm volatile("s_waitcnt lgkmcnt(0)" ::: "memory");
}
template <bool RAW>
__device__ __forceinline__ void softmax_tile(f32x16& p0, f32x16& p1, float& m, float& l, f32x16 (&o)[2], LAS float* wsf, int r32, int hi) {
    const float sc = RAW ? CS : 1.0f;
    const float mx = rowmax32(p0, p1);
    const float mnew = fmaxf(m, mx);
    if (__any(mnew > m)) { const float al = __builtin_amdgcn_exp2f((m - mnew) * sc); l *= al; scale_rows(o, al, wsf, r32, hi); }
    m = mnew;
    const float nm = -m * sc; float s = 0.f;
#pragma unroll
    for (int r = 0; r < 16; ++r) { p0[r] = __builtin_amdgcn_exp2f(__builtin_fmaf(p0[r], sc, nm)); p1[r] = __builtin_amdgcn_exp2f(__builtin_fmaf(p1[r], sc, nm)); s += p0[r] + p1[r]; }
    l += s;
}
__device__ __forceinline__ void store_o(const f32x16 (&o)[2], LAS unsigned char* ost_w, bf16_t* dst, int pitch, int lane) {
    const int r32 = lane & 31, hi = lane >> 5;
    LAS bf16_t* stg = (LAS bf16_t*)ost_w;
#pragma unroll
    for (int r = 0; r < 16; ++r) { const int orow = crow(r, hi);
#pragma unroll
        for (int d0 = 0; d0 < 2; ++d0) stg[orow * 64 + d0 * 32 + r32] = (bf16_t)f2bf(o[d0][r]); }
    asm volatile("s_waitcnt lgkmcnt(0)" ::: "memory");
#pragma unroll
    for (int i = 0; i < 4; ++i) { const int row = i * 8 + (lane >> 3), ch = lane & 7; const u32x4 v = *(const LAS u32x4*)(stg + row * 64 + ch * 8); *(u32x4*)(dst + (size_t)row * pitch + ch * 8) = v; }
    asm volatile("s_waitcnt lgkmcnt(0)" ::: "memory");
}
__device__ __forceinline__ void load_q(bf16x8 (&qr)[4], const bf16_t* qrow, int hi) {
#pragma unroll
    for (int d0 = 0; d0 < 4; ++d0) qr[d0] = *(const bf16x8*)(qrow + d0 * 16 + hi * 8);
}

__device__ __forceinline__ void fox_unit(const Ctx& C, int b, int h, int qb, const bf16_t* proj, float bfh, bf16_t* ys) {
    LAS unsigned char* lds = C.lds; const int lane = C.lane, wid = C.wave, r32 = lane & 31, hi = lane >> 5, tid = C.tid;
    LAS float* cumL = (LAS float*)(lds + L_X);
    LAS float* wtot = (LAS float*)(lds + L_X + 8192);
    LAS float* wsf = (LAS float*)(lds + L_WSF) + wid * 64;
    const size_t rowb = (size_t)b * SEQ; const int Q0 = qb * 256, NT = 4 * qb + 4, nS = Q0 + 256;
    const bf16_t* kb = proj + rowb * LDP + P_FK + h * 64; const bf16_t* vb = proj + rowb * LDP + P_FV + h * 64;
    dma_kv(lds + L_RING, kb, vb, LDP, wid, lane);
    float c4[4]; float run = 0.f;
#pragma unroll
    for (int i = 0; i < 4; ++i) { const int s = 4 * tid + i; float lf = 0.f; if (s < nS) lf = logsigmoidf_(bf2f(proj[(rowb + s) * LDP + P_FF + h]) + bfh); run += lf; c4[i] = run; }
    float incl = run;
#pragma unroll
    for (int o = 1; o < 64; o <<= 1) { const float t = __shfl_up(incl, o); if (lane >= o) incl += t; }
    if (lane == 63) wtot[wid] = incl;
    __syncthreads();
    float off = incl - run;
#pragma unroll
    for (int w = 0; w < 8; ++w) off += (w < wid) ? wtot[w] : 0.f;
#pragma unroll
    for (int i = 0; i < 4; ++i) cumL[4 * tid + i] = off + c4[i];
    __syncthreads();
    const float cref = cumL[Q0];
    __syncthreads();
#pragma unroll
    for (int i = 0; i < 4; ++i) cumL[4 * tid + i] = (cref - cumL[4 * tid + i]) * LOG2E;
    bf16x8 qr[4]; load_q(qr, proj + (rowb + Q0 + 32 * wid + r32) * LDP + P_FQ + h * 64, hi);
    f32x16 o[2];
#pragma unroll
    for (int r = 0; r < 16; ++r) { o[0][r] = 0.f; o[1][r] = 0.f; }
    float m = -1e30f, l = 0.f; const int my_last = 4 * qb + (wid >> 1); const int qidx = Q0 + 32 * wid + r32;
    __syncthreads();
    for (int t = 0; t < NT; ++t) {
        LAS unsigned char* slot = lds + L_RING + (t & 1) * SLOT;
        if (t + 1 < NT) dma_kv(lds + L_RING + ((t + 1) & 1) * SLOT, kb + (size_t)(t + 1) * 64 * LDP, vb + (size_t)(t + 1) * 64 * LDP, LDP, wid, lane);
        if (t <= my_last) {
            f32x16 p0, p1; qkt(p0, p1, slot, qr, r32, hi);
#pragma unroll
            for (int g4 = 0; g4 < 4; ++g4) { const f32x4 b0 = *(const LAS f32x4*)(cumL + 64 * t + 8 * g4 + 4 * hi), b1 = *(const LAS f32x4*)(cumL + 64 * t + 32 + 8 * g4 + 4 * hi);
#pragma unroll
                for (int j = 0; j < 4; ++j) { p0[4 * g4 + j] = __builtin_fmaf(p0[4 * g4 + j], CS, b0[j]); p1[4 * g4 + j] = __builtin_fmaf(p1[4 * g4 + j], CS, b1[j]); } }
            if (t == my_last) {
#pragma unroll
                for (int r = 0; r < 16; ++r) { const int kv = 64 * t + crow(r, hi); if (kv > qidx) p0[r] = -__builtin_inff(); if (kv + 32 > qidx) p1[r] = -__builtin_inff(); } }
            softmax_tile<false>(p0, p1, m, l, o, wsf, r32, hi);
            bf16x8 pa[4]; pack_p(p0, p1, pa);
            pv(o, slot + 8192, pa, lane);
        }
        __syncthreads();
    }
    l += swap_half(l);
    scale_rows(o, 1.0f / l, wsf, r32, hi);
    store_o(o, lds + L_OST + wid * 4096, ys + ((size_t)3 * M + rowb + Q0 + 32 * wid) * 512 + h * 64, 512, lane);
    __syncthreads();
}

__device__ __forceinline__ void sb_unit(const Ctx& C, int b, int h, int qb, const bf16_t* proj, bf16_t* ys) {
    LAS unsigned char* lds = C.lds; const int lane = C.lane, wid = C.wave, r32 = lane & 31, hi = lane >> 5;
    LAS unsigned* votes = (LAS unsigned*)(lds + L_X);
    const size_t rowb = (size_t)b * SEQ; const int Q0 = qb * 256, NT = 4 * qb + 4;
    const bf16_t* kb = proj + rowb * LDP + P_SK + h * 64; const bf16_t* vb = proj + rowb * LDP + P_SV + h * 64;
    dma_kv(lds + L_RING, kb + (size_t)(NT - 1) * 64 * LDP, vb + (size_t)(NT - 1) * 64 * LDP, LDP, wid, lane);
    bf16x8 qr[4]; load_q(qr, proj + (rowb + Q0 + 32 * wid + r32) * LDP + P_SQ + h * 64, hi);
    bf16x8 ua[2], ones;
#pragma unroll
    for (int s = 0; s < 2; ++s)
#pragma unroll
        for (int e = 0; e < 8; ++e) ua[s][e] = ((16 * s + 8 * (e >> 2) + 4 * hi + (e & 3)) >= r32) ? (short)0x3F80 : (short)0;
#pragma unroll
    for (int e = 0; e < 8; ++e) ones[e] = (short)0x3F80;
    f32x16 o[2];
#pragma unroll
    for (int r = 0; r < 16; ++r) { o[0][r] = 0.f; o[1][r] = 0.f; }
    float R2 = 0.f; bool done = false; const int my_first = 4 * qb + (wid >> 1); const int qidx = Q0 + 32 * wid + r32;
    __syncthreads();
    int it = 0;
    for (int t = NT - 1; t >= 0; --t, ++it) {
        LAS unsigned char* slot = lds + L_RING + (it & 1) * SLOT;
        if (t > 0) dma_kv(lds + L_RING + ((it + 1) & 1) * SLOT, kb + (size_t)(t - 1) * 64 * LDP, vb + (size_t)(t - 1) * 64 * LDP, LDP, wid, lane);
        if (t <= my_first && !done) {
            f32x16 z0, z1; qkt(z0, z1, slot, qr, r32, hi);
            f32x16 sp0, sp1;
#pragma unroll
            for (int r = 0; r < 16; ++r) { z0[r] *= CS; z1[r] *= CS;
                sp0[r] = __builtin_amdgcn_logf(1.0f + __builtin_amdgcn_exp2f(fminf(z0[r], 100.f))); sp1[r] = __builtin_amdgcn_logf(1.0f + __builtin_amdgcn_exp2f(fminf(z1[r], 100.f))); }
            if (t == my_first) {
#pragma unroll
                for (int r = 0; r < 16; ++r) { const int kv = 64 * t + crow(r, hi); if (kv >= qidx) { sp0[r] = 0.f; z0[r] = -__builtin_inff(); } if (kv + 32 >= qidx) { sp1[r] = 0.f; z1[r] = -__builtin_inff(); } } }
            bf16x8 spa[4]; pack_p(sp0, sp1, spa);
            f32x16 S0, S1;
#pragma unroll
            for (int r = 0; r < 16; ++r) { S0[r] = R2; S1[r] = R2; }
            S0 = __builtin_amdgcn_mfma_f32_32x32x16_bf16(ua[0], spa[0], S0, 0, 0, 0); S0 = __builtin_amdgcn_mfma_f32_32x32x16_bf16(ua[1], spa[1], S0, 0, 0, 0);
            S0 = __builtin_amdgcn_mfma_f32_32x32x16_bf16(ones, spa[2], S0, 0, 0, 0); S0 = __builtin_amdgcn_mfma_f32_32x32x16_bf16(ones, spa[3], S0, 0, 0, 0);
            S1 = __builtin_amdgcn_mfma_f32_32x32x16_bf16(ua[0], spa[2], S1, 0, 0, 0); S1 = __builtin_amdgcn_mfma_f32_32x32x16_bf16(ua[1], spa[3], S1, 0, 0, 0);
            f32x16 a0, a1;
#pragma unroll
            for (int r = 0; r < 16; ++r) { a0[r] = __builtin_amdgcn_exp2f(z0[r] - S0[r]); a1[r] = __builtin_amdgcn_exp2f(z1[r] - S1[r]); }
            bf16x8 pa[4]; pack_p(a0, a1, pa);
            pv(o, slot + 8192, pa, lane);
            R2 = __shfl(S0[0], r32);
            done = __all(R2 > 126.0f);
        }
        if (lane == 0) votes[(it & 1) * 8 + wid] = done ? 1u : 0u;
        __syncthreads();
        unsigned all = 1u;
#pragma unroll
        for (int w = 0; w < 8; ++w) all &= votes[(it & 1) * 8 + w];
        if (all) break;
    }
    __syncthreads();
    store_o(o, lds + L_OST + wid * 4096, ys + ((size_t)1 * M + rowb + Q0 + 32 * wid) * 512 + h * 64, 512, lane);
    __syncthreads();
}
}
namespace gla {
using att::f32x16; using att::crow; using att::cvtpk; using att::vfrag;
constexpr int G_LA = 0;
constexpr int G_SEG = 16640;
constexpr int G_WA = 18688;
constexpr int G_QP = 22784;
constexpr int G_KP = 30976;
constexpr int G_KPP = 39168;
constexpr int G_V = 47360;
__device__ __forceinline__ void prep_unit(const Ctx& C, const Args& a, int l, int b, int h, int c, const bf16_t* proj, bf16_t* gqp, float* gdec, float* gds, float* goi) {
    LAS unsigned char* lds = C.lds; const int tid = C.tid, lane = C.lane, wid = C.wave, r32 = lane & 31, hi = lane >> 5;
    LAS float* LA = (LAS float*)(lds + G_LA); LAS float* SEG = (LAS float*)(lds + G_SEG); LAS float* WA = (LAS float*)(lds + G_WA);
    const size_t rowb = (size_t)b * SEQ; const int T0 = 64 * c; const int unit = (b * 4 + h) * 32 + c;
    for (int i = tid; i < 1024; i += NTHR) WA[i] = a.gla_w_alpha[(size_t)l * 16 * 256 + (i >> 6) * 256 + h * 64 + (i & 63)];
    __syncthreads();
    {
        const int t = tid >> 3, k0 = (tid & 7) * 8; const bf16_t* pr = proj + (rowb + T0 + t) * LDP;
        float al[16]; { float t0[8], t1[8]; ld8(pr + P_GA, t0); ld8(pr + P_GA + 8, t1);
#pragma unroll
            for (int r = 0; r < 8; ++r) { al[r] = t0[r]; al[8 + r] = t1[r]; } }
#pragma unroll
        for (int i = 0; i < 8; ++i) { float x = a.gla_b_alpha[l * 256 + h * 64 + k0 + i];
#pragma unroll
            for (int r = 0; r < 16; ++r) x += al[r] * WA[r * 64 + k0 + i];
            LA[t * 65 + k0 + i] = logsigmoidf_(x) * (1.0f / 16.0f); }
    }
    __syncthreads();
    {
        const int k = tid & 63, seg = tid >> 6; float v[8]; float run = 0.f;
#pragma unroll
        for (int i = 0; i < 8; ++i) { run += LA[(8 * seg + i) * 65 + k]; v[i] = run; }
        SEG[seg * 64 + k] = run;
        __syncthreads();
        float off = 0.f;
#pragma unroll
        for (int s = 0; s < 8; ++s) off += (s < seg) ? SEG[s * 64 + k] : 0.f;
#pragma unroll
        for (int i = 0; i < 8; ++i) LA[(8 * seg + i) * 65 + k] = v[i] + off;
    }
    __syncthreads();
    {
        const int t = tid >> 3, ks = tid & 7, k0 = ks * 8; const bf16_t* pr = proj + (rowb + T0 + t) * LDP;
        float qv[8], kv[8]; ld8(pr + P_GQ + h * 64 + k0, qv); ld8(pr + P_GK + h * 64 + k0, kv);
        float qp[8], kp[8], kpp[8];
#pragma unroll
        for (int i = 0; i < 8; ++i) { const float bb = LA[t * 65 + k0 + i], bl = LA[63 * 65 + k0 + i]; qp[i] = qv[i] * 0.125f * __expf(bb); kp[i] = kv[i] * __expf(-bb); kpp[i] = kv[i] * __expf(bl - bb);
            if (t == 63) gdec[(size_t)unit * 64 + k0 + i] = __expf(bl); }
        u32x4 w; w.x = pk2(qp[0], qp[1]); w.y = pk2(qp[2], qp[3]); w.z = pk2(qp[4], qp[5]); w.w = pk2(qp[6], qp[7]);
        *(LAS u32x4*)(lds + G_QP + ks * 1024 + t * 16) = w; *(u32x4*)(gqp + (rowb + T0 + t) * 256 + h * 64 + k0) = w;
        w.x = pk2(kp[0], kp[1]); w.y = pk2(kp[2], kp[3]); w.z = pk2(kp[4], kp[5]); w.w = pk2(kp[6], kp[7]);
        *(LAS u32x4*)(lds + G_KP + ks * 1024 + t * 16) = w;
        w.x = pk2(kpp[0], kpp[1]); w.y = pk2(kpp[2], kpp[3]); w.z = pk2(kpp[4], kpp[5]); w.w = pk2(kpp[6], kpp[7]);
        *(LAS u32x4*)(lds + G_KPP + (ks >> 2) * 4096 + t * 64 + (ks & 3) * 16) = w;
        const int vs = tid & 7; const u32x4 v0 = *(const u32x4*)(pr + P_GV + h * 128 + vs * 16), v1 = *(const u32x4*)(pr + P_GV + h * 128 + vs * 16 + 8);
        const int vbk = vs >> 1; LAS unsigned char* vp = lds + G_V + (vbk >> 1) * 8192 + (vbk & 1) * 4096 + t * 64 + (vs & 1) * 32;
        *(LAS u32x4*)vp = v0; *(LAS u32x4*)(vp + 16) = v1;
    }
    __syncthreads();
    {
        const int tb = wid & 1, vb = wid >> 1;
        bf16x8 qf[4];
#pragma unroll
        for (int d0 = 0; d0 < 4; ++d0) qf[d0] = *(const LAS bf16x8*)(lds + G_QP + (2 * d0 + hi) * 1024 + (32 * tb + r32) * 16);
        f32x16 o;
#pragma unroll
        for (int r = 0; r < 16; ++r) o[r] = 0.f;
        for (int sb = 0; sb <= tb; ++sb) {
            f32x16 s;
#pragma unroll
            for (int r = 0; r < 16; ++r) s[r] = 0.f;
#pragma unroll
            for (int d0 = 0; d0 < 4; ++d0) { const bf16x8 kf = *(const LAS bf16x8*)(lds + G_KP + (2 * d0 + hi) * 1024 + (32 * sb + r32) * 16); s = __builtin_amdgcn_mfma_f32_32x32x16_bf16(kf, qf[d0], s, 0, 0, 0); }
            if (sb == tb) {
#pragma unroll
                for (int r = 0; r < 16; ++r) if (crow(r, hi) > r32) s[r] = 0.f; }
            u32x4 w; bf16x8 pa0, pa1;
            w.x = cvtpk(s[0], s[1]); w.y = cvtpk(s[2], s[3]); w.z = cvtpk(s[4], s[5]); w.w = cvtpk(s[6], s[7]); pa0 = __builtin_bit_cast(bf16x8, w);
            w.x = cvtpk(s[8], s[9]); w.y = cvtpk(s[10], s[11]); w.z = cvtpk(s[12], s[13]); w.w = cvtpk(s[14], s[15]); pa1 = __builtin_bit_cast(bf16x8, w);
            const LAS unsigned char* vimg = lds + G_V + (vb >> 1) * 8192;
            o = __builtin_amdgcn_mfma_f32_32x32x16_bf16(pa0, vfrag(vimg, vb & 1, 2 * sb, lane), o, 0, 0, 0);
            o = __builtin_amdgcn_mfma_f32_32x32x16_bf16(pa1, vfrag(vimg, vb & 1, 2 * sb + 1, lane), o, 0, 0, 0);
        }
        float* op = goi + (rowb + T0 + 32 * tb) * 512 + h * 128 + vb * 32 + r32;
#pragma unroll
        for (int r = 0; r < 16; ++r) op[(size_t)crow(r, hi) * 512] = o[r];
        const int kb = wid & 1; f32x16 d;
#pragma unroll
        for (int r = 0; r < 16; ++r) d[r] = 0.f;
        const LAS unsigned char* vimg = lds + G_V + (vb >> 1) * 8192;
#pragma unroll
        for (int ks = 0; ks < 4; ++ks) d = __builtin_amdgcn_mfma_f32_32x32x16_bf16(vfrag(vimg, vb & 1, ks, lane), vfrag(lds + G_KPP, kb, ks, lane), d, 0, 0, 0);
        float* dp = gds + (size_t)unit * 8192 + (size_t)(32 * vb) * 64 + 32 * kb + r32;
#pragma unroll
        for (int r = 0; r < 16; ++r) dp[crow(r, hi) * 64] = d[r];
    }
    __syncthreads();
}

constexpr int S_ST = 0;
constexpr int S_RED = 18432;
__device__ __forceinline__ void seq_unit(const Ctx& C, const Args& a, int l, int b, int h, const bf16_t* proj, const bf16_t* gqp, const float* gdec, const float* gds, const float* goi, bf16_t* ys) {
    LAS unsigned char* lds = C.lds; const int tid = C.tid, lane = C.lane, wid = C.wave, r32 = lane & 31, hi = lane >> 5;
    LAS float* RED = (LAS float*)(lds + S_RED);
    const size_t rowb = (size_t)b * SEQ; const int sv = tid >> 2, sk = (tid & 3) * 16;
    const int tb = wid & 1, vb = wid >> 1;
    float st[16];
#pragma unroll
    for (int i = 0; i < 16; ++i) st[i] = 0.f;
    float ng[16];
#pragma unroll
    for (int r = 0; r < 16; ++r) ng[r] = a.gla_norm[l * 128 + 32 * vb + crow(r, hi)];
    for (int c = 0; c < 32; ++c) {
        const int unit = (b * 4 + h) * 32 + c; const size_t tok = rowb + 64 * c + 32 * tb + r32;
        { u32x4 w; w.x = pk2(st[0], st[1]); w.y = pk2(st[2], st[3]); w.z = pk2(st[4], st[5]); w.w = pk2(st[6], st[7]); *(LAS u32x4*)(lds + S_ST + sv * 144 + sk * 2) = w;
          w.x = pk2(st[8], st[9]); w.y = pk2(st[10], st[11]); w.z = pk2(st[12], st[13]); w.w = pk2(st[14], st[15]); *(LAS u32x4*)(lds + S_ST + sv * 144 + sk * 2 + 16) = w; }
        bf16x8 qf[4];
#pragma unroll
        for (int s = 0; s < 4; ++s) qf[s] = *(const bf16x8*)(gqp + tok * 256 + h * 64 + 16 * s + 8 * hi);
        f32x4 oi[4]; u32x2 gt[4];
#pragma unroll
        for (int g4 = 0; g4 < 4; ++g4) { oi[g4] = *(const f32x4*)(goi + tok * 512 + h * 128 + 32 * vb + 8 * g4 + 4 * hi); gt[g4] = *(const u32x2*)(proj + tok * LDP + P_GG + h * 128 + 32 * vb + 8 * g4 + 4 * hi); }
        f32x4 dsv[4], dcv[4];
#pragma unroll
        for (int j = 0; j < 4; ++j) { dsv[j] = *(const f32x4*)(gds + (size_t)unit * 8192 + sv * 64 + sk + 4 * j); dcv[j] = *(const f32x4*)(gdec + (size_t)unit * 64 + sk + 4 * j); }
        __syncthreads();
        f32x16 acc;
#pragma unroll
        for (int r = 0; r < 16; ++r) acc[r] = 0.f;
#pragma unroll
        for (int s = 0; s < 4; ++s) { const bf16x8 af = *(const LAS bf16x8*)(lds + S_ST + (32 * vb + r32) * 144 + 32 * s + 16 * hi); acc = __builtin_amdgcn_mfma_f32_32x32x16_bf16(af, qf[s], acc, 0, 0, 0); }
        float ssq = 0.f;
#pragma unroll
        for (int r = 0; r < 16; ++r) { acc[r] += oi[r >> 2][r & 3]; ssq += acc[r] * acc[r]; }
        ssq += att::swap_half(ssq);
        if (hi == 0) RED[vb * 64 + 32 * tb + r32] = ssq;
        __syncthreads();
        const float tot = RED[32 * tb + r32] + RED[64 + 32 * tb + r32] + RED[128 + 32 * tb + r32] + RED[192 + 32 * tb + r32];
        const float rstd = rsqrtf(tot * (1.0f / 128.0f) + EPS);
        bf16_t* yo = ys + ((size_t)2 * M + tok) * 512 + h * 128 + 32 * vb + 4 * hi;
#pragma unroll
        for (int g4 = 0; g4 < 4; ++g4) { const float g0 = bflo(gt[g4].x), g1 = bfhi(gt[g4].x), g2 = bflo(gt[g4].y), g3 = bfhi(gt[g4].y);
            u32x2 w; w.x = cvtpk(acc[4 * g4] * rstd * ng[4 * g4] * g0 * sigmoidf_(g0), acc[4 * g4 + 1] * rstd * ng[4 * g4 + 1] * g1 * sigmoidf_(g1));
            w.y = cvtpk(acc[4 * g4 + 2] * rstd * ng[4 * g4 + 2] * g2 * sigmoidf_(g2), acc[4 * g4 + 3] * rstd * ng[4 * g4 + 3] * g3 * sigmoidf_(g3));
            *(u32x2*)(yo + 8 * g4) = w; }
#pragma unroll
        for (int i = 0; i < 16; ++i) st[i] = dcv[i >> 2][i & 3] * st[i] + dsv[i >> 2][i & 3];
    }
    __syncthreads();
}
}
namespace nsa {
using namespace att;
constexpr int N_GT = 34816, N_SELW = 37888, N_LIST = 37888 + 256, N_IMPS = 38400, N_IMPM = 46848, N_IMPC = 80640, N_OST = N_IMPM;
__device__ __forceinline__ void nsa_unit(const Ctx& C, int b, int g, int qt, const bf16_t* proj, const bf16_t* kcvc, bf16_t* ys) {
    LAS unsigned char* lds = C.lds; const int tid = C.tid, lane = C.lane, wid = C.wave, r32 = lane & 31, hi = lane >> 5;
    const int hp = wid & 3, qs = wid >> 2, h = 4 * g + hp; const size_t rowb = (size_t)b * SEQ; const int T0 = 64 * qt, jd = qt;
    const int qidx = 32 * qs + r32, qtok = T0 + qidx;
    LAS float* wsf = (LAS float*)(lds + L_WSF) + wid * 64; LAS float* GT = (LAS float*)(lds + N_GT) + wid * 96;
    LAS unsigned* SELW = (LAS unsigned*)(lds + N_SELW); LAS unsigned* LIST = (LAS unsigned*)(lds + N_LIST);
    LAS float* IMPS = (LAS float*)(lds + N_IMPS); LAS float* IMPM = (LAS float*)(lds + N_IMPM) + wid * 1056; LAS float* IMPC = (LAS float*)(lds + N_IMPC) + wid * 1056;
    const bf16_t* kc = kcvc + (((size_t)0 * NB + b) * 128 * 2 + g) * 64; const bf16_t* vc = kcvc + (((size_t)1 * NB + b) * 128 * 2 + g) * 64;
    const int ncmax = (T0 + 63 >= 31) ? ((T0 + 63 - 31) / 16 + 1) : 0;
    const int nct = (ncmax + 63) >> 6;
    if (nct > 0) dma_kv(lds + L_RING, kc, vc, 128, wid, lane);
    if (nct > 1) dma_kv(lds + L_RING + SLOT, kc + 64 * 128, vc + 64 * 128, 128, wid, lane);
    const bf16_t* prow = proj + (rowb + qtok) * LDP;
    bf16x8 qr[4]; load_q(qr, prow + P_NQ + h * 64, hi);
    if (hi == 0) {
#pragma unroll
        for (int i = 0; i < 3; ++i) GT[i * 32 + r32] = sigmoidf_(bf2f(prow[P_NG + h * 3 + i])); }
    asm volatile("s_waitcnt vmcnt(0)" ::: "memory");
    __syncthreads();
    f32x16 yacc[2];
#pragma unroll
    for (int r = 0; r < 16; ++r) { yacc[0][r] = 0.f; yacc[1][r] = 0.f; }
    {
        const int ncv = (qtok >= 31) ? ((qtok - 31) / 16 + 1) : 0;
        f32x16 p[4];
#pragma unroll
        for (int i = 0; i < 4; ++i)
#pragma unroll
            for (int r = 0; r < 16; ++r) p[i][r] = -__builtin_inff();
        if (nct > 0) qkt(p[0], p[1], lds + L_RING, qr, r32, hi);
        if (nct > 1) qkt(p[2], p[3], lds + L_RING + SLOT, qr, r32, hi);
#pragma unroll
        for (int i = 0; i < 4; ++i)
#pragma unroll
            for (int r = 0; r < 16; ++r) if (32 * i + crow(r, hi) >= ncv) p[i][r] = -__builtin_inff();
        float mx = fmaxf(rowmax32(p[0], p[1]), rowmax32(p[2], p[3]));
        const float msafe = (mx == -__builtin_inff()) ? 0.f : mx; const float nm = -msafe * CS; float s = 0.f;
#pragma unroll
        for (int i = 0; i < 4; ++i)
#pragma unroll
            for (int r = 0; r < 16; ++r) { p[i][r] = __builtin_amdgcn_exp2f(__builtin_fmaf(p[i][r], CS, nm)); s += p[i][r]; }
        s += swap_half(s);
        const float il = (s > 0.f) ? 1.0f / s : 0.f;
#pragma unroll
        for (int i = 0; i < 4; ++i)
#pragma unroll
            for (int r = 0; r < 16; ++r) p[i][r] *= il;
#pragma unroll
        for (int i = 0; i < 4; ++i)
#pragma unroll
            for (int g4 = 0; g4 < 4; ++g4) { const int j = 8 * i + 2 * g4 + hi; const float c3 = 0.5f * p[i][4 * g4 + 3];
                IMPM[r32 * 33 + j] = p[i][4 * g4] + p[i][4 * g4 + 1] + p[i][4 * g4 + 2] + c3; IMPC[r32 * 33 + j + 1] = c3; }
        f32x16 oc[2];
#pragma unroll
        for (int r = 0; r < 16; ++r) { oc[0][r] = 0.f; oc[1][r] = 0.f; }
        bf16x8 pa[4];
        if (nct > 0) { pack_p(p[0], p[1], pa); pv(oc, lds + L_RING + 8192, pa, lane); }
        if (nct > 1) { pack_p(p[2], p[3], pa); pv(oc, lds + L_RING + SLOT + 8192, pa, lane); }
#pragma unroll
        for (int g4 = 0; g4 < 4; ++g4) { const f32x4 gv = *(const LAS f32x4*)(GT + 0 * 32 + 8 * g4 + 4 * hi);
#pragma unroll
            for (int j = 0; j < 4; ++j) { yacc[0][4 * g4 + j] = oc[0][4 * g4 + j] * gv[j]; yacc[1][4 * g4 + j] = oc[1][4 * g4 + j] * gv[j]; } }
    }
    __syncthreads();
    {
        const int q = tid >> 3, part = tid & 7, qsq = q >> 5, rq = q & 31, t = T0 + q;
#pragma unroll
        for (int jj = 0; jj < 4; ++jj) { const int j = 4 * part + jj; float v = 0.f;
#pragma unroll
            for (int hh = 0; hh < 4; ++hh) { const LAS float* pm = (const LAS float*)(lds + N_IMPM) + (qsq * 4 + hh) * 1056 + rq * 33; const LAS float* pc = (const LAS float*)(lds + N_IMPC) + (qsq * 4 + hh) * 1056 + rq * 33;
                v += pm[j]; if (j > 0) v += pc[j]; }
            if (j == 0 || j == (t >> 6)) v = __builtin_inff(); else if (64 * j > t) v = -__builtin_inff();
            IMPS[q * 33 + j] = v; }
        __syncthreads();
        unsigned bits = 0u;
#pragma unroll
        for (int jj = 0; jj < 4; ++jj) { const int j = 4 * part + jj; const float vj = IMPS[q * 33 + j]; int rank = 0;
#pragma unroll 8
            for (int j2 = 0; j2 < 32; ++j2) { const float v2 = IMPS[q * 33 + j2]; rank += (v2 > vj || (v2 == vj && j2 < j)) ? 1 : 0; }
            if (rank < 8) bits |= 1u << j; }
        bits |= __shfl_xor(bits, 1); bits |= __shfl_xor(bits, 2); bits |= __shfl_xor(bits, 4);
        if (part == 0) SELW[q] = bits;
        __syncthreads();
        if (wid == 0) {
            unsigned un = SELW[lane];
#pragma unroll
            for (int o = 1; o < 64; o <<= 1) un |= __shfl_xor(un, o);
            if (lane == 0) { int n = 0; for (int j = 0; j <= jd; ++j) if ((un >> j) & 1u) LIST[1 + n++] = (unsigned)j;
                for (int j = (jd - 4 > 0 ? jd - 4 : 0); j <= jd; ++j) LIST[1 + n++] = 0x100u | (unsigned)j;
                LIST[0] = (unsigned)n; }
        }
        __syncthreads();
    }
    {
        const int n = (int)LIST[0]; const unsigned selq = SELW[qidx];
        const bf16_t* ksb = proj + rowb * LDP + P_KS + g * 64; const bf16_t* vsb = proj + rowb * LDP + P_VS + g * 64;
        const bf16_t* kwb = proj + rowb * LDP + P_KW + g * 64; const bf16_t* vwb = proj + rowb * LDP + P_VW + g * 64;
        f32x16 o[2];
#pragma unroll
        for (int r = 0; r < 16; ++r) { o[0][r] = 0.f; o[1][r] = 0.f; }
        float m = -1e30f, l = 0.f; int mode = 0;
        { const unsigned e0 = LIST[1]; const int j0 = e0 & 0xff; const bool w0 = (e0 >> 8) != 0; dma_kv(lds + L_RING, (w0 ? kwb : ksb) + (size_t)j0 * 64 * LDP, (w0 ? vwb : vsb) + (size_t)j0 * 64 * LDP, LDP, wid, lane); }
        asm volatile("s_waitcnt vmcnt(0)" ::: "memory");
        __syncthreads();
        for (int i = 0; i < n; ++i) {
            const unsigned e = LIST[1 + i]; const int j = e & 0xff; const int md = e >> 8;
            LAS unsigned char* slot = lds + L_RING + (i & 1) * SLOT;
            if (i + 1 < n) { const unsigned e1 = LIST[2 + i]; const int j1 = e1 & 0xff; const bool w1 = (e1 >> 8) != 0;
                dma_kv(lds + L_RING + ((i + 1) & 1) * SLOT, (w1 ? kwb : ksb) + (size_t)j1 * 64 * LDP, (w1 ? vwb : vsb) + (size_t)j1 * 64 * LDP, LDP, wid, lane); }
            if (md != mode) {
                l += swap_half(l);
                const float f = GT[1 * 32 + r32] / l;
                scale_rows(o, f, wsf, r32, hi);
#pragma unroll
                for (int r = 0; r < 16; ++r) { yacc[0][r] += o[0][r]; yacc[1][r] += o[1][r]; o[0][r] = 0.f; o[1][r] = 0.f; }
                m = -1e30f; l = 0.f; mode = md;
            }
            const bool allowed = (md != 0) || (((selq >> j) & 1u) != 0u);
            if (__any(allowed)) {
                f32x16 p0, p1; qkt(p0, p1, slot, qr, r32, hi);
                const bool diag = (j == jd), first = (md != 0) && (j == jd - 4);
#pragma unroll
                for (int r = 0; r < 16; ++r) { const int k0 = crow(r, hi), k1 = k0 + 32;
                    bool v0 = allowed, v1 = allowed;
                    if (diag) { v0 = v0 && (k0 <= qidx); v1 = v1 && (k1 <= qidx); }
                    if (first) { v0 = v0 && (k0 > qidx); v1 = v1 && (k1 > qidx); }
                    if (!v0) p0[r] = -__builtin_inff(); if (!v1) p1[r] = -__builtin_inff(); }
                softmax_tile<true>(p0, p1, m, l, o, wsf, r32, hi);
                bf16x8 pa[4]; pack_p(p0, p1, pa);
                pv(o, slot + 8192, pa, lane);
            }
            asm volatile("s_waitcnt vmcnt(0)" ::: "memory");
            __syncthreads();
        }
        l += swap_half(l);
        const float f = GT[2 * 32 + r32] / l;
        scale_rows(o, f, wsf, r32, hi);
#pragma unroll
        for (int r = 0; r < 16; ++r) { yacc[0][r] += o[0][r]; yacc[1][r] += o[1][r]; }
    }
    store_o(yacc, lds + N_OST + wid * 4096, ys + ((size_t)0 * M + rowb + T0 + 32 * qs) * 512 + h * 64, 512, lane);
    __syncthreads();
}
}
namespace cmpx {
using att::f32x16; using att::crow;
constexpr int C_HID = 0;
__device__ __forceinline__ void cmp_unit(const Ctx& C, const Args& a, int kv, int b, int g, int chalf, const bf16_t* proj, const bf16_t* w1t, const bf16_t* w2t, const float* bias1, bf16_t* kcvc) {
    LAS unsigned char* lds = C.lds; const int lane = C.lane, wid = C.wave, r32 = lane & 31, hi = lane >> 5;
    const size_t rowb = (size_t)b * SEQ;
    {
        const int mb = wid & 1, nb = wid >> 1; const int c = 64 * chalf + 32 * mb + r32, cl = c < 126 ? c : 126;
        const bf16_t* ap = proj + (rowb + 16 * cl) * LDP + (kv ? P_VC : P_KC) + g * 64 + 8 * hi;
        const bf16_t* b0p = w1t + (size_t)kv * 256 * 2048 + (size_t)(64 * nb + r32) * 2048 + 8 * hi; const bf16_t* b1p = b0p + 32 * 2048;
        f32x16 acc0, acc1;
#pragma unroll
        for (int r = 0; r < 16; ++r) { acc0[r] = 0.f; acc1[r] = 0.f; }
        bf16x8 af[4], bf0[4], bf1[4];
#pragma unroll
        for (int j = 0; j < 4; ++j) { af[j] = *(const bf16x8*)(ap + 16 * j); bf0[j] = *(const bf16x8*)(b0p + 16 * j); bf1[j] = *(const bf16x8*)(b1p + 16 * j); }
        for (int ll = 0; ll < 32; ++ll) {
            bf16x8 an[4], bn0[4], bn1[4]; const int ln = ll < 31 ? ll + 1 : 31;
#pragma unroll
            for (int j = 0; j < 4; ++j) { an[j] = *(const bf16x8*)(ap + (size_t)ln * LDP + 16 * j); bn0[j] = *(const bf16x8*)(b0p + 64 * ln + 16 * j); bn1[j] = *(const bf16x8*)(b1p + 64 * ln + 16 * j); }
#pragma unroll
            for (int j = 0; j < 4; ++j) { acc0 = __builtin_amdgcn_mfma_f32_32x32x16_bf16(af[j], bf0[j], acc0, 0, 0, 0); acc1 = __builtin_amdgcn_mfma_f32_32x32x16_bf16(af[j], bf1[j], acc1, 0, 0, 0); }
#pragma unroll
            for (int j = 0; j < 4; ++j) { af[j] = an[j]; bf0[j] = bn0[j]; bf1[j] = bn1[j]; }
        }
        const float bs0 = bias1[kv * 256 + 64 * nb + r32], bs1 = bias1[kv * 256 + 64 * nb + 32 + r32];
        LAS bf16_t* hid = (LAS bf16_t*)(lds + C_HID);
#pragma unroll
        for (int r = 0; r < 16; ++r) { const int row = 32 * mb + crow(r, hi);
            hid[row * 264 + 64 * nb + r32] = (bf16_t)f2bf(gelu_tanh(acc0[r] + bs0)); hid[row * 264 + 64 * nb + 32 + r32] = (bf16_t)f2bf(gelu_tanh(acc1[r] + bs1)); }
    }
    __syncthreads();
    if (wid < 4) {
        const int mb = wid & 1, db = wid >> 1;
        f32x16 acc;
#pragma unroll
        for (int r = 0; r < 16; ++r) acc[r] = 0.f;
        const bf16_t* bp = w2t + (size_t)kv * 64 * 256 + (size_t)(32 * db + r32) * 256 + 8 * hi;
#pragma unroll
        for (int s = 0; s < 16; ++s) { const bf16x8 af = *(const LAS bf16x8*)(lds + C_HID + (32 * mb + r32) * 528 + 32 * s + 16 * hi); const bf16x8 bfr = *(const bf16x8*)(bp + 16 * s);
            acc = __builtin_amdgcn_mfma_f32_32x32x16_bf16(af, bfr, acc, 0, 0, 0); }
        const bool rope = (kv == 0) && (db == 0);
        const float inv = powf(500000.0f, -(float)(2 * (r32 & 7)) / 16.0f);
#pragma unroll
        for (int r = 0; r < 16; ++r) { const int cidx = 64 * chalf + 32 * mb + crow(r, hi); float v = acc[r];
            if (rope) { const float vp = __shfl_xor(v, 8); const int cc = cidx < 126 ? cidx : 126; const float ang = (float)a.pos[b * SEQ + 16 * cc + 31] * inv; float sn, cs; sincosf(ang, &sn, &cs);
                if (r32 < 8) v = v * cs - vp * sn; else if (r32 < 16) v = v * cs + vp * sn; }
            kcvc[((((size_t)kv * NB + b) * 128 + cidx) * 2 + g) * 64 + 32 * db + r32] = (cidx < 127) ? (bf16_t)f2bf(v) : (bf16_t)0; }
    }
    __syncthreads();
}
__device__ __forceinline__ void rope_unit(const Ctx& C, const Args& a, int u, bf16_t* proj) {
    for (int i = C.tid; i < 256 * 12; i += NTHR) { const int tok = 256 * u + i / 12, j = i % 12; const int col = j < 8 ? P_NQ + j * 64 : (j < 10 ? P_KS + (j - 8) * 64 : P_KW + (j - 10) * 64);
        rope_rotate(proj + (size_t)tok * LDP + col, a.pos[tok]); }
}
}

#ifndef OPT_FOX
#define OPT_FOX 1
#endif
#ifndef OPT_SB
#define OPT_SB 1
#endif
#ifndef OPT_GLA
#define OPT_GLA 1
#endif
#ifndef OPT_NSA
#define OPT_NSA 1
#endif
#ifndef OPT_PREP
#define OPT_PREP 1
#endif
constexpr int CW_Q = 8192;
#define QLOOP(cntptr, total, ...) do { LAS unsigned* qs_ = (LAS unsigned*)(lds + MISC_OFF + 64); unsigned nxt_ = 0u; \
    if (threadIdx.x == 0) nxt_ = atomicAdd((cntptr), 1u); \
    for (;;) { if (threadIdx.x == 0) *qs_ = nxt_; __syncthreads(); const unsigned u = *qs_; if (u >= (unsigned)(total)) break; \
        if (threadIdx.x == 0) nxt_ = atomicAdd((cntptr), 1u); { __VA_ARGS__; } __syncthreads(); } __syncthreads(); } while (0)

__device__ __forceinline__ void phase_C(LAS unsigned char* lds, const Args& a, int l, unsigned* ctl, bf16_t* proj, bf16_t* ys, bf16_t* gqp, float* gdec, float* gds, float* goi) {
    unsigned* qc = ctl + CW_Q + (l * 16) * 64;
#if OPT_PREP
    { const Ctx C = make_ctx(lds); const bf16_t* w1t = (const bf16_t*)(a.ws + WS_CW1); const bf16_t* w2t = (const bf16_t*)(a.ws + WS_KC + 512 * 1024); const float* bias1 = (const float*)(a.ws + WS_KC + 576 * 1024); bf16_t* kcvc = (bf16_t*)(a.ws + WS_KC);
      QLOOP(qc + 0 * 64, 64, { const int chalf = u & 1, g = (u >> 1) & 1, b = (u >> 2) & 7, kv = (int)(u >> 5); cmpx::cmp_unit(C, a, kv, b, g, chalf, proj, w1t, w2t, bias1, kcvc); }); }
#endif
#if OPT_FOX
    { const Ctx C = make_ctx(lds); QLOOP(qc + 1 * 64, 512, { const int qb = 7 - (int)(u >> 6), bh = u & 63; att::fox_unit(C, bh >> 3, bh & 7, qb, proj, a.fox_b_f[l * 8 + (bh & 7)], ys); }); }
#endif
#if OPT_GLA
    { const Ctx C = make_ctx(lds); QLOOP(qc + 2 * 64, 1024, { const int c = u & 31, bh = u >> 5; gla::prep_unit(C, a, l, bh >> 2, bh & 3, c, proj, gqp, gdec, gds, goi); }); }
#endif
#if OPT_SB
    { const Ctx C = make_ctx(lds); QLOOP(qc + 3 * 64, 512, { const int qb = 7 - (int)(u >> 6), bh = u & 63; att::sb_unit(C, bh >> 3, bh & 7, qb, proj, ys); }); }
#endif
#if OPT_PREP
    { const Ctx C = make_ctx(lds); QLOOP(qc + 4 * 64, 64, { cmpx::rope_unit(C, a, (int)u, proj); }); }
#endif
}
__device__ __forceinline__ void phase_D(LAS unsigned char* lds, const Args& a, int l, unsigned* ctl, bf16_t* proj, bf16_t* ys, const bf16_t* kcvc, bf16_t* gqp, float* gdec, float* gds, float* goi) {
    unsigned* qc = ctl + CW_Q + (l * 16 + 8) * 64;
#if OPT_GLA
    { const Ctx C = make_ctx(lds); QLOOP(qc + 0 * 64, 32, { gla::seq_unit(C, a, l, (int)(u >> 2), (int)(u & 3), proj, gqp, gdec, gds, goi, ys); }); }
#endif
#if OPT_NSA
    { const Ctx C = make_ctx(lds); QLOOP(qc + 1 * 64, 512, { const int qt = 31 - (int)(u >> 4), bg = u & 15; nsa::nsa_unit(C, bg >> 1, bg & 1, qt, proj, kcvc, ys); }); }
#endif
}

__device__ __forceinline__ const Args* args_reload() {
#if defined(__HIP_DEVICE_COMPILE__)
    auto p_ = __builtin_amdgcn_kernarg_segment_ptr(); asm volatile("" : "+s"(p_)); return (const Args*)p_;
#else
    return nullptr;
#endif
}
#define ARGS_RELOAD() args_reload()
__global__ void __launch_bounds__(NTHR, 2) hybrid_fwd(Args a0) {
    extern __shared__ __attribute__((aligned(16))) unsigned char lds_raw[];
    LAS unsigned char* lds = (LAS unsigned char*)lds_raw;
    volatile LAS unsigned* MISC = (volatile LAS unsigned*)(lds + MISC_OFF);
    if (threadIdx.x < 64) MISC[threadIdx.x] = 0u;
    __syncthreads();
#if MK_ONE_LAUNCH
    XcdBarrier bar = xcd_barrier_post((unsigned*)(a0.ws + WS_CTL) + CW_BAR, MISC + 8);
#define GRID_BAR() xcd_barrier(bar)
#else
#define GRID_BAR() do {} while (0)
#endif
#ifndef PH_MASK
#define PH_MASK 0xFFFF
#endif
    const int l_lo = a0.l_lo, l_hi = a0.l_hi, p_lo = a0.p_lo, p_hi = a0.p_hi, do_final = a0.do_final;
#define IN(k) (((PH_MASK >> (k)) & 1) && p_lo <= (k) && (k) < p_hi)
#define WSP(T, off) ((T*)(a.ws + (off)))
    for (int l = l_lo; l < l_hi; ++l) {
        if (IN(0)) {
            const Args a = *ARGS_RELOAD(); unsigned char* ws = a.ws;
            const Ctx C = make_ctx(lds); int base = 0;
            transpose_matrix<true>(C, a.w_in + (size_t)l * DM * DIN, DM, DIN, LDP, WSP(bf16_t, WS_WIN), base);
            for (int z = 0; z < 4; ++z) transpose_matrix<false>(C, a.w_branch + ((size_t)l * 4 + z) * 512 * DM, 512, DM, DM, WSP(bf16_t, WS_WB) + (size_t)z * DM * 512, base);
            transpose_matrix<false>(C, a.w_out + (size_t)l * DM * DM, DM, DM, DM, WSP(bf16_t, WS_WO), base);
            transpose_matrix<false>(C, a.w_ff1 + (size_t)l * DM * DFF, DM, DFF, DFF, WSP(bf16_t, WS_WF1), base);
            transpose_matrix<false>(C, a.w_ff2 + (size_t)l * DFF * DM, DFF, DM, DM, WSP(bf16_t, WS_WF2), base);
#if OPT_PREP
            transpose_matrix<false>(C, a.cmp_wk1 + (size_t)l * 2048 * 256, 2048, 256, 256, (bf16_t*)(ws + WS_CW1), base);
            transpose_matrix<false>(C, a.cmp_wv1 + (size_t)l * 2048 * 256, 2048, 256, 256, (bf16_t*)(ws + WS_CW1) + 256 * 2048, base);
            transpose_matrix<false>(C, a.cmp_wk2 + (size_t)l * 256 * 64, 256, 64, 64, (bf16_t*)(ws + WS_KC + 512 * 1024), base);
            transpose_matrix<false>(C, a.cmp_wv2 + (size_t)l * 256 * 64, 256, 64, 64, (bf16_t*)(ws + WS_KC + 512 * 1024) + 64 * 256, base);
            for (int o = C.gw; o < 512; o += C.NGW) { const int kv = o >> 8, n = o & 255; const float* w1 = (kv ? a.cmp_wv1 : a.cmp_wk1) + (size_t)l * 2048 * 256; const float* pe = (kv ? a.cmp_pos_v : a.cmp_pos_k) + (size_t)l * 2048;
                float s = 0.f; for (int k = C.lane; k < 2048; k += 64) s += pe[k] * w1[(size_t)k * 256 + n]; s = wave_sum(s); if (C.lane == 0) ((float*)(ws + WS_KC + 576 * 1024))[o] = s; }
#endif
            rms_rows_phase(C, (l == 0) ? a.x : a.out, a.norm_mix + l * DM, WSP(bf16_t, WS_HB));
            GRID_BAR();
        }
        if (IN(1)) {
            const Args a = *ARGS_RELOAD();
            pg8::Gemm g{WSP(bf16_t, WS_HB), WSP(bf16_t, WS_WIN), DM, DM, DM, 0, 0}; pg8::StaticOrder S; S.init(M, LDP, gridDim.x, blockIdx.x);
            pg8::EpiBf16<0> E{WSP(bf16_t, WS_PROJ), LDP};
            pg8::gemm_phase(lds, g, S, E);
            GRID_BAR();
        }
        if (IN(2)) { const Args a = *ARGS_RELOAD(); phase_C(lds, a, l, WSP(unsigned, WS_CTL), WSP(bf16_t, WS_PROJ), WSP(bf16_t, WS_YS), WSP(bf16_t, WS_GQP), WSP(float, WS_GKP), WSP(float, WS_GDS), WSP(float, WS_GOI)); GRID_BAR(); }
        if (IN(3)) { const Args a = *ARGS_RELOAD(); phase_D(lds, a, l, WSP(unsigned, WS_CTL), WSP(bf16_t, WS_PROJ), WSP(bf16_t, WS_YS), WSP(bf16_t, WS_KC), WSP(bf16_t, WS_GQP), WSP(float, WS_GKP), WSP(float, WS_GDS), WSP(float, WS_GOI)); GRID_BAR(); }
        if (IN(5)) {
            const Args a = *ARGS_RELOAD();
            pg8::Gemm g{WSP(bf16_t, WS_YS), WSP(bf16_t, WS_WB), 512, 512, 512, (size_t)M * 512, (size_t)DM * 512}; pg8::ZOrder S; S.init(M, DM, gridDim.x, blockIdx.x); S.NZ = 4;
            pg8::EpiGate E{WSP(bf16_t, WS_PROJ), a.b_gate + (size_t)l * 4 * DM, WSP(float, WS_MIXF), WSP(bf16_t, WS_MIX)};
            pg8::gemm_phase(lds, g, S, E);
            GRID_BAR();
        }
        if (IN(6)) {
            const Args a = *ARGS_RELOAD();
            pg8::Gemm g{WSP(bf16_t, WS_MIX), WSP(bf16_t, WS_WO), DM, DM, DM, 0, 0}; pg8::StaticOrder S; S.init(M, DM, gridDim.x, blockIdx.x);
            pg8::EpiRes E{(l == 0) ? a.x : a.out, a.out, DM};
            pg8::gemm_phase(lds, g, S, E);
            GRID_BAR();
        }
        if (IN(7)) { const Args a = *ARGS_RELOAD(); const Ctx C = make_ctx(lds); rms_rows_phase(C, a.out, a.norm_ff + l * DM, WSP(bf16_t, WS_HB)); GRID_BAR(); }
        if (IN(8)) {
            const Args a = *ARGS_RELOAD();
            pg8::Gemm g{WSP(bf16_t, WS_HB), WSP(bf16_t, WS_WF1), DM, DM, DM, 0, 0}; pg8::StaticOrder S; S.init(M, DFF, gridDim.x, blockIdx.x);
            pg8::EpiBf16<1> E{WSP(bf16_t, WS_HID), DFF};
            pg8::gemm_phase(lds, g, S, E);
            GRID_BAR();
        }
        if (IN(9)) {
            const Args a = *ARGS_RELOAD();
            pg8::Gemm g{WSP(bf16_t, WS_HID), WSP(bf16_t, WS_WF2), DFF, DFF, DFF, 0, 0}; pg8::StaticOrder S; S.init(M, DM, gridDim.x, blockIdx.x);
            pg8::EpiRes E{a.out, a.out, DM};
            pg8::gemm_phase(lds, g, S, E);
            GRID_BAR();
        }
    }
    if (do_final) { const Args a = *ARGS_RELOAD(); const Ctx C = make_ctx(lds); final_norm_phase(C, a.out, a.norm_final); }
#undef IN
#undef WSP
}

#define NAIVE_CTX() extern __shared__ __attribute__((aligned(16))) unsigned char lds_raw[]; Ctx C; C.lds = (LAS unsigned char*)lds_raw; C.tid = threadIdx.x; C.lane = C.tid & 63; \
    C.wave = __builtin_amdgcn_readfirstlane(C.tid >> 6); C.G = gridDim.x; C.bid = blockIdx.x; C.gw = C.bid * NWAVES + C.wave; C.NGW = C.G * NWAVES; unsigned char* ws = a.ws; \
    bf16_t* ys = (bf16_t*)(ws + WS_YS); bf16_t* proj = (bf16_t*)(ws + WS_PROJ); float* cum = (float*)(ws + WS_CUM); float* ch = (float*)(ws + WS_CH); bf16_t* kcvc = (bf16_t*)(ws + WS_KC); \
    float* gds = (float*)(ws + WS_GDS); float* goi = (float*)(ws + WS_GOI); (void)ys; (void)proj; (void)cum; (void)ch; (void)kcvc; (void)gds; (void)goi;
__global__ void __launch_bounds__(NTHR, 2) k_prepA(Args a) { NAIVE_CTX(); naive_prepA(C, a, a.l_lo, proj, cum, ch); }
__global__ void __launch_bounds__(NTHR, 2) k_prepB(Args a) { NAIVE_CTX(); naive_prepB(C, a, a.l_lo, ch, kcvc); }
__global__ void __launch_bounds__(NTHR, 2) k_gla(Args a) { NAIVE_CTX(); naive_gla(C, a, a.l_lo, proj, goi, ys); }
__global__ void __launch_bounds__(NTHR, 2) k_nsa(Args a) { NAIVE_CTX(); naive_nsa(C, proj, kcvc, (float*)(ws + WS_MIX), ys); }
__global__ void __launch_bounds__(NTHR, 2) k_fox(Args a) { NAIVE_CTX(); naive_fox(C, proj, cum, ys); }
__global__ void __launch_bounds__(NTHR, 2) k_sb(Args a) { NAIVE_CTX(); naive_sb(C, proj, ys); }

extern "C" void kernel_launch(void* const* d_in, const int* in_sizes, int n_in, void* d_out, int out_size, void* d_ws, size_t ws_size, hipStream_t stream) {
    static int grid = 0;
    if (grid == 0) {
        if (n_in != 21 || in_sizes[0] != M * DM || out_size != M * DM || ws_size < WS_END) { fprintf(stderr, "kernel_launch: shape/ws mismatch (n_in %d, ws %zu, need %zu)\n", n_in, ws_size, (size_t)WS_END); grid = -1; return; }
        int dev = 0, cus = 0, per_cu = 0;
        if (hipGetDevice(&dev) != hipSuccess || hipDeviceGetAttribute(&cus, hipDeviceAttributeMultiprocessorCount, dev) != hipSuccess) { grid = -1; return; }
        if (hipFuncSetAttribute((const void*)hybrid_fwd, hipFuncAttributeMaxDynamicSharedMemorySize, LDS_BYTES) != hipSuccess) { grid = -1; return; }
        if (hipOccupancyMaxActiveBlocksPerMultiprocessor(&per_cu, (const void*)hybrid_fwd, NTHR, LDS_BYTES) != hipSuccess || per_cu < 1) { fprintf(stderr, "kernel_launch: occupancy query says %d\n", per_cu); }
        (void)hipGetLastError();
        grid = cus;
    }
    if (grid < 0) return;
    (void)hipMemsetAsync((char*)d_ws + WS_CTL, 0, CTL_BYTES, stream);
    Args a{};
    a.x = (const float*)d_in[0]; a.pos = (const int*)d_in[1]; a.norm_mix = (const float*)d_in[2]; a.w_in = (const float*)d_in[3]; a.b_gate = (const float*)d_in[4];
    a.cmp_pos_k = (const float*)d_in[5]; a.cmp_pos_v = (const float*)d_in[6]; a.cmp_wk1 = (const float*)d_in[7]; a.cmp_wk2 = (const float*)d_in[8]; a.cmp_wv1 = (const float*)d_in[9]; a.cmp_wv2 = (const float*)d_in[10];
    a.gla_w_alpha = (const float*)d_in[11]; a.gla_b_alpha = (const float*)d_in[12]; a.gla_norm = (const float*)d_in[13]; a.fox_b_f = (const float*)d_in[14];
    a.w_branch = (const float*)d_in[15]; a.w_out = (const float*)d_in[16]; a.norm_ff = (const float*)d_in[17]; a.w_ff1 = (const float*)d_in[18]; a.w_ff2 = (const float*)d_in[19]; a.norm_final = (const float*)d_in[20];
    a.out = (float*)d_out; a.ws = (unsigned char*)d_ws; a.pad = 0;
#if MK_ONE_LAUNCH
    a.l_lo = 0; a.l_hi = NL; a.p_lo = 0; a.p_hi = 10; a.do_final = 1;
    hipLaunchKernelGGL(hybrid_fwd, dim3(grid), dim3(NTHR), LDS_BYTES, stream, a);
#else
    for (int l = 0; l < NL; ++l)
        for (int p = 0; p < 10; ++p) { a.l_lo = l; a.l_hi = l + 1; a.p_lo = p; a.p_hi = p + 1; a.do_final = 0;
            if (p == 4) continue;
            if (p == 2 && !OPT_PREP) { hipLaunchKernelGGL(k_prepA, dim3(grid), dim3(NTHR), 0, stream, a); hipLaunchKernelGGL(k_prepB, dim3(grid), dim3(NTHR), 0, stream, a); }
            if (p == 3) {
                if (!OPT_GLA) hipLaunchKernelGGL(k_gla, dim3(32), dim3(NTHR), 8192, stream, a);
                if (!OPT_NSA) hipLaunchKernelGGL(k_nsa, dim3(64), dim3(NTHR), 65536, stream, a);
                if (!OPT_FOX) hipLaunchKernelGGL(k_fox, dim3(grid), dim3(NTHR), 0, stream, a);
                if (!OPT_SB) hipLaunchKernelGGL(k_sb, dim3(grid), dim3(NTHR), 0, stream, a);
            }
            hipLaunchKernelGGL(hybrid_fwd, dim3(grid), dim3(NTHR), LDS_BYTES, stream, a); }
    a.l_lo = 0; a.l_hi = 0; a.p_lo = 0; a.p_hi = 0; a.do_final = 1;
    hipLaunchKernelGGL(hybrid_fwd, dim3(grid), dim3(NTHR), LDS_BYTES, stream, a);
#endif
}
```

```cpp
#include <hip/hip_runtime.h>
#include <cstdio>
#include <cstdint>

#ifndef MK_ONE_LAUNCH
#define MK_ONE_LAUNCH 1
#endif

#define GAS __attribute__((address_space(1)))
#define LAS __attribute__((address_space(3)))
typedef unsigned short bf16_t;
typedef short bf16x8 __attribute__((ext_vector_type(8)));
typedef float f32x4 __attribute__((ext_vector_type(4)));
typedef float f32x2 __attribute__((ext_vector_type(2)));
typedef unsigned u32x4 __attribute__((ext_vector_type(4)));
typedef unsigned u32x2 __attribute__((ext_vector_type(2)));

constexpr int NB = 8, SEQ = 2048, M = NB * SEQ, DM = 1024, NL = 4, DIN = 10032, LDP = 10240, DFF = 4096;
constexpr float EPS = 1e-6f;
constexpr int P_NQ = 0, P_KC = 512, P_VC = 640, P_KS = 768, P_VS = 896, P_KW = 1024, P_VW = 1152;
constexpr int P_SQ = 1280, P_SK = 1792, P_SV = 2304;
constexpr int P_GQ = 2816, P_GK = 3072, P_GV = 3328, P_GG = 3840;
constexpr int P_FQ = 4352, P_FK = 4864, P_FV = 5376;
constexpr int P_GATE = 5888, P_NG = 9984, P_GA = 10008, P_FF = 10024;
__host__ __device__ __forceinline__ int win_src_col(int n) {
    if (n < 1280) return n;
    if (n < 3840) return n + 24;
    if (n < 5888) return n + 40;
    if (n < 9984) return n + 48;
    if (n < 10008) return n - 9984 + 1280;
    if (n < 10024) return n - 10008 + 3864;
    if (n < 10032) return n - 10024 + 5928;
    return -1;
}

constexpr size_t MiB = 1u << 20;
constexpr size_t WS_CTL = 0, CTL_BYTES = 1 * MiB;
constexpr size_t WS_WIN = 1 * MiB;
constexpr size_t WS_WB = 21 * MiB;
constexpr size_t WS_WO = 25 * MiB;
constexpr size_t WS_WF1 = 27 * MiB;
constexpr size_t WS_WF2 = 35 * MiB;
constexpr size_t WS_CW1 = 43 * MiB;
constexpr size_t WS_KC = 45 * MiB;
constexpr size_t WS_CUM = 46 * MiB;
constexpr size_t WS_CH = 47 * MiB;
constexpr size_t WS_HB = 52 * MiB;
constexpr size_t WS_MIX = 84 * MiB;
constexpr size_t WS_YS = 116 * MiB;
constexpr size_t WS_GQP = 180 * MiB;
constexpr size_t WS_GKP = 188 * MiB;
constexpr size_t WS_GKPP = 196 * MiB;
constexpr size_t WS_GDS = 204 * MiB;
constexpr size_t WS_GOI = 236 * MiB;
constexpr size_t WS_MIXF = WS_GDS;
constexpr size_t WS_PROJ = 268 * MiB;
constexpr size_t WS_HID = WS_PROJ;
constexpr size_t WS_END = 588 * MiB;

constexpr int CW_BAR = 4096;

constexpr int RING_BYTES = 131072;
constexpr int MISC_OFF = 146944;
constexpr int LDS_BYTES = 147456;
constexpr int NWAVES = 8, NTHR = 512;

__device__ __forceinline__ unsigned f2bf(float f) { unsigned u = __builtin_bit_cast(unsigned, f); return (u + 0x7fffu + ((u >> 16) & 1u)) >> 16; }
__device__ __forceinline__ unsigned pk2(float lo, float hi) { return f2bf(lo) | (f2bf(hi) << 16); }
__device__ __forceinline__ float bf2f(unsigned short b) { return __builtin_bit_cast(float, ((unsigned)b) << 16); }
__device__ __forceinline__ float bflo(unsigned w) { return __builtin_bit_cast(float, w << 16); }
__device__ __forceinline__ float bfhi(unsigned w) { return __builtin_bit_cast(float, w & 0xffff0000u); }
__device__ __forceinline__ float wave_sum(float v) {
#pragma unroll
    for (int o = 1; o < 64; o <<= 1) v += __shfl_xor(v, o);
    return v;
}
__device__ __forceinline__ float sigmoidf_(float x) { return __builtin_amdgcn_rcpf(1.0f + __builtin_amdgcn_exp2f(-1.4426950408889634f * x)); }
__device__ __forceinline__ float softplusf_(float x) { return fmaxf(x, 0.f) + log1pf(__expf(-fabsf(x))); }
__device__ __forceinline__ float logsigmoidf_(float x) { return fminf(x, 0.f) - log1pf(__expf(-fabsf(x))); }

#define XB_TMO      128
#define XB_XCNT(j)  (256  + 64 * (j))
#define XB_XSUB(j)  (1280 + 64 * (j))
#define XB_XGEN(j)  (2304 + 64 * (j))
#define XB_TOP      3328
#define XB_TOPGEN   3392
#define XCD_BAR_WORDS 3456
#define XB_SPIN_CAP (1u << 18)
__device__ __forceinline__ unsigned xb_ld(unsigned* p)              { return __hip_atomic_load(p, __ATOMIC_RELAXED, __HIP_MEMORY_SCOPE_AGENT); }
__device__ __forceinline__ unsigned xb_add(unsigned* p, unsigned v) { return __hip_atomic_fetch_add(p, v, __ATOMIC_RELAXED, __HIP_MEMORY_SCOPE_AGENT); }
__device__ __forceinline__ unsigned xb_xcc_id() { return (unsigned)__builtin_amdgcn_s_getreg((3 << 11) | 20) & 0xFu; }
#define XB_SPIN(cond, bar) do { unsigned _sp = 0; while (cond) { __builtin_amdgcn_s_sleep(1); \
    if ((++_sp & 255u) == 0u) { if (xb_ld(&(bar)[XB_TMO])) break; if (_sp > XB_SPIN_CAP) { atomicAdd(&(bar)[XB_TMO], 1u); break; } } } } while (0)
struct XcdBarrier { unsigned* bar; unsigned x; volatile LAS unsigned* st; };
__device__ __forceinline__ XcdBarrier xcd_barrier_post(unsigned* bar, volatile LAS unsigned* st) {
    XcdBarrier b; b.bar = bar; b.x = xb_xcc_id(); b.st = st;
    if (threadIdx.x == 0) (void)xb_add(&bar[XB_XCNT(b.x)], 1u);
    return b;
}
__device__ __forceinline__ void xcd_barrier_complete(unsigned* bar, unsigned x, unsigned& nloc, unsigned& nx) {
    const unsigned G = gridDim.x * gridDim.y * gridDim.z;
    unsigned sum, cnt, mine, sp = 0u;
    for (;;) {
        sum = 0u; cnt = 0u; mine = 0u;
#pragma unroll
        for (unsigned j = 0; j < 16; ++j) { const unsigned c = xb_ld(&bar[XB_XCNT(j)]); sum += c; cnt += (c > 0u) ? 1u : 0u; mine = (j == x) ? c : mine; }
        if (sum == G) break;
        __builtin_amdgcn_s_sleep(1);
        if ((++sp & 255u) == 0u) { if (xb_ld(&bar[XB_TMO])) break; if (sp > XB_SPIN_CAP) { atomicAdd(&bar[XB_TMO], 1u); break; } }
    }
    nloc = mine > 0u ? mine : 1u; nx = cnt > 0u ? cnt : 1u;
}
__device__ __forceinline__ void xcd_barrier(const XcdBarrier& b) {
    asm volatile("s_waitcnt vmcnt(0)" ::: "memory");
    __syncthreads();
    if (threadIdx.x == 0) {
        unsigned* bar = b.bar;
        __builtin_amdgcn_s_waitcnt(0);
        unsigned nloc = b.st[0], nx = b.st[1];
        if (nloc == 0u) { xcd_barrier_complete(bar, b.x, nloc, nx); b.st[0] = nloc; b.st[1] = nx; }
        const unsigned old = xb_add(&bar[XB_XSUB(b.x)], 1u);
        const unsigned gen = old / nloc;
        if (old + 1u == (gen + 1u) * nloc) {
            __builtin_amdgcn_fence(__ATOMIC_RELEASE, "agent");
            asm volatile("s_waitcnt vmcnt(0)" ::: "memory");
            const unsigned og = xb_add(&bar[XB_TOP], 1u);
            const unsigned tg = og / nx;
            if (og + 1u == (tg + 1u) * nx) xb_add(&bar[XB_TOPGEN], 1u);
            else XB_SPIN(xb_ld(&bar[XB_TOPGEN]) == tg, bar);
            __builtin_amdgcn_fence(__ATOMIC_ACQUIRE, "agent");
            xb_add(&bar[XB_XGEN(b.x)], 1u);
            asm volatile("s_waitcnt vmcnt(0)" ::: "memory");
        } else {
            XB_SPIN(xb_ld(&bar[XB_XGEN(b.x)]) == gen, bar);
            __builtin_amdgcn_fence(__ATOMIC_ACQUIRE, "agent");
            asm volatile("s_waitcnt vmcnt(0)" ::: "memory");
        }
    }
    __syncthreads();
}

namespace pg8 {
constexpr int BM = 256, BK = 64, HALF = 128, HTB = HALF * BK * 2, STAGE_BYTES = 8 * HTB, NXCD = 8, WGM = 8;
__host__ __device__ __forceinline__ int lds_byte(int r, int c) { const int st = (r >> 4) * 2 + (c >> 5), rr = r & 15, cc = c & 31, ob = rr * 64 + cc * 2; return st * 1024 + (ob ^ (((ob >> 9) & 1) << 5)); }
__host__ __device__ __forceinline__ void stage_rc(int b, int& R, int& C) { const int st = b / 1024, sb = b % 1024, swz = sb ^ (((sb >> 9) & 1) << 5); R = (st >> 1) * 16 + swz / 64; C = (st & 1) * 32 + (swz % 64) / 2; }
__host__ __device__ __forceinline__ int perm32(int rho) { const int n = rho >> 4, i = rho & 15; return 8 * (i >> 2) + 4 * n + (i & 3); }

struct Unit { int pm, pn, z; };
struct Gemm { const bf16_t* A; const bf16_t* Bt; int lda, ldb, K; size_t zA, zB; };

struct StaticOrder {
    int nM, nN, nwg, G, c;
    __host__ __device__ void init(int M_, int N_, int G_, int c_) { nM = M_ / BM; nN = N_ / BM; nwg = nM * nN; G = G_; c = c_; }
    __host__ __device__ bool tile(long L, Unit& u) const {
        if (L >= nwg) return false;
        int wgid = (int)L; { const int q = nwg / NXCD, r = nwg % NXCD, xcd = wgid % NXCD, off = wgid / NXCD; wgid = (xcd < r ? xcd * (q + 1) : r * (q + 1) + (xcd - r) * q) + off; }
        const int nig = WGM * nN, gid = wgid / nig, fm = gid * WGM, gsz = (nM - fm) < WGM ? (nM - fm) : WGM;
        u.pm = fm + ((wgid % nig) % gsz); u.pn = (wgid % nig) / gsz; u.z = 0; return true;
    }
    __host__ __device__ bool next(int i, Unit& u) const { return tile((long)i * G + c, u); }
};
struct ZOrder : StaticOrder {
    int NZ;
    __host__ __device__ bool next(int i, Unit& u) const { const int ti = i / NZ; if (!tile((long)ti * G + c, u)) return false; u.z = i - ti * NZ; return true; }
};

__device__ __forceinline__ unsigned cvt_pk_bf16(float lo, float hi) { unsigned r; asm volatile("v_cvt_pk_bf16_f32 %0, %1, %2" : "=v"(r) : "v"(lo), "v"(hi)); return r; }

struct NoState {};
template <int ACT  > struct EpiBf16 {
    static constexpr bool PERM = true, HALFN = false; typedef NoState State;
    bf16_t* O; int ldc;
    __device__ __forceinline__ void operator()(const f32x4 (&acc)[2][2][4][2], NoState&, const Unit& u, int wr, int wc, int fr, int fq) const {
        const int row0 = u.pm * BM + wr * 64 + fr; const int col0 = u.pn * BM + wc * 32 + 8 * fq;
#pragma unroll
        for (int ai = 0; ai < 2; ++ai)
#pragma unroll
            for (int m = 0; m < 4; ++m) { bf16_t* rowp = O + (size_t)(row0 + ai * HALF + m * 16) * ldc + col0;
#pragma unroll
                for (int bj = 0; bj < 2; ++bj) { f32x4 v0 = acc[ai][bj][m][0], v1 = acc[ai][bj][m][1];
                    if (ACT == 1) {
#pragma unroll
                        for (int j = 0; j < 4; ++j) { const float a = fmaxf(v0[j], 0.f), b = fmaxf(v1[j], 0.f); v0[j] = a * a; v1[j] = b * b; } }
                    u32x4 w; w.x = cvt_pk_bf16(v0[0], v0[1]); w.y = cvt_pk_bf16(v0[2], v0[3]); w.z = cvt_pk_bf16(v1[0], v1[1]); w.w = cvt_pk_bf16(v1[2], v1[3]);
                    *(u32x4*)(rowp + bj * HALF) = w; } }
    }
};
struct EpiRes {
    static constexpr bool PERM = false, HALFN = false; typedef NoState State;
    const float* base; float* out; int ldc;
    __device__ __forceinline__ void operator()(const f32x4 (&acc)[2][2][4][2], NoState&, const Unit& u, int wr, int wc, int fr, int fq) const {
        const int row0 = u.pm * BM + wr * 64 + fr, col0 = u.pn * BM + wc * 32 + 4 * fq;
#pragma unroll
        for (int ai = 0; ai < 2; ++ai) {
            f32x4 bs[4][2][2];
#pragma unroll
            for (int m = 0; m < 4; ++m) { const size_t off = (size_t)(row0 + ai * HALF + m * 16) * ldc + col0;
#pragma unroll
                for (int bj = 0; bj < 2; ++bj)
#pragma unroll
                    for (int n = 0; n < 2; ++n) bs[m][bj][n] = *(const f32x4*)(base + off + bj * HALF + n * 16); }
#pragma unroll
            for (int m = 0; m < 4; ++m) { const size_t off = (size_t)(row0 + ai * HALF + m * 16) * ldc + col0;
#pragma unroll
                for (int bj = 0; bj < 2; ++bj)
#pragma unroll
                    for (int n = 0; n < 2; ++n) *(f32x4*)(out + off + bj * HALF + n * 16) = bs[m][bj][n] + acc[ai][bj][m][n]; }
        }
    }
};
struct GateSum { f32x4 v[2][4][2]; };
struct EpiGate {
    static constexpr bool PERM = false, HALFN = true; typedef GateSum State;
    const bf16_t* proj; const float* b_gate; bf16_t* mix;
    __device__ __forceinline__ void operator()(const f32x4 (&acc)[2][1][4][2], GateSum& st, const Unit& u, int wr, int wc, int fr, int fq) const {
        const int row0 = u.pm * BM + wr * 64 + fr, col0 = u.pn * HALF + wc * 32 + 4 * fq; const int z = u.z;
        f32x4 bg[2];
#pragma unroll
        for (int n = 0; n < 2; ++n) bg[n] = *(const f32x4*)(b_gate + z * DM + col0 + n * 16);
#pragma unroll
        for (int ai = 0; ai < 2; ++ai) {
            u32x2 gl[4][2];
#pragma unroll
            for (int m = 0; m < 4; ++m)
#pragma unroll
                for (int n = 0; n < 2; ++n) gl[m][n] = *(const u32x2*)(proj + (size_t)(row0 + ai * HALF + m * 16) * LDP + P_GATE + z * DM + col0 + n * 16);
#pragma unroll
            for (int m = 0; m < 4; ++m)
#pragma unroll
                for (int n = 0; n < 2; ++n) { const u32x2 g2 = gl[m][n]; const f32x4 b4 = bg[n]; const f32x4 av = acc[ai][0][m][n];
                    f32x4 t = (z == 0) ? (f32x4){0.f, 0.f, 0.f, 0.f} : st.v[ai][m][n];
                    t[0] += sigmoidf_(bflo(g2.x) + b4[0]) * av[0]; t[1] += sigmoidf_(bfhi(g2.x) + b4[1]) * av[1];
                    t[2] += sigmoidf_(bflo(g2.y) + b4[2]) * av[2]; t[3] += sigmoidf_(bfhi(g2.y) + b4[3]) * av[3];
                    st.v[ai][m][n] = t;
                    if (z == 3) { u32x2 w; w.x = cvt_pk_bf16(t[0], t[1]); w.y = cvt_pk_bf16(t[2], t[3]); *(u32x2*)(mix + (size_t)(row0 + ai * HALF + m * 16) * DM + col0 + n * 16) = w; } }
        }
    }
};

template <class Epi, class Sched>
__device__ __forceinline__ void gemm_phase(LAS unsigned char* lds, const Gemm g, const Sched& S, const Epi& E) {
    int tid_ = threadIdx.x; asm volatile("" : "+v"(tid_));
    const int tid = tid_, wid = __builtin_amdgcn_readfirstlane(tid >> 6), lane = tid & 63, wr = wid >> 2, wc = wid & 3, fr = lane & 15, fq = lane >> 4;
    const int K = g.K, nt = K / BK;
    unsigned voffA[2], voffB[2];
#pragma unroll
    for (int i = 0; i < 2; ++i) { int R, C; stage_rc(tid * 16 + i * 8192, R, C); const int Rb = Epi::PERM ? ((R & ~31) + perm32(R & 31)) : R;
        voffA[i] = (unsigned)(R * g.lda + C) * 2u; voffB[i] = (unsigned)(Rb * g.ldb + C) * 2u; }
    const size_t kstep = (size_t)(BK * 2);
    constexpr bool HN = Epi::HALFN; constexpr int NBJ = HN ? 1 : 2;
    const size_t hstepA = (size_t)HALF * g.lda * 2, hstepB = HN ? (size_t)0 : (size_t)HALF * g.ldb * 2, bunit = HN ? (size_t)HALF * g.ldb * 2 : (size_t)2 * HALF * g.ldb * 2;
    const unsigned ldsw = (unsigned)wid * 1024u;
    const int aoff = lds_byte(wr * 64 + fr, fq * 8), boff = lds_byte(wc * 32 + fr, fq * 8);
#define PG8_SA(b, h) (((b) * 2 + (h)) * HTB)
#define PG8_SB(b, h) ((4 + (b) * 2 + (h)) * HTB)
#define PG8_STAGE(bufoff, gbase, voff) do { _Pragma("unroll") for (int _i = 0; _i < 2; ++_i) \
        __builtin_amdgcn_global_load_lds((const unsigned*)((const char*)(gbase) + (voff)[_i]), (LAS unsigned*)(lds + (bufoff) + ldsw + _i * 8192), 16, 0, 0); } while (0)
#define PG8_LDA(dst, b, h) do { _Pragma("unroll") for (int m = 0; m < 4; ++m) _Pragma("unroll") for (int k = 0; k < 2; ++k) dst[m][k] = *(const LAS bf16x8*)(lds + PG8_SA(b, h) + aoff + m * 2048 + k * 1024); } while (0)
#define PG8_LDB(dst, b, h) do { _Pragma("unroll") for (int n = 0; n < 2; ++n) _Pragma("unroll") for (int k = 0; k < 2; ++k) dst[n][k] = *(const LAS bf16x8*)(lds + PG8_SB(b, h) + boff + n * 2048 + k * 1024); } while (0)
#define PG8_MMA(ai, bj, At, Bt) do { __builtin_amdgcn_s_setprio(1); _Pragma("unroll") for (int m = 0; m < 4; ++m) _Pragma("unroll") for (int n = 0; n < 2; ++n) _Pragma("unroll") for (int k = 0; k < 2; ++k) \
        acc[ai][bj][m][n] = __builtin_amdgcn_mfma_f32_16x16x32_bf16(Bt[n][k], At[m][k], acc[ai][bj][m][n], 0, 0, 0); __builtin_amdgcn_s_setprio(0); } while (0)
#define PG8_WAIT_V(n) asm volatile("s_waitcnt vmcnt(" #n ")" ::: "memory")
#define PG8_WAIT_L(n) asm volatile("s_waitcnt lgkmcnt(" #n ")" ::: "memory")
#define PG8_BAR __builtin_amdgcn_s_barrier()
#define PG8_SCHED __builtin_amdgcn_sched_barrier(0)
#define PG8_APTR(u) ((const char*)g.A + ((size_t)(u).z * g.zA) * 2 + (size_t)(u).pm * 2 * hstepA)
#define PG8_BPTR(u) ((const char*)g.Bt + ((size_t)(u).z * g.zB) * 2 + (size_t)(u).pn * bunit)
    Unit cur, nxt; int ui = 0;
    if (!S.next(0, cur)) return;
    f32x4 acc[2][NBJ][4][2]; typename Epi::State est;
#pragma unroll
    for (int a = 0; a < 2; ++a)
#pragma unroll
        for (int b = 0; b < NBJ; ++b)
#pragma unroll
            for (int m = 0; m < 4; ++m)
#pragma unroll
                for (int n = 0; n < 2; ++n) acc[a][b][m][n] = (f32x4){0.f, 0.f, 0.f, 0.f};
    bf16x8 At[4][2], B0[2][2], B1[2][2];
    const char* cA = PG8_APTR(cur); const char* cB = PG8_BPTR(cur);
    PG8_STAGE(PG8_SB(0, 0), cB, voffB); PG8_STAGE(PG8_SA(0, 0), cA, voffA); PG8_STAGE(PG8_SB(0, 1), cB + hstepB, voffB); PG8_STAGE(PG8_SA(0, 1), cA + hstepA, voffA);
    if (wr == 1) PG8_BAR;
    PG8_WAIT_V(4); PG8_BAR;
    PG8_STAGE(PG8_SB(1, 0), cB + kstep, voffB); PG8_STAGE(PG8_SA(1, 0), cA + kstep, voffA); PG8_STAGE(PG8_SB(1, 1), cB + hstepB + kstep, voffB);
    PG8_WAIT_V(6); PG8_BAR;
    for (;;) {
        const bool has_next = S.next(ui + 1, nxt);
        const char* nA = has_next ? PG8_APTR(nxt) : cA; const char* nB = has_next ? PG8_BPTR(nxt) : cB;
        for (int t = 0; t < nt; t += 2) {
            const bool last = (t == nt - 2);
            const char* a1 = cA + (size_t)(t + 1) * kstep;
            const char* a2 = last ? nA : cA + (size_t)(t + 2) * kstep; const char* b2 = last ? nB : cB + (size_t)(t + 2) * kstep;
            const char* a3 = a2 + kstep; const char* b3 = b2 + kstep;
            PG8_LDB(B0, 0, 0); PG8_SCHED; PG8_LDA(At, 0, 0); PG8_STAGE(PG8_SA(1, 1), a1 + hstepA, voffA);
            PG8_WAIT_L(8); PG8_BAR; PG8_WAIT_L(0); PG8_MMA(0, 0, At, B0); PG8_BAR; PG8_SCHED;
            if constexpr (!HN) PG8_LDB(B1, 0, 1); PG8_STAGE(PG8_SB(0, 0), b2, voffB);
            PG8_BAR; PG8_WAIT_L(0); if constexpr (!HN) PG8_MMA(0, 1, At, B1); PG8_BAR;
            PG8_LDA(At, 0, 1); PG8_STAGE(PG8_SA(0, 0), a2, voffA);
            PG8_BAR; PG8_WAIT_L(0); PG8_MMA(1, 0, At, B0); PG8_BAR; PG8_SCHED;
            PG8_STAGE(PG8_SB(0, 1), b2 + hstepB, voffB);
            PG8_WAIT_V(6); PG8_BAR; if constexpr (!HN) PG8_MMA(1, 1, At, B1); PG8_BAR;
            PG8_LDB(B0, 1, 0); PG8_SCHED; PG8_LDA(At, 1, 0); PG8_STAGE(PG8_SA(0, 1), a2 + hstepA, voffA);
            PG8_WAIT_L(8); PG8_BAR; PG8_WAIT_L(0); PG8_MMA(0, 0, At, B0); PG8_BAR; PG8_SCHED;
            if constexpr (!HN) PG8_LDB(B1, 1, 1); PG8_STAGE(PG8_SB(1, 0), b3, voffB);
            PG8_BAR; PG8_WAIT_L(0); if constexpr (!HN) PG8_MMA(0, 1, At, B1); PG8_BAR;
            PG8_LDA(At, 1, 1); PG8_STAGE(PG8_SA(1, 0), a3, voffA);
            PG8_BAR; PG8_WAIT_L(0); PG8_MMA(1, 0, At, B0); PG8_BAR; PG8_SCHED;
            PG8_STAGE(PG8_SB(1, 1), b3 + hstepB, voffB);
            PG8_WAIT_V(6); PG8_BAR; if constexpr (!HN) PG8_MMA(1, 1, At, B1); PG8_BAR;
        }
        E(acc, est, cur, wr, wc, fr, fq);
        if (!has_next) break;
#pragma unroll
        for (int a = 0; a < 2; ++a)
#pragma unroll
            for (int b = 0; b < NBJ; ++b)
#pragma unroll
                for (int m = 0; m < 4; ++m)
#pragma unroll
                    for (int n = 0; n < 2; ++n) acc[a][b][m][n] = (f32x4){0.f, 0.f, 0.f, 0.f};
        cur = nxt; cA = nA; cB = nB; ++ui;
    }
    PG8_WAIT_V(0);
    if (wr == 0) PG8_BAR;
    PG8_BAR;
#undef PG8_SA
#undef PG8_SB
#undef PG8_STAGE
#undef PG8_LDA
#undef PG8_LDB
#undef PG8_MMA
#undef PG8_WAIT_V
#undef PG8_WAIT_L
#undef PG8_BAR
#undef PG8_SCHED
#undef PG8_APTR
#undef PG8_BPTR
}
}

struct Args {
    const float* x; const int* pos; const float* norm_mix; const float* w_in; const float* b_gate;
    const float* cmp_pos_k; const float* cmp_pos_v; const float* cmp_wk1; const float* cmp_wk2; const float* cmp_wv1; const float* cmp_wv2;
    const float* gla_w_alpha; const float* gla_b_alpha; const float* gla_norm; const float* fox_b_f;
    const float* w_branch; const float* w_out; const float* norm_ff; const float* w_ff1; const float* w_ff2; const float* norm_final;
    float* out; unsigned char* ws;
    int l_lo, l_hi, p_lo, p_hi, do_final, pad;
};

struct Ctx { LAS unsigned char* lds; int tid, lane, wave, G, bid, gw, NGW; };
__device__ __forceinline__ Ctx make_ctx(LAS unsigned char* lds) {
    Ctx C; int t = threadIdx.x; asm volatile("" : "+v"(t));
    C.lds = lds; C.tid = t; C.lane = t & 63; C.wave = __builtin_amdgcn_readfirstlane(t >> 6); C.G = gridDim.x; C.bid = blockIdx.x; C.gw = C.bid * NWAVES + C.wave; C.NGW = C.G * NWAVES; return C;
}

template <bool MAP>
__device__ __forceinline__ void transpose_item(const float* W, int Nsrc, int Kdim, bf16_t* WT, LAS float* scr, int k0, int n0, int lane) {
    const int nn = n0 + (lane & 31); const int sc = MAP ? win_src_col(nn) : nn;
#pragma unroll 8
    for (int i = 0; i < 32; ++i) { const int kk = 2 * i + (lane >> 5); scr[kk * 33 + (lane & 31)] = (sc >= 0) ? W[(size_t)(k0 + kk) * Nsrc + sc] : 0.f; }
    asm volatile("s_waitcnt lgkmcnt(0)" ::: "memory");
    const int c = lane & 7;
#pragma unroll
    for (int j = 0; j < 4; ++j) { const int n = (lane >> 3) + 8 * j; const LAS float* s = scr + (8 * c) * 33 + n;
        u32x4 o; o.x = pk2(s[0 * 33], s[1 * 33]); o.y = pk2(s[2 * 33], s[3 * 33]); o.z = pk2(s[4 * 33], s[5 * 33]); o.w = pk2(s[6 * 33], s[7 * 33]);
        *(u32x4*)(WT + (size_t)(n0 + n) * Kdim + k0 + 8 * c) = o; }
    asm volatile("s_waitcnt lgkmcnt(0)" ::: "memory");
}
template <bool MAP>
__device__ __forceinline__ void transpose_matrix(const Ctx& C, const float* W, int Kdim, int Nsrc, int Ndst, bf16_t* WT, int& base) {
    LAS float* scr = (LAS float*)(C.lds + C.wave * 16384);
    const int nblk = Ndst / 32, items = (Kdim / 64) * nblk;
    int first = (C.gw - base % C.NGW + C.NGW) % C.NGW;
    for (int it = first; it < items; it += C.NGW) { const int kb = it / nblk, nb = it % nblk; transpose_item<MAP>(W, Nsrc, Kdim, WT, scr, 64 * kb, 32 * nb, C.lane); }
    base += items;
}
__device__ __forceinline__ void rms_row_bf16(const float* xrow, const float* g, bf16_t* orow, int lane) {
    const f32x4* xr = (const f32x4*)xrow + lane; const f32x4* gr = (const f32x4*)g + lane;
    f32x4 v[4]; float s = 0.f;
#pragma unroll
    for (int j = 0; j < 4; ++j) { v[j] = xr[64 * j]; s += (v[j].x * v[j].x + v[j].y * v[j].y) + (v[j].z * v[j].z + v[j].w * v[j].w); }
    const float r = rsqrtf(wave_sum(s) * (1.f / DM) + EPS);
    unsigned long long* o8 = (unsigned long long*)orow + lane;
#pragma unroll
    for (int j = 0; j < 4; ++j) { const f32x4 gg = gr[64 * j];
        o8[64 * j] = (unsigned long long)pk2(v[j].x * r * gg.x, v[j].y * r * gg.y) | ((unsigned long long)pk2(v[j].z * r * gg.z, v[j].w * r * gg.w) << 32); }
}
__device__ __forceinline__ void rms_rows_phase(const Ctx& C, const float* x, const float* g, bf16_t* hb) {
    for (int m = C.gw; m < M; m += C.NGW) rms_row_bf16(x + (size_t)m * DM, g, hb + (size_t)m * DM, C.lane);
}
__device__ __forceinline__ void final_norm_phase(const Ctx& C, float* x, const float* g) {
    for (int m = C.gw; m < M; m += C.NGW) {
        f32x4* xr = (f32x4*)(x + (size_t)m * DM) + C.lane; const f32x4* gr = (const f32x4*)g + C.lane;
        f32x4 v[4]; float s = 0.f;
#pragma unroll
        for (int j = 0; j < 4; ++j) { v[j] = xr[64 * j]; s += (v[j].x * v[j].x + v[j].y * v[j].y) + (v[j].z * v[j].z + v[j].w * v[j].w); }
        const float r = rsqrtf(wave_sum(s) * (1.f / DM) + EPS);
#pragma unroll
        for (int j = 0; j < 4; ++j) xr[64 * j] = v[j] * r * gr[64 * j];
    }
}

__device__ __forceinline__ void ld8(const bf16_t* p, float (&o)[8]) {
    const u32x4 w = *(const u32x4*)p;
    o[0] = bflo(w.x); o[1] = bfhi(w.x); o[2] = bflo(w.y); o[3] = bfhi(w.y); o[4] = bflo(w.z); o[5] = bfhi(w.z); o[6] = bflo(w.w); o[7] = bfhi(w.w);
}
__device__ __forceinline__ float dot64(const float (&q)[64], const bf16_t* k) {
    float s = 0.f;
#pragma unroll
    for (int c = 0; c < 8; ++c) { float kv[8]; ld8(k + 8 * c, kv);
#pragma unroll
        for (int j = 0; j < 8; ++j) s += q[8 * c + j] * kv[j]; }
    return s;
}
__device__ __forceinline__ void axpy64(float (&acc)[64], float p, const bf16_t* v) {
#pragma unroll
    for (int c = 0; c < 8; ++c) { float vv[8]; ld8(v + 8 * c, vv);
#pragma unroll
        for (int j = 0; j < 8; ++j) acc[8 * c + j] += p * vv[j]; }
}
__device__ __forceinline__ void ldq64(float (&q)[64], const bf16_t* p, float scale) {
#pragma unroll
    for (int c = 0; c < 8; ++c) { float t[8]; ld8(p + 8 * c, t);
#pragma unroll
        for (int j = 0; j < 8; ++j) q[8 * c + j] = t[j] * scale; }
}
struct OS { float m, l; };
#define OS_STEP(sc) do { const float mn_ = fmaxf(st.m, (sc)); const float al_ = __expf(st.m - mn_); const float p_ = __expf((sc) - mn_); st.l = st.l * al_ + p_; \
    _Pragma("unroll") for (int d_ = 0; d_ < 64; ++d_) acc[d_] *= al_; axpy64(acc, p_, vrow); st.m = mn_; } while (0)

__device__ __forceinline__ void rope_rotate(bf16_t* p, int posv) {
    u32x4 a = *(u32x4*)p, b = *(u32x4*)(p + 8);
    float x1[8] = {bflo(a.x), bfhi(a.x), bflo(a.y), bfhi(a.y), bflo(a.z), bfhi(a.z), bflo(a.w), bfhi(a.w)};
    float x2[8] = {bflo(b.x), bfhi(b.x), bflo(b.y), bfhi(b.y), bflo(b.z), bfhi(b.z), bflo(b.w), bfhi(b.w)};
    float o1[8], o2[8];
#pragma unroll
    for (int i = 0; i < 8; ++i) { const float inv = powf(500000.0f, -(float)(2 * i) / 16.0f); const float ang = (float)posv * inv; float sn, cs; sincosf(ang, &sn, &cs);
        o1[i] = x1[i] * cs - x2[i] * sn; o2[i] = x2[i] * cs + x1[i] * sn; }
    a.x = pk2(o1[0], o1[1]); a.y = pk2(o1[2], o1[3]); a.z = pk2(o1[4], o1[5]); a.w = pk2(o1[6], o1[7]);
    b.x = pk2(o2[0], o2[1]); b.y = pk2(o2[2], o2[3]); b.z = pk2(o2[4], o2[5]); b.w = pk2(o2[6], o2[7]);
    *(u32x4*)p = a; *(u32x4*)(p + 8) = b;
}
__device__ __forceinline__ float gelu_tanh(float x) { const float u = 0.7978845608028654f * (x + 0.044715f * x * x * x); return 0.5f * x * (1.0f + tanhf(u)); }

__device__ __forceinline__ void naive_prepA(const Ctx& C, const Args& a, int l, bf16_t* proj, float* cum, float* ch) {
    const int gt = C.bid * NTHR + C.tid, NT = C.G * NTHR;
    for (int i = gt; i < M * 12; i += NT) { const int tok = i / 12, j = i % 12; const int col = j < 8 ? P_NQ + j * 64 : (j < 10 ? P_KS + (j - 8) * 64 : P_KW + (j - 10) * 64);
        rope_rotate(proj + (size_t)tok * LDP + col, a.pos[tok]); }
    for (int bh = C.gw; bh < NB * 8; bh += C.NGW) { const int b = bh >> 3, h = bh & 7; const float bf = a.fox_b_f[l * 8 + h];
        float loc[32]; float run = 0.f;
#pragma unroll
        for (int i = 0; i < 32; ++i) { const int s = C.lane * 32 + i; const float f = bf2f(proj[(size_t)(b * SEQ + s) * LDP + P_FF + h]); run += logsigmoidf_(f + bf); loc[i] = run; }
        float incl = run;
#pragma unroll
        for (int o = 1; o < 64; o <<= 1) { const float t = __shfl_up(incl, o); if (C.lane >= o) incl += t; }
        const float excl = incl - run;
#pragma unroll
        for (int i = 0; i < 32; ++i) cum[(size_t)bh * SEQ + C.lane * 32 + i] = excl + loc[i]; }
    const int NCH = 2 * NB * 127 * 2 * 256;
    for (int i = gt; i < NCH; i += NT) { const int j = i & 255; int r = i >> 8; const int g = r & 1; r >>= 1; const int c = r % 127; r /= 127; const int b = r % NB; const int kv = r / NB;
        const float* w1 = (kv ? a.cmp_wv1 : a.cmp_wk1) + (size_t)l * 2048 * 256; const float* pe = (kv ? a.cmp_pos_v : a.cmp_pos_k) + (size_t)l * 32 * 64;
        const int col = (kv ? P_VC : P_KC) + g * 64; float s = 0.f;
        for (int ll = 0; ll < 32; ++ll) { const bf16_t* xr = proj + (size_t)(b * SEQ + 16 * c + ll) * LDP + col;
            for (int d8 = 0; d8 < 8; ++d8) { float xv[8]; ld8(xr + 8 * d8, xv);
#pragma unroll
                for (int d = 0; d < 8; ++d) s += (xv[d] + pe[ll * 64 + d8 * 8 + d]) * w1[(size_t)(ll * 64 + d8 * 8 + d) * 256 + j]; } }
        ch[i] = gelu_tanh(s); }
}
__device__ __forceinline__ void naive_prepB(const Ctx& C, const Args& a, int l, const float* ch, bf16_t* kcvc) {
    const int gt = C.bid * NTHR + C.tid, NT = C.G * NTHR; const int NO = 2 * NB * 127 * 2 * 64;
    for (int i = gt; i < 2 * NB * 128; i += NT) { const int kv = i / (NB * 128), b = (i / 128) % NB, e = i % 128; kcvc[((((size_t)kv * NB + b) * 128 + 127) * 2) * 64 + e] = 0; }
    for (int i = gt; i < NO; i += NT) { const int d = i & 63; int r = i >> 6; const int g = r & 1; r >>= 1; const int c = r % 127; r /= 127; const int b = r % NB; const int kv = r / NB;
        const float* w2 = (kv ? a.cmp_wv2 : a.cmp_wk2) + (size_t)l * 256 * 64; const float* hrow = ch + ((((size_t)kv * NB + b) * 127 + c) * 2 + g) * 256;
        float v = 0.f, vp = 0.f; const int dp = (d < 8) ? d + 8 : d - 8;
        for (int j = 0; j < 256; ++j) { const float hv = hrow[j]; v += hv * w2[j * 64 + d]; if (d < 16) vp += hv * w2[j * 64 + dp]; }
        if (kv == 0 && d < 16) { const int i8 = d & 7; const float inv = powf(500000.0f, -(float)(2 * i8) / 16.0f); const float ang = (float)a.pos[b * SEQ + 16 * c + 31] * inv; float sn, cs; sincosf(ang, &sn, &cs);
            v = (d < 8) ? (v * cs - vp * sn) : (v * cs + vp * sn); }
        kcvc[((((size_t)kv * NB + b) * 128 + c) * 2 + g) * 64 + d] = (bf16_t)f2bf(v); }
}

__device__ __forceinline__ void naive_fox(const Ctx& C, const bf16_t* proj, const float* cum, bf16_t* ys) {
    for (int blk = C.bid; blk < NB * 8 * 4; blk += C.G) { const int bh = blk >> 2, b = bh >> 3, h = bh & 7; const int t = (blk & 3) * 512 + C.tid;
        const size_t rowb = (size_t)b * SEQ; float q[64]; ldq64(q, proj + (rowb + t) * LDP + P_FQ + h * 64, 0.125f);
        const float ct = cum[(size_t)bh * SEQ + t]; float acc[64];
#pragma unroll
        for (int d = 0; d < 64; ++d) acc[d] = 0.f;
        OS st; st.m = -1e30f; st.l = 0.f; const int tmax = t | 63;
        for (int s = 0; s <= tmax; ++s) { const bf16_t* krow = proj + (rowb + s) * LDP + P_FK + h * 64; const bf16_t* vrow = proj + (rowb + s) * LDP + P_FV + h * 64;
            if (s <= t) { const float sc = dot64(q, krow) + ct - cum[(size_t)bh * SEQ + s]; OS_STEP(sc); } }
        const float il = 1.f / st.l; bf16_t* o = ys + ((size_t)3 * M + rowb + t) * 512 + h * 64;
#pragma unroll
        for (int d = 0; d < 64; d += 2) *(unsigned*)(o + d) = pk2(acc[d] * il, acc[d + 1] * il); }
}
__device__ __forceinline__ void naive_sb(const Ctx& C, const bf16_t* proj, bf16_t* ys) {
    for (int blk = C.bid; blk < NB * 8 * 4; blk += C.G) { const int bh = blk >> 2, b = bh >> 3, h = bh & 7; const int t = (blk & 3) * 512 + C.tid;
        const size_t rowb = (size_t)b * SEQ; float q[64]; ldq64(q, proj + (rowb + t) * LDP + P_SQ + h * 64, 0.125f);
        float acc[64];
#pragma unroll
        for (int d = 0; d < 64; ++d) acc[d] = 0.f;
        float R = 0.f; const int tmax = t | 63;
        for (int s = tmax - 1; s >= 0; --s) { const bf16_t* krow = proj + (rowb + s) * LDP + P_SK + h * 64; const bf16_t* vrow = proj + (rowb + s) * LDP + P_SV + h * 64;
            if (s < t) { const float z = dot64(q, krow); const float sp = softplusf_(z); const float av = __expf(z - sp - R); axpy64(acc, av, vrow); R += sp; } }
        bf16_t* o = ys + ((size_t)1 * M + rowb + t) * 512 + h * 64;
#pragma unroll
        for (int d = 0; d < 64; d += 2) *(unsigned*)(o + d) = pk2(acc[d], acc[d + 1]); }
}
__device__ __forceinline__ void naive_gla(const Ctx& C, const Args& a, int l, const bf16_t* proj, float* obuf, bf16_t* ys) {
    LAS float* red = (LAS float*)C.lds;
    for (int bh = C.bid; bh < NB * 4; bh += C.G) { const int b = bh >> 2, h = bh & 3; const int kk = C.tid >> 3, vs = C.tid & 7; const size_t rowb = (size_t)b * SEQ;
        float wa[16];
#pragma unroll
        for (int r = 0; r < 16; ++r) wa[r] = a.gla_w_alpha[(size_t)l * 16 * 256 + r * 256 + h * 64 + kk];
        const float ba = a.gla_b_alpha[l * 256 + h * 64 + kk];
        float stt[16];
#pragma unroll
        for (int i = 0; i < 16; ++i) stt[i] = 0.f;
        for (int t = 0; t < SEQ; ++t) { const bf16_t* pr = proj + (rowb + t) * LDP;
            float al[16]; { float t0[8], t1[8]; ld8(pr + P_GA, t0); ld8(pr + P_GA + 8, t1);
#pragma unroll
                for (int r = 0; r < 8; ++r) { al[r] = t0[r]; al[8 + r] = t1[r]; } }
            float xa = ba;
#pragma unroll
            for (int r = 0; r < 16; ++r) xa += al[r] * wa[r];
            const float dec = __expf(logsigmoidf_(xa) * (1.0f / 16.0f));
            const float kv = bf2f(pr[P_GK + h * 64 + kk]), qv = bf2f(pr[P_GQ + h * 64 + kk]) * 0.125f;
            float vv[16]; { float t0[8], t1[8]; ld8(pr + P_GV + h * 128 + vs * 16, t0); ld8(pr + P_GV + h * 128 + vs * 16 + 8, t1);
#pragma unroll
                for (int r = 0; r < 8; ++r) { vv[r] = t0[r]; vv[8 + r] = t1[r]; } }
            float po[16];
#pragma unroll
            for (int i = 0; i < 16; ++i) { stt[i] = dec * stt[i] + kv * vv[i]; po[i] = qv * stt[i]; }
#pragma unroll
            for (int i = 0; i < 16; ++i) { po[i] += __shfl_xor(po[i], 8); po[i] += __shfl_xor(po[i], 16); po[i] += __shfl_xor(po[i], 32); }
            LAS float* rb = red + (t & 1) * 1024 + C.wave * 128;
            if (C.lane < 8) {
#pragma unroll
                for (int i = 0; i < 16; ++i) rb[C.lane * 16 + i] = po[i]; }
            __syncthreads();
            if (C.tid < 128) { float s = 0.f;
#pragma unroll
                for (int w = 0; w < 8; ++w) s += red[(t & 1) * 1024 + w * 128 + C.tid];
                obuf[(rowb + t) * 512 + h * 128 + C.tid] = s; } }
        __syncthreads();
        for (int t = C.wave; t < SEQ; t += NWAVES) { const float* orow = obuf + (rowb + t) * 512 + h * 128; const float o0 = orow[C.lane], o1 = orow[C.lane + 64];
            const float ss = wave_sum(o0 * o0 + o1 * o1); const float r = rsqrtf(ss * (1.f / 128.f) + EPS);
            const bf16_t* gp = proj + (rowb + t) * LDP + P_GG + h * 128; const float g0 = bf2f(gp[C.lane]), g1 = bf2f(gp[C.lane + 64]);
            const float n0 = a.gla_norm[l * 128 + C.lane], n1 = a.gla_norm[l * 128 + C.lane + 64];
            bf16_t* yo = ys + ((size_t)2 * M + rowb + t) * 512 + h * 128;
            yo[C.lane] = (bf16_t)f2bf(o0 * r * n0 * (g0 * sigmoidf_(g0))); yo[C.lane + 64] = (bf16_t)f2bf(o1 * r * n1 * (g1 * sigmoidf_(g1))); }
        __syncthreads(); }
}
__device__ __forceinline__ void naive_nsa(const Ctx& C, const bf16_t* proj, const bf16_t* kcvc, float* yf, bf16_t* ys) {
    LAS float* imp = (LAS float*)C.lds;
    for (int blk = C.bid; blk < NB * 2 * 4; blk += C.G) { const int bg = blk >> 2, b = bg >> 1, g = bg & 1; const int t = (blk & 3) * 512 + C.tid; const size_t rowb = (size_t)b * SEQ;
        const bf16_t* prow = proj + (rowb + t) * LDP;
#pragma unroll
        for (int j = 0; j < 32; ++j) imp[j * 512 + C.tid] = 0.f;
        const int ncv = (t >= 31) ? ((t - 31) / 16 + 1) : 0; const int tw = t | 63; const int ncv_w = (tw >= 31) ? ((tw - 31) / 16 + 1) : 0;
        const bf16_t* kc = kcvc + (((size_t)0 * NB + b) * 128 * 2 + g) * 64; const bf16_t* vc = kcvc + (((size_t)1 * NB + b) * 128 * 2 + g) * 64;
        for (int hp = 0; hp < 4; ++hp) { const int h = g * 4 + hp; float q[64]; ldq64(q, prow + P_NQ + h * 64, 0.125f);
            float m = -1e30f, lsum = 0.f;
            for (int c = 0; c < ncv_w; ++c) if (c < ncv) { const float sc = dot64(q, kc + (size_t)c * 128); const float mn = fmaxf(m, sc); lsum = lsum * __expf(m - mn) + __expf(sc - mn); m = mn; }
            float acc[64];
#pragma unroll
            for (int d = 0; d < 64; ++d) acc[d] = 0.f;
            const float il = (ncv > 0) ? 1.f / lsum : 0.f;
            for (int c = 0; c < ncv_w; ++c) if (c < ncv) { const float sc = dot64(q, kc + (size_t)c * 128); const float p = __expf(sc - m) * il; axpy64(acc, p, vc + (size_t)c * 128);
                const int j = c >> 2, r = c & 3;
                if (r < 3) imp[j * 512 + C.tid] += p; else { imp[j * 512 + C.tid] += 0.5f * p; imp[(j + 1) * 512 + C.tid] += 0.5f * p; } }
            const float gc = sigmoidf_(bf2f(prow[P_NG + h * 3 + 0])); float* yo = yf + (rowb + t) * 512 + h * 64;
#pragma unroll
            for (int d = 0; d < 64; ++d) yo[d] = gc * acc[d]; }
        const int jt = t >> 6;
#pragma unroll
        for (int j = 0; j < 32; ++j) { float v = imp[j * 512 + C.tid]; if (j == 0 || j == jt) v = __builtin_inff(); else if (64 * j > t) v = -__builtin_inff(); imp[j * 512 + C.tid] = v; }
        unsigned sel = 0u;
        for (int j = 0; j < 32; ++j) { const float vj = imp[j * 512 + C.tid]; int rank = 0;
            for (int j2 = 0; j2 < 32; ++j2) { const float v2 = imp[j2 * 512 + C.tid]; rank += (v2 > vj || (v2 == vj && j2 < j)) ? 1 : 0; }
            if (rank < 8) sel |= (1u << j); }
        const int twmin = t & ~63;
        for (int hp = 0; hp < 4; ++hp) { const int h = g * 4 + hp; float q[64]; ldq64(q, prow + P_NQ + h * 64, 0.125f);
            float* yo = yf + (rowb + t) * 512 + h * 64;
            { float acc[64];
#pragma unroll
              for (int d = 0; d < 64; ++d) acc[d] = 0.f;
              OS st; st.m = -1e30f; st.l = 0.f;
              for (int s = 0; s <= tw; ++s) { if (s <= t && ((sel >> (s >> 6)) & 1u)) { const bf16_t* krow = proj + (rowb + s) * LDP + P_KS + g * 64; const bf16_t* vrow = proj + (rowb + s) * LDP + P_VS + g * 64;
                    const float sc = dot64(q, krow); OS_STEP(sc); } }
              const float gs = sigmoidf_(bf2f(prow[P_NG + h * 3 + 1])) / st.l;
#pragma unroll
              for (int d = 0; d < 64; ++d) yo[d] += gs * acc[d]; }
            { float acc[64];
#pragma unroll
              for (int d = 0; d < 64; ++d) acc[d] = 0.f;
              OS st; st.m = -1e30f; st.l = 0.f; const int slo = (twmin - 255) > 0 ? (twmin - 255) : 0;
              for (int s = slo; s <= tw; ++s) { if (s <= t && s > t - 256) { const bf16_t* krow = proj + (rowb + s) * LDP + P_KW + g * 64; const bf16_t* vrow = proj + (rowb + s) * LDP + P_VW + g * 64;
                    const float sc = dot64(q, krow); OS_STEP(sc); } }
              const float gw = sigmoidf_(bf2f(prow[P_NG + h * 3 + 2])) / st.l; bf16_t* o = ys + ((size_t)0 * M + rowb + t) * 512 + h * 64;
#pragma unroll
              for (int d = 0; d < 64; d += 2) *(unsigned*)(o + d) = pk2(yo[d] + gw * acc[d], yo[d + 1] + gw * acc[d + 1]); } }
        __syncthreads(); }
}

namespace att {
typedef float f32x16 __attribute__((ext_vector_type(16)));
typedef short s16x4 __attribute__((ext_vector_type(4)));
constexpr float LOG2E = 1.4426950408889634f;
constexpr float CS = 0.125f * LOG2E;
constexpr int SLOT = 16384;
constexpr int L_RING = 0, L_WSF = 65536, L_OST = 67584, L_X = 100352;
#define RING_WAIT() do { asm volatile("s_waitcnt vmcnt(4) lgkmcnt(0)" ::: "memory"); __builtin_amdgcn_s_barrier(); asm volatile("" ::: "memory"); } while (0)
#define RING_DRAIN() do { asm volatile("s_waitcnt vmcnt(0) lgkmcnt(0)" ::: "memory"); __builtin_amdgcn_s_barrier(); asm volatile("" ::: "memory"); } while (0)
__device__ __forceinline__ int crow(int r, int hi) { return (r & 3) + 8 * (r >> 2) + 4 * hi; }
__device__ __forceinline__ unsigned cvtpk(float lo, float hi) { unsigned r; asm volatile("v_cvt_pk_bf16_f32 %0, %1, %2" : "=v"(r) : "v"(lo), "v"(hi)); return r; }
__device__ __forceinline__ float swap_half(float v) { return __shfl_xor(v, 32); }

__device__ __forceinline__ void dma_kv(LAS unsigned char* slot, const bf16_t* kbase, const bf16_t* vbase, int pitch, int wid, int lane) {
    const bf16_t* ks = kbase + (size_t)lane * pitch + wid * 8;
    const bf16_t* vs = vbase + (size_t)(16 * (wid & 3) + (lane >> 2)) * pitch + (wid >> 2) * 32 + (lane & 3) * 8;
    __builtin_amdgcn_global_load_lds((const unsigned*)ks, (LAS unsigned*)(slot + wid * 1024), 16, 0, 0);
    __builtin_amdgcn_global_load_lds((const unsigned*)vs, (LAS unsigned*)(slot + 8192 + wid * 1024), 16, 0, 0);
}
__device__ __forceinline__ void qkt(f32x16& p0, f32x16& p1, const LAS unsigned char* kslot, const bf16x8 (&qr)[4], int r32, int hi) {
    const LAS unsigned char* kb = kslot + hi * 1024 + r32 * 16;
    const f32x16 z = {0.f, 0.f, 0.f, 0.f, 0.f, 0.f, 0.f, 0.f, 0.f, 0.f, 0.f, 0.f, 0.f, 0.f, 0.f, 0.f};
    bf16x8 kf[8];
#pragma unroll
    for (int d0 = 0; d0 < 4; ++d0) { kf[2 * d0] = *(const LAS bf16x8*)(kb + d0 * 2048); kf[2 * d0 + 1] = *(const LAS bf16x8*)(kb + d0 * 2048 + 512); }
    __builtin_amdgcn_sched_barrier(0);
    p0 = z; p1 = z;
#pragma unroll
    for (int d0 = 0; d0 < 4; ++d0) {
        p0 = __builtin_amdgcn_mfma_f32_32x32x16_bf16(kf[2 * d0], qr[d0], p0, 0, 0, 0);
        p1 = __builtin_amdgcn_mfma_f32_32x32x16_bf16(kf[2 * d0 + 1], qr[d0], p1, 0, 0, 0);
    }
}
typedef short v4i16_t __attribute__((ext_vector_type(4)));
__device__ __forceinline__ s16x4 vtr(const LAS unsigned char* p) { return __builtin_bit_cast(s16x4, __builtin_amdgcn_ds_read_tr16_b64_v4i16((LAS v4i16_t*)p)); }
__device__ __forceinline__ bf16x8 vfrag(const LAS unsigned char* vslot, int dh, int ks, int lane) {
    const int hi = lane >> 5;
    const LAS unsigned char* p = vslot + dh * 4096 + ks * 1024 + ((lane >> 4) & 1) * 32 + (lane & 3) * 8 + (4 * hi + ((lane & 15) >> 2)) * 64;
    const s16x4 lo = vtr(p), hh = vtr(p + 512);
    return (bf16x8){lo[0], lo[1], lo[2], lo[3], hh[0], hh[1], hh[2], hh[3]};
}
__device__ __forceinline__ void pack_p(const f32x16& p0, const f32x16& p1, bf16x8 (&pa)[4]) {
    u32x4 w;
    w.x = cvtpk(p0[0], p0[1]); w.y = cvtpk(p0[2], p0[3]); w.z = cvtpk(p0[4], p0[5]); w.w = cvtpk(p0[6], p0[7]); pa[0] = __builtin_bit_cast(bf16x8, w);
    w.x = cvtpk(p0[8], p0[9]); w.y = cvtpk(p0[10], p0[11]); w.z = cvtpk(p0[12], p0[13]); w.w = cvtpk(p0[14], p0[15]); pa[1] = __builtin_bit_cast(bf16x8, w);
    w.x = cvtpk(p1[0], p1[1]); w.y = cvtpk(p1[2], p1[3]); w.z = cvtpk(p1[4], p1[5]); w.w = cvtpk(p1[6], p1[7]); pa[2] = __builtin_bit_cast(bf16x8, w);
    w.x = cvtpk(p1[8], p1[9]); w.y = cvtpk(p1[10], p1[11]); w.z = cvtpk(p1[12], p1[13]); w.w = cvtpk(p1[14], p1[15]); pa[3] = __builtin_bit_cast(bf16x8, w);
}
__device__ __forceinline__ void pv(f32x16 (&o)[2], const LAS unsigned char* vslot, const bf16x8 (&pa)[4], int lane) {
    const int hi = lane >> 5;
    const unsigned vb = (unsigned)(uintptr_t)vslot + ((lane >> 4) & 1) * 32 + (lane & 3) * 8 + (4 * hi + ((lane & 15) >> 2)) * 64;
    s16x4 lo[8], hh[8];
#define PV_RD(i) do { asm volatile("ds_read_b64_tr_b16 %0, %1 offset:%c2" : "=&v"(lo[i]) : "v"(vb), "i"(((i) >> 2) * 4096 + ((i) & 3) * 1024) : "memory"); \
                      asm volatile("ds_read_b64_tr_b16 %0, %1 offset:%c2" : "=&v"(hh[i]) : "v"(vb), "i"(((i) >> 2) * 4096 + ((i) & 3) * 1024 + 512) : "memory"); } while (0)
    PV_RD(0); PV_RD(1); PV_RD(2); PV_RD(3); PV_RD(4); PV_RD(5); PV_RD(6); PV_RD(7);
#undef PV_RD
    asm volatile("s_waitcnt lgkmcnt(0)" ::: "memory"); __builtin_amdgcn_sched_barrier(0);
#pragma unroll
    for (int d0 = 0; d0 < 2; ++d0)
#pragma unroll
        for (int ks = 0; ks < 4; ++ks) { const int i = d0 * 4 + ks; const bf16x8 vf = (bf16x8){lo[i][0], lo[i][1], lo[i][2], lo[i][3], hh[i][0], hh[i][1], hh[i][2], hh[i][3]};
            o[d0] = __builtin_amdgcn_mfma_f32_32x32x16_bf16(pa[ks], vf, o[d0], 0, 0, 0); }
}
__device__ __forceinline__ float rowmax32(const f32x16& p0, const f32x16& p1) {
    float a = fmaxf(p0[0], p1[0]);
#pragma unroll
    for (int r = 1; r < 16; ++r) a = fmaxf(a, fmaxf(p0[r], p1[r]));
    return fmaxf(a, swap_half(a));
}
__device__ __forceinline__ void scale_rows(f32x16 (&o)[2], float f, LAS float* wsf, int r32, int hi) {
    if (hi == 0) wsf[r32] = f;
    asm volatile("s_waitcnt lgkmcnt(0)" ::: "memory");
#pragma unroll
    for (int g4 = 0; g4 < 4; ++g4) { const f32x4 fv = *(const LAS f32x4*)(wsf + 8 * g4 + 4 * hi);
#pragma unroll
        for (int j = 0; j < 4; ++j) { o[0][4 * g4 + j] *= fv[j]; o[1][4 * g4 + j] *= fv[j]; } }
    asm volatile("s_waitcnt lgkmcnt(0)" ::: "memory");
}
template <bool RAW>
__device__ __forceinline__ void softmax_tile(f32x16& p0, f32x16& p1, float& m, float& l, f32x16 (&o)[2], LAS float* wsf, int r32, int hi) {
    const float sc = RAW ? CS : 1.0f;
    const float mx = rowmax32(p0, p1);
    const float mnew = fmaxf(m, mx);
    if (__any(mnew > m)) { const float al = __builtin_amdgcn_exp2f((m - mnew) * sc); l *= al; scale_rows(o, al, wsf, r32, hi); }
    m = mnew;
    const float nm = -m * sc; float s = 0.f;
#pragma unroll
    for (int r = 0; r < 16; ++r) { p0[r] = __builtin_amdgcn_exp2f(__builtin_fmaf(p0[r], sc, nm)); p1[r] = __builtin_amdgcn_exp2f(__builtin_fmaf(p1[r], sc, nm)); s += p0[r] + p1[r]; }
    l += s;
}
__device__ __forceinline__ void store_o(const f32x16 (&o)[2], LAS unsigned char* ost_w, bf16_t* dst, int pitch, int lane) {
    const int r32 = lane & 31, hi = lane >> 5;
    LAS bf16_t* stg = (LAS bf16_t*)ost_w;
#pragma unroll
    for (int r = 0; r < 16; ++r) { const int orow = crow(r, hi);
#pragma unroll
        for (int d0 = 0; d0 < 2; ++d0) stg[orow * 64 + d0 * 32 + r32] = (bf16_t)f2bf(o[d0][r]); }
    asm volatile("s_waitcnt lgkmcnt(0)" ::: "memory");
#pragma unroll
    for (int i = 0; i < 4; ++i) { const int row = i * 8 + (lane >> 3), ch = lane & 7; const u32x4 v = *(const LAS u32x4*)(stg + row * 64 + ch * 8); *(u32x4*)(dst + (size_t)row * pitch + ch * 8) = v; }
    asm volatile("s_waitcnt lgkmcnt(0)" ::: "memory");
}
__device__ __forceinline__ void load_q(bf16x8 (&qr)[4], const bf16_t* qrow, int hi) {
#pragma unroll
    for (int d0 = 0; d0 < 4; ++d0) qr[d0] = *(const bf16x8*)(qrow + d0 * 16 + hi * 8);
}

__device__ __forceinline__ void foxprep_unit(const Ctx& C, int b, int h, const bf16_t* proj, float bfh, float* cum, float* knm) {
    LAS unsigned char* lds = C.lds; const int lane = C.lane, wid = C.wave, tid = C.tid;
    LAS float* wtot = (LAS float*)(lds + L_X); LAS float* tmax = (LAS float*)(lds + L_X + 64);
    const size_t rowb = (size_t)b * SEQ; const int bh = b * 8 + h;
    float c4[4]; float run = 0.f; float nmax = 0.f;
#pragma unroll
    for (int i = 0; i < 4; ++i) { const int s = 4 * tid + i; const bf16_t* pr = proj + (rowb + s) * LDP;
        run += logsigmoidf_(bf2f(pr[P_FF + h]) + bfh); c4[i] = run;
        float n2 = 0.f;
#pragma unroll
        for (int c = 0; c < 8; ++c) { float kv[8]; ld8(pr + P_FK + h * 64 + 8 * c, kv);
#pragma unroll
            for (int j = 0; j < 8; ++j) n2 += kv[j] * kv[j]; }
        nmax = fmaxf(nmax, n2); }
    float incl = run;
#pragma unroll
    for (int o = 1; o < 64; o <<= 1) { const float t = __shfl_up(incl, o); if (lane >= o) incl += t; }
    if (lane == 63) wtot[wid] = incl;
    nmax = fmaxf(nmax, __shfl_xor(nmax, 1)); nmax = fmaxf(nmax, __shfl_xor(nmax, 2)); nmax = fmaxf(nmax, __shfl_xor(nmax, 4)); nmax = fmaxf(nmax, __shfl_xor(nmax, 8));
    if ((tid & 15) == 0) tmax[tid >> 4] = sqrtf(nmax);
    __syncthreads();
    float off = incl - run;
#pragma unroll
    for (int w = 0; w < 8; ++w) off += (w < wid) ? wtot[w] : 0.f;
#pragma unroll
    for (int i = 0; i < 4; ++i) cum[(size_t)bh * SEQ + 4 * tid + i] = off + c4[i];
    if (tid == 0) { float pm = 0.f; for (int t = 0; t < 32; ++t) { pm = fmaxf(pm, tmax[t]); knm[bh * 32 + t] = pm; } }
    __syncthreads();
}
template <int ABL>
__device__ __forceinline__ void fox_unit(const Ctx& C, int b, int h, int qb, const bf16_t* proj, const float* cum, const float* knm, bf16_t* ys) {
    LAS unsigned char* lds = C.lds; const int lane = C.lane, wid = C.wave, r32 = lane & 31, hi = lane >> 5, tid = C.tid;
    LAS float* cumL = (LAS float*)(lds + L_X);
    LAS float* pmL = (LAS float*)(lds + L_X + 8192);
    LAS unsigned* votes = (LAS unsigned*)(lds + L_X + 8192 + 128);
    LAS float* wsf = (LAS float*)(lds + L_WSF) + wid * 64;
    const size_t rowb = (size_t)b * SEQ; const int Q0 = qb * 256, NT = 4 * qb + 4, bh = b * 8 + h;
    const bf16_t* kb = proj + rowb * LDP + P_FK + h * 64; const bf16_t* vb = proj + rowb * LDP + P_FV + h * 64;
#define FOX_DMA(i_) do { const int tt_ = (NT - 1 - (i_)) > 0 ? (NT - 1 - (i_)) : 0; dma_kv(lds + L_RING + ((i_) & 3) * SLOT, kb + (size_t)tt_ * 64 * LDP, vb + (size_t)tt_ * 64 * LDP, LDP, wid, lane); } while (0)
    const float cref = cum[(size_t)bh * SEQ + Q0];
    { const f32x4 c4 = *(const f32x4*)(cum + (size_t)bh * SEQ + 4 * tid); f32x4 o4;
#pragma unroll
      for (int i = 0; i < 4; ++i) o4[i] = (cref - c4[i]) * LOG2E;
      *(LAS f32x4*)(cumL + 4 * tid) = o4; }
    if (tid < 32) pmL[tid] = knm[bh * 32 + tid];
    bf16x8 qr[4]; load_q(qr, proj + (rowb + Q0 + 32 * wid + r32) * LDP + P_FQ + h * 64, hi);
    float qn = 0.f;
#pragma unroll
    for (int d0 = 0; d0 < 4; ++d0)
#pragma unroll
        for (int j = 0; j < 8; ++j) { const float v = bf2f((unsigned short)qr[d0][j]); qn += v * v; }
    qn += swap_half(qn); const float qs = sqrtf(qn) * CS;
    f32x16 o[2];
#pragma unroll
    for (int r = 0; r < 16; ++r) { o[0][r] = 0.f; o[1][r] = 0.f; }
    float m = -1e30f, l = 0.f; bool done = false; const int my_last = 4 * qb + (wid >> 1); const int qidx = Q0 + 32 * wid + r32;
    __syncthreads();
    FOX_DMA(0); FOX_DMA(1); FOX_DMA(2);
    for (int it = 0; it < NT; ++it) {
        const int t = NT - 1 - it;
        RING_WAIT();
        if (it > 0) { unsigned all = 1u;
#pragma unroll
            for (int w = 0; w < 8; ++w) all &= votes[((it - 1) & 1) * 8 + w];
            if (all) break; }
        FOX_DMA(it + 3);
        LAS unsigned char* slot = lds + L_RING + (it & 3) * SLOT;
        if (t <= my_last && !done) {
            f32x16 p0, p1; qkt(p0, p1, slot, qr, r32, hi);
#pragma unroll
            for (int g4 = 0; g4 < 4; ++g4) { const f32x4 b0 = *(const LAS f32x4*)(cumL + 64 * t + 8 * g4 + 4 * hi), b1 = *(const LAS f32x4*)(cumL + 64 * t + 32 + 8 * g4 + 4 * hi);
#pragma unroll
                for (int j = 0; j < 4; ++j) { p0[4 * g4 + j] = __builtin_fmaf(p0[4 * g4 + j], CS, b0[j]); p1[4 * g4 + j] = __builtin_fmaf(p1[4 * g4 + j], CS, b1[j]); } }
            if (t == my_last) {
#pragma unroll
                for (int r = 0; r < 16; ++r) { const int kv = 64 * t + crow(r, hi); if (kv > qidx) p0[r] = -__builtin_inff(); if (kv + 32 > qidx) p1[r] = -__builtin_inff(); } }
            softmax_tile<false>(p0, p1, m, l, o, wsf, r32, hi);
            bf16x8 pa[4]; pack_p(p0, p1, pa);
            pv(o, slot + 8192, pa, lane);
            if (t > 0) { const float bound = qs * pmL[t - 1] + cumL[64 * t - 1]; done = __all(bound < m - 40.0f); }
        }
        if (lane == 0) votes[(it & 1) * 8 + wid] = (done || t == 0) ? 1u : 0u;
    }
    RING_DRAIN();
#undef FOX_DMA
    l += swap_half(l);
    scale_rows(o, 1.0f / l, wsf, r32, hi);
    store_o(o, lds + L_OST + wid * 4096, ys + ((size_t)3 * M + rowb + Q0 + 32 * wid) * 512 + h * 64, 512, lane);
    __syncthreads();
}

__device__ __forceinline__ void sb_unit(const Ctx& C, int b, int h, int qb, const bf16_t* proj, bf16_t* ys) {
    LAS unsigned char* lds = C.lds; const int lane = C.lane, wid = C.wave, r32 = lane & 31, hi = lane >> 5;
    LAS unsigned* votes = (LAS unsigned*)(lds + L_X);
    const size_t rowb = (size_t)b * SEQ; const int Q0 = qb * 256, NT = 4 * qb + 4;
    const bf16_t* kb = proj + rowb * LDP + P_SK + h * 64; const bf16_t* vb = proj + rowb * LDP + P_SV + h * 64;
#define SB_DMA(i_) do { const int tt_ = (NT - 1 - (i_)) > 0 ? (NT - 1 - (i_)) : 0; dma_kv(lds + L_RING + ((i_) & 3) * SLOT, kb + (size_t)tt_ * 64 * LDP, vb + (size_t)tt_ * 64 * LDP, LDP, wid, lane); } while (0)
    bf16x8 qr[4]; load_q(qr, proj + (rowb + Q0 + 32 * wid + r32) * LDP + P_SQ + h * 64, hi);
    bf16x8 ua[2], ones;
#pragma unroll
    for (int s = 0; s < 2; ++s)
#pragma unroll
        for (int e = 0; e < 8; ++e) ua[s][e] = ((16 * s + 8 * (e >> 2) + 4 * hi + (e & 3)) >= r32) ? (short)0x3F80 : (short)0;
#pragma unroll
    for (int e = 0; e < 8; ++e) ones[e] = (short)0x3F80;
    f32x16 o[2];
#pragma unroll
    for (int r = 0; r < 16; ++r) { o[0][r] = 0.f; o[1][r] = 0.f; }
    float R2 = 0.f; bool done = false; const int my_first = 4 * qb + (wid >> 1); const int qidx = Q0 + 32 * wid + r32;
    __syncthreads();
    SB_DMA(0); SB_DMA(1); SB_DMA(2);
    for (int it = 0; it < NT; ++it) {
        const int t = NT - 1 - it;
        RING_WAIT();
        if (it > 0) { unsigned all = 1u;
#pragma unroll
            for (int w = 0; w < 8; ++w) all &= votes[((it - 1) & 1) * 8 + w];
            if (all) break; }
        SB_DMA(it + 3);
        LAS unsigned char* slot = lds + L_RING + (it & 3) * SLOT;
        if (t <= my_first && !done) {
            f32x16 z0, z1; qkt(z0, z1, slot, qr, r32, hi);
            f32x16 sp0, sp1;
#pragma unroll
            for (int r = 0; r < 16; ++r) { z0[r] *= CS; z1[r] *= CS;
                sp0[r] = __builtin_amdgcn_logf(1.0f + __builtin_amdgcn_exp2f(fminf(z0[r], 100.f))); sp1[r] = __builtin_amdgcn_logf(1.0f + __builtin_amdgcn_exp2f(fminf(z1[r], 100.f))); }
            if (t == my_first) {
#pragma unroll
                for (int r = 0; r < 16; ++r) { const int kv = 64 * t + crow(r, hi); if (kv >= qidx) { sp0[r] = 0.f; z0[r] = -__builtin_inff(); } if (kv + 32 >= qidx) { sp1[r] = 0.f; z1[r] = -__builtin_inff(); } } }
            bf16x8 spa[4]; pack_p(sp0, sp1, spa);
            f32x16 S0, S1;
#pragma unroll
            for (int r = 0; r < 16; ++r) { S0[r] = R2; S1[r] = R2; }
            S0 = __builtin_amdgcn_mfma_f32_32x32x16_bf16(ua[0], spa[0], S0, 0, 0, 0); S0 = __builtin_amdgcn_mfma_f32_32x32x16_bf16(ua[1], spa[1], S0, 0, 0, 0);
            S0 = __builtin_amdgcn_mfma_f32_32x32x16_bf16(ones, spa[2], S0, 0, 0, 0); S0 = __builtin_amdgcn_mfma_f32_32x32x16_bf16(ones, spa[3], S0, 0, 0, 0);
            S1 = __builtin_amdgcn_mfma_f32_32x32x16_bf16(ua[0], spa[2], S1, 0, 0, 0); S1 = __builtin_amdgcn_mfma_f32_32x32x16_bf16(ua[1], spa[3], S1, 0, 0, 0);
            f32x16 a0, a1;
#pragma unroll
            for (int r = 0; r < 16; ++r) { a0[r] = __builtin_amdgcn_exp2f(z0[r] - S0[r]); a1[r] = __builtin_amdgcn_exp2f(z1[r] - S1[r]); }
            bf16x8 pa[4]; pack_p(a0, a1, pa);
            pv(o, slot + 8192, pa, lane);
            R2 = __shfl(S0[0], r32);
            done = __all(R2 > 126.0f);
        }
        if (lane == 0) votes[(it & 1) * 8 + wid] = done ? 1u : 0u;
    }
    RING_DRAIN();
#undef SB_DMA
    store_o(o, lds + L_OST + wid * 4096, ys + ((size_t)1 * M + rowb + Q0 + 32 * wid) * 512 + h * 64, 512, lane);
    __syncthreads();
}
}
namespace gla {
using att::f32x16; using att::crow; using att::cvtpk; using att::vfrag;
constexpr int G_LA = 0;
constexpr int G_SEG = 16640;
constexpr int G_WA = 18688;
constexpr int G_QP = 22784;
constexpr int G_KP = 30976;
constexpr int G_KPP = 39168;
constexpr int G_V = 47360;
__device__ __forceinline__ void prep_unit(const Ctx& C, const Args& a, int l, int b, int h, int c, const bf16_t* proj, bf16_t* gqp, float* gdec, float* gds, float* goi) {
    LAS unsigned char* lds = C.lds; const int tid = C.tid, lane = C.lane, wid = C.wave, r32 = lane & 31, hi = lane >> 5;
    LAS float* LA = (LAS float*)(lds + G_LA); LAS float* SEG = (LAS float*)(lds + G_SEG); LAS float* WA = (LAS float*)(lds + G_WA);
    const size_t rowb = (size_t)b * SEQ; const int T0 = 64 * c; const int unit = (b * 4 + h) * 32 + c;
    for (int i = tid; i < 1024; i += NTHR) WA[i] = a.gla_w_alpha[(size_t)l * 16 * 256 + (i >> 6) * 256 + h * 64 + (i & 63)];
    __syncthreads();
    {
        const int t = tid >> 3, k0 = (tid & 7) * 8; const bf16_t* pr = proj + (rowb + T0 + t) * LDP;
        float al[16]; { float t0[8], t1[8]; ld8(pr + P_GA, t0); ld8(pr + P_GA + 8, t1);
#pragma unroll
            for (int r = 0; r < 8; ++r) { al[r] = t0[r]; al[8 + r] = t1[r]; } }
#pragma unroll
        for (int i = 0; i < 8; ++i) { float x = a.gla_b_alpha[l * 256 + h * 64 + k0 + i];
#pragma unroll
            for (int r = 0; r < 16; ++r) x += al[r] * WA[r * 64 + k0 + i];
            LA[t * 65 + k0 + i] = logsigmoidf_(x) * (1.0f / 16.0f); }
    }
    __syncthreads();
    {
        const int k = tid & 63, seg = tid >> 6; float v[8]; float run = 0.f;
#pragma unroll
        for (int i = 0; i < 8; ++i) { run += LA[(8 * seg + i) * 65 + k]; v[i] = run; }
        SEG[seg * 64 + k] = run;
        __syncthreads();
        float off = 0.f;
#pragma unroll
        for (int s = 0; s < 8; ++s) off += (s < seg) ? SEG[s * 64 + k] : 0.f;
#pragma unroll
        for (int i = 0; i < 8; ++i) LA[(8 * seg + i) * 65 + k] = v[i] + off;
    }
    __syncthreads();
    {
        const int t = tid >> 3, ks = tid & 7, k0 = ks * 8; const bf16_t* pr = proj + (rowb + T0 + t) * LDP;
        float qv[8], kv[8]; ld8(pr + P_GQ + h * 64 + k0, qv); ld8(pr + P_GK + h * 64 + k0, kv);
        float qp[8], kp[8], kpp[8];
#pragma unroll
        for (int i = 0; i < 8; ++i) { const float bb = LA[t * 65 + k0 + i], bl = LA[63 * 65 + k0 + i]; qp[i] = qv[i] * 0.125f * __expf(bb); kp[i] = kv[i] * __expf(-bb); kpp[i] = kv[i] * __expf(bl - bb);
            if (t == 63) gdec[(size_t)unit * 64 + k0 + i] = __expf(bl); }
        u32x4 w; w.x = pk2(qp[0], qp[1]); w.y = pk2(qp[2], qp[3]); w.z = pk2(qp[4], qp[5]); w.w = pk2(qp[6], qp[7]);
        *(LAS u32x4*)(lds + G_QP + ks * 1024 + t * 16) = w; *(u32x4*)(gqp + (rowb + T0 + t) * 256 + h * 64 + k0) = w;
        w.x = pk2(kp[0], kp[1]); w.y = pk2(kp[2], kp[3]); w.z = pk2(kp[4], kp[5]); w.w = pk2(kp[6], kp[7]);
        *(LAS u32x4*)(lds + G_KP + ks * 1024 + t * 16) = w;
        w.x = pk2(kpp[0], kpp[1]); w.y = pk2(kpp[2], kpp[3]); w.z = pk2(kpp[4], kpp[5]); w.w = pk2(kpp[6], kpp[7]);
        *(LAS u32x4*)(lds + G_KPP + (ks >> 2) * 4096 + t * 64 + (ks & 3) * 16) = w;
        const int vs = tid & 7; const u32x4 v0 = *(const u32x4*)(pr + P_GV + h * 128 + vs * 16), v1 = *(const u32x4*)(pr + P_GV + h * 128 + vs * 16 + 8);
        const int vbk = vs >> 1; LAS unsigned char* vp = lds + G_V + (vbk >> 1) * 8192 + (vbk & 1) * 4096 + t * 64 + (vs & 1) * 32;
        *(LAS u32x4*)vp = v0; *(LAS u32x4*)(vp + 16) = v1;
    }
    __syncthreads();
    {
        const int tb = wid & 1, vb = wid >> 1;
        bf16x8 qf[4];
#pragma unroll
        for (int d0 = 0; d0 < 4; ++d0) qf[d0] = *(const LAS bf16x8*)(lds + G_QP + (2 * d0 + hi) * 1024 + (32 * tb + r32) * 16);
        f32x16 o;
#pragma unroll
        for (int r = 0; r < 16; ++r) o[r] = 0.f;
        for (int sb = 0; sb <= tb; ++sb) {
            f32x16 s;
#pragma unroll
            for (int r = 0; r < 16; ++r) s[r] = 0.f;
#pragma unroll
            for (int d0 = 0; d0 < 4; ++d0) { const bf16x8 kf = *(const LAS bf16x8*)(lds + G_KP + (2 * d0 + hi) * 1024 + (32 * sb + r32) * 16); s = __builtin_amdgcn_mfma_f32_32x32x16_bf16(kf, qf[d0], s, 0, 0, 0); }
            if (sb == tb) {
#pragma unroll
                for (int r = 0; r < 16; ++r) if (crow(r, hi) > r32) s[r] = 0.f; }
            u32x4 w; bf16x8 pa0, pa1;
            w.x = cvtpk(s[0], s[1]); w.y = cvtpk(s[2], s[3]); w.z = cvtpk(s[4], s[5]); w.w = cvtpk(s[6], s[7]); pa0 = __builtin_bit_cast(bf16x8, w);
            w.x = cvtpk(s[8], s[9]); w.y = cvtpk(s[10], s[11]); w.z = cvtpk(s[12], s[13]); w.w = cvtpk(s[14], s[15]); pa1 = __builtin_bit_cast(bf16x8, w);
            const LAS unsigned char* vimg = lds + G_V + (vb >> 1) * 8192;
            o = __builtin_amdgcn_mfma_f32_32x32x16_bf16(pa0, vfrag(vimg, vb & 1, 2 * sb, lane), o, 0, 0, 0);
            o = __builtin_amdgcn_mfma_f32_32x32x16_bf16(pa1, vfrag(vimg, vb & 1, 2 * sb + 1, lane), o, 0, 0, 0);
        }
        float* op = goi + (rowb + T0 + 32 * tb) * 512 + h * 128 + vb * 32 + r32;
#pragma unroll
        for (int r = 0; r < 16; ++r) op[(size_t)crow(r, hi) * 512] = o[r];
        const int kb = wid & 1; f32x16 d;
#pragma unroll
        for (int r = 0; r < 16; ++r) d[r] = 0.f;
        const LAS unsigned char* vimg = lds + G_V + (vb >> 1) * 8192;
#pragma unroll
        for (int ks = 0; ks < 4; ++ks) d = __builtin_amdgcn_mfma_f32_32x32x16_bf16(vfrag(vimg, vb & 1, ks, lane), vfrag(lds + G_KPP, kb, ks, lane), d, 0, 0, 0);
        float* dp = gds + (size_t)unit * 8192 + (size_t)(32 * vb) * 64 + 32 * kb + r32;
#pragma unroll
        for (int r = 0; r < 16; ++r) dp[crow(r, hi) * 64] = d[r];
    }
    __syncthreads();
}

__device__ __forceinline__ void scan_unit(const Ctx& C, int b, int h, int e, const float* gdec, const float* gds, bf16_t* sall) {
    const int tid = C.tid; const int v = 16 * e + (tid >> 5), k2 = (tid & 31) * 2; const int bh = b * 4 + h;
    f32x2 ds[32], dc[32];
#pragma unroll
    for (int c = 0; c < 32; ++c) { const size_t unit = (size_t)bh * 32 + c; ds[c] = *(const f32x2*)(gds + unit * 8192 + v * 64 + k2); dc[c] = *(const f32x2*)(gdec + unit * 64 + k2); }
    float s0 = 0.f, s1 = 0.f;
#pragma unroll
    for (int c = 0; c < 32; ++c) { const size_t unit = (size_t)bh * 32 + c; *(unsigned*)(sall + (unit * 128 + v) * 64 + k2) = pk2(s0, s1); s0 = dc[c].x * s0 + ds[c].x; s1 = dc[c].y * s1 + ds[c].y; }
}
__device__ __forceinline__ void out_unit(const Ctx& C, const Args& a, int l, int b, int h, int cg, const bf16_t* proj, const bf16_t* gqp, const bf16_t* sall, const float* goi, bf16_t* ys) {
    const int lane = C.lane, wid = C.wave, r32 = lane & 31, hi = lane >> 5;
    const int c = 4 * cg + (wid >> 1), tb = wid & 1; const size_t unit = (size_t)(b * 4 + h) * 32 + c; const size_t tok = (size_t)b * SEQ + 64 * c + 32 * tb + r32;
    bf16x8 qf[4];
#pragma unroll
    for (int s = 0; s < 4; ++s) qf[s] = *(const bf16x8*)(gqp + tok * 256 + h * 64 + 16 * s + 8 * hi);
    f32x16 acc[4];
#pragma unroll
    for (int vb = 0; vb < 4; ++vb) {
#pragma unroll
        for (int g4 = 0; g4 < 4; ++g4) { const f32x4 o4 = *(const f32x4*)(goi + tok * 512 + h * 128 + 32 * vb + 8 * g4 + 4 * hi);
#pragma unroll
            for (int j = 0; j < 4; ++j) acc[vb][4 * g4 + j] = o4[j]; }
#pragma unroll
        for (int s = 0; s < 4; ++s) { const bf16x8 af = *(const bf16x8*)(sall + (unit * 128 + 32 * vb + r32) * 64 + 16 * s + 8 * hi); acc[vb] = __builtin_amdgcn_mfma_f32_32x32x16_bf16(af, qf[s], acc[vb], 0, 0, 0); }
    }
    float ssq = 0.f;
#pragma unroll
    for (int vb = 0; vb < 4; ++vb)
#pragma unroll
        for (int r = 0; r < 16; ++r) ssq += acc[vb][r] * acc[vb][r];
    ssq += att::swap_half(ssq);
    const float rstd = rsqrtf(ssq * (1.0f / 128.0f) + EPS);
#pragma unroll
    for (int vb = 0; vb < 4; ++vb) { bf16_t* yo = ys + ((size_t)2 * M + tok) * 512 + h * 128 + 32 * vb + 4 * hi;
#pragma unroll
        for (int g4 = 0; g4 < 4; ++g4) { const u32x2 gt = *(const u32x2*)(proj + tok * LDP + P_GG + h * 128 + 32 * vb + 8 * g4 + 4 * hi); const f32x4 ng = *(const f32x4*)(a.gla_norm + l * 128 + 32 * vb + 8 * g4 + 4 * hi);
            const float g0 = bflo(gt.x), g1 = bfhi(gt.x), g2 = bflo(gt.y), g3 = bfhi(gt.y);
            u32x2 w; w.x = cvtpk(acc[vb][4 * g4] * rstd * ng[0] * g0 * sigmoidf_(g0), acc[vb][4 * g4 + 1] * rstd * ng[1] * g1 * sigmoidf_(g1));
            w.y = cvtpk(acc[vb][4 * g4 + 2] * rstd * ng[2] * g2 * sigmoidf_(g2), acc[vb][4 * g4 + 3] * rstd * ng[3] * g3 * sigmoidf_(g3));
            *(u32x2*)(yo + 8 * g4) = w; } }
}
}
namespace nsa {
using namespace att;
constexpr int N_GT = 67584, N_SELW = 70656, N_LIST = 70656 + 256, N_IMPS = 71168, N_IMPM = 79616, N_OST = N_IMPM;
__device__ __forceinline__ void nsa_unit(const Ctx& C, int b, int g, int qt, const bf16_t* proj, const bf16_t* kcvc, bf16_t* ys) {
    LAS unsigned char* lds = C.lds; const int tid = C.tid, lane = C.lane, wid = C.wave, r32 = lane & 31, hi = lane >> 5;
    const int hp = wid & 3, qs = wid >> 2, h = 4 * g + hp; const size_t rowb = (size_t)b * SEQ; const int T0 = 64 * qt, jd = qt;
    const int qidx = 32 * qs + r32, qtok = T0 + qidx;
    LAS float* wsf = (LAS float*)(lds + L_WSF) + wid * 64; LAS float* GT = (LAS float*)(lds + N_GT) + wid * 96;
    LAS unsigned* SELW = (LAS unsigned*)(lds + N_SELW); LAS unsigned* LIST = (LAS unsigned*)(lds + N_LIST);
    LAS float* IMPS = (LAS float*)(lds + N_IMPS); LAS float* IMPM = (LAS float*)(lds + N_IMPM) + wid * 1056;
    const bf16_t* kc = kcvc + (((size_t)0 * NB + b) * 128 * 2 + g) * 64; const bf16_t* vc = kcvc + (((size_t)1 * NB + b) * 128 * 2 + g) * 64;
    const int ncmax = (T0 + 63 >= 31) ? ((T0 + 63 - 31) / 16 + 1) : 0;
    const int nct = (ncmax + 63) >> 6;
    if (nct > 0) dma_kv(lds + L_RING, kc, vc, 128, wid, lane);
    if (nct > 1) dma_kv(lds + L_RING + SLOT, kc + 64 * 128, vc + 64 * 128, 128, wid, lane);
    const bf16_t* prow = proj + (rowb + qtok) * LDP;
    bf16x8 qr[4]; load_q(qr, prow + P_NQ + h * 64, hi);
    if (hi == 0) {
#pragma unroll
        for (int i = 0; i < 3; ++i) GT[i * 32 + r32] = sigmoidf_(bf2f(prow[P_NG + h * 3 + i])); }
    asm volatile("s_waitcnt vmcnt(0)" ::: "memory");
    __syncthreads();
    f32x16 yacc[2];
#pragma unroll
    for (int r = 0; r < 16; ++r) { yacc[0][r] = 0.f; yacc[1][r] = 0.f; }
    {
        const int ncv = (qtok >= 31) ? ((qtok - 31) / 16 + 1) : 0;
        f32x16 p[4];
#pragma unroll
        for (int i = 0; i < 4; ++i)
#pragma unroll
            for (int r = 0; r < 16; ++r) p[i][r] = -__builtin_inff();
        if (nct > 0) qkt(p[0], p[1], lds + L_RING, qr, r32, hi);
        if (nct > 1) qkt(p[2], p[3], lds + L_RING + SLOT, qr, r32, hi);
#pragma unroll
        for (int i = 0; i < 4; ++i)
#pragma unroll
            for (int r = 0; r < 16; ++r) if (32 * i + crow(r, hi) >= ncv) p[i][r] = -__builtin_inff();
        float mx = fmaxf(rowmax32(p[0], p[1]), rowmax32(p[2], p[3]));
        const float msafe = (mx == -__builtin_inff()) ? 0.f : mx; const float nm = -msafe * CS; float s = 0.f;
#pragma unroll
        for (int i = 0; i < 4; ++i)
#pragma unroll
            for (int r = 0; r < 16; ++r) { p[i][r] = __builtin_amdgcn_exp2f(__builtin_fmaf(p[i][r], CS, nm)); s += p[i][r]; }
        s += swap_half(s);
        const float il = (s > 0.f) ? 1.0f / s : 0.f;
#pragma unroll
        for (int i = 0; i < 4; ++i)
#pragma unroll
            for (int r = 0; r < 16; ++r) p[i][r] *= il;
        float c3[4][4], pc3[4][4];
#pragma unroll
        for (int i = 0; i < 4; ++i)
#pragma unroll
            for (int g4 = 0; g4 < 4; ++g4) { c3[i][g4] = 0.5f * p[i][4 * g4 + 3]; pc3[i][g4] = swap_half(c3[i][g4]); }
#pragma unroll
        for (int i = 0; i < 4; ++i)
#pragma unroll
            for (int g4 = 0; g4 < 4; ++g4) { const int j = 8 * i + 2 * g4 + hi;
                const float from_lo = pc3[i][g4];
                const float from_hi = (g4 > 0) ? pc3[i][g4 - 1] : ((i > 0) ? pc3[i - 1][3] : 0.f);
                IMPM[r32 * 33 + j] = p[i][4 * g4] + p[i][4 * g4 + 1] + p[i][4 * g4 + 2] + c3[i][g4] + (hi ? from_lo : from_hi); }
        f32x16 oc[2];
#pragma unroll
        for (int r = 0; r < 16; ++r) { oc[0][r] = 0.f; oc[1][r] = 0.f; }
        bf16x8 pa[4];
        if (nct > 0) { pack_p(p[0], p[1], pa); pv(oc, lds + L_RING + 8192, pa, lane); }
        if (nct > 1) { pack_p(p[2], p[3], pa); pv(oc, lds + L_RING + SLOT + 8192, pa, lane); }
#pragma unroll
        for (int g4 = 0; g4 < 4; ++g4) { const f32x4 gv = *(const LAS f32x4*)(GT + 0 * 32 + 8 * g4 + 4 * hi);
#pragma unroll
            for (int j = 0; j < 4; ++j) { yacc[0][4 * g4 + j] = oc[0][4 * g4 + j] * gv[j]; yacc[1][4 * g4 + j] = oc[1][4 * g4 + j] * gv[j]; } }
    }
    __syncthreads();
    {
        const int q = tid >> 3, part = tid & 7, qsq = q >> 5, rq = q & 31, t = T0 + q;
#pragma unroll
        for (int jj = 0; jj < 4; ++jj) { const int j = 4 * part + jj; float v = 0.f;
#pragma unroll
            for (int hh = 0; hh < 4; ++hh) { const LAS float* pm = (const LAS float*)(lds + N_IMPM) + (qsq * 4 + hh) * 1056 + rq * 33; v += pm[j]; }
            if (j == 0 || j == (t >> 6)) v = __builtin_inff(); else if (64 * j > t) v = -__builtin_inff();
            IMPS[q * 33 + j] = v; }
        __syncthreads();
        unsigned bits = 0u;
#pragma unroll
        for (int jj = 0; jj < 4; ++jj) { const int j = 4 * part + jj; const float vj = IMPS[q * 33 + j]; int rank = 0;
#pragma unroll 8
            for (int j2 = 0; j2 < 32; ++j2) { const float v2 = IMPS[q * 33 + j2]; rank += (v2 > vj || (v2 == vj && j2 < j)) ? 1 : 0; }
            if (rank < 8) bits |= 1u << j; }
        bits |= __shfl_xor(bits, 1); bits |= __shfl_xor(bits, 2); bits |= __shfl_xor(bits, 4);
        if (part == 0) SELW[q] = bits;
        __syncthreads();
        if (wid == 0) {
            unsigned un = SELW[lane];
#pragma unroll
            for (int o = 1; o < 64; o <<= 1) un |= __shfl_xor(un, o);
            if (lane == 0) { int n = 0; for (int j = 0; j <= jd; ++j) if ((un >> j) & 1u) LIST[1 + n++] = (unsigned)j;
                for (int j = (jd - 4 > 0 ? jd - 4 : 0); j <= jd; ++j) LIST[1 + n++] = 0x100u | (unsigned)j;
                LIST[0] = (unsigned)n; }
        }
        __syncthreads();
    }
    {
        const int n = (int)LIST[0]; const unsigned selq = SELW[qidx];
        const bf16_t* ksb = proj + rowb * LDP + P_KS + g * 64; const bf16_t* vsb = proj + rowb * LDP + P_VS + g * 64;
        const bf16_t* kwb = proj + rowb * LDP + P_KW + g * 64; const bf16_t* vwb = proj + rowb * LDP + P_VW + g * 64;
        f32x16 o[2];
#pragma unroll
        for (int r = 0; r < 16; ++r) { o[0][r] = 0.f; o[1][r] = 0.f; }
        float m = -1e30f, l = 0.f; int mode = 0;
        { const unsigned e0 = LIST[1]; const int j0 = e0 & 0xff; const bool w0 = (e0 >> 8) != 0; dma_kv(lds + L_RING, (w0 ? kwb : ksb) + (size_t)j0 * 64 * LDP, (w0 ? vwb : vsb) + (size_t)j0 * 64 * LDP, LDP, wid, lane); }
        asm volatile("s_waitcnt vmcnt(0)" ::: "memory");
        __syncthreads();
        for (int i = 0; i < n; ++i) {
            const unsigned e = LIST[1 + i]; const int j = e & 0xff; const int md = e >> 8;
            LAS unsigned char* slot = lds + L_RING + (i & 1) * SLOT;
            if (i + 1 < n) { const unsigned e1 = LIST[2 + i]; const int j1 = e1 & 0xff; const bool w1 = (e1 >> 8) != 0;
                dma_kv(lds + L_RING + ((i + 1) & 1) * SLOT, (w1 ? kwb : ksb) + (size_t)j1 * 64 * LDP, (w1 ? vwb : vsb) + (size_t)j1 * 64 * LDP, LDP, wid, lane); }
            if (md != mode) {
                l += swap_half(l);
                const float f = GT[1 * 32 + r32] / l;
                scale_rows(o, f, wsf, r32, hi);
#pragma unroll
                for (int r = 0; r < 16; ++r) { yacc[0][r] += o[0][r]; yacc[1][r] += o[1][r]; o[0][r] = 0.f; o[1][r] = 0.f; }
                m = -1e30f; l = 0.f; mode = md;
            }
            const bool allowed = (md != 0) || (((selq >> j) & 1u) != 0u);
            if (__any(allowed)) {
                f32x16 p0, p1; qkt(p0, p1, slot, qr, r32, hi);
                const bool diag = (j == jd), first = (md != 0) && (j == jd - 4);
#pragma unroll
                for (int r = 0; r < 16; ++r) { const int k0 = crow(r, hi), k1 = k0 + 32;
                    bool v0 = allowed, v1 = allowed;
                    if (diag) { v0 = v0 && (k0 <= qidx); v1 = v1 && (k1 <= qidx); }
                    if (first) { v0 = v0 && (k0 > qidx); v1 = v1 && (k1 > qidx); }
                    if (!v0) p0[r] = -__builtin_inff(); if (!v1) p1[r] = -__builtin_inff(); }
                softmax_tile<true>(p0, p1, m, l, o, wsf, r32, hi);
                bf16x8 pa[4]; pack_p(p0, p1, pa);
                pv(o, slot + 8192, pa, lane);
            }
            asm volatile("s_waitcnt vmcnt(0)" ::: "memory");
            __syncthreads();
        }
        l += swap_half(l);
        const float f = GT[2 * 32 + r32] / l;
        scale_rows(o, f, wsf, r32, hi);
#pragma unroll
        for (int r = 0; r < 16; ++r) { yacc[0][r] += o[0][r]; yacc[1][r] += o[1][r]; }
    }
    store_o(yacc, lds + N_OST + wid * 4096, ys + ((size_t)0 * M + rowb + T0 + 32 * qs) * 512 + h * 64, 512, lane);
    __syncthreads();
}
}
namespace cmpx {
using att::f32x16; using att::crow;
constexpr int C_HID = 0;
__device__ __forceinline__ void cmp_unit(const Ctx& C, const Args& a, int kv, int b, int g, int chalf, const bf16_t* proj, const bf16_t* w1t, const bf16_t* w2t, const float* bias1, bf16_t* kcvc) {
    LAS unsigned char* lds = C.lds; const int lane = C.lane, wid = C.wave, r32 = lane & 31, hi = lane >> 5;
    const size_t rowb = (size_t)b * SEQ;
    {
        const int mb = wid & 1, nb = wid >> 1; const int c = 64 * chalf + 32 * mb + r32, cl = c < 126 ? c : 126;
        const bf16_t* ap = proj + (rowb + 16 * cl) * LDP + (kv ? P_VC : P_KC) + g * 64 + 8 * hi;
        const bf16_t* b0p = w1t + (size_t)kv * 256 * 2048 + (size_t)(64 * nb + r32) * 2048 + 8 * hi; const bf16_t* b1p = b0p + 32 * 2048;
        f32x16 acc0, acc1;
#pragma unroll
        for (int r = 0; r < 16; ++r) { acc0[r] = 0.f; acc1[r] = 0.f; }
        bf16x8 af[4], bf0[4], bf1[4];
#pragma unroll
        for (int j = 0; j < 4; ++j) { af[j] = *(const bf16x8*)(ap + 16 * j); bf0[j] = *(const bf16x8*)(b0p + 16 * j); bf1[j] = *(const bf16x8*)(b1p + 16 * j); }
        for (int ll = 0; ll < 32; ++ll) {
            bf16x8 an[4], bn0[4], bn1[4]; const int ln = ll < 31 ? ll + 1 : 31;
#pragma unroll
            for (int j = 0; j < 4; ++j) { an[j] = *(const bf16x8*)(ap + (size_t)ln * LDP + 16 * j); bn0[j] = *(const bf16x8*)(b0p + 64 * ln + 16 * j); bn1[j] = *(const bf16x8*)(b1p + 64 * ln + 16 * j); }
#pragma unroll
            for (int j = 0; j < 4; ++j) { acc0 = __builtin_amdgcn_mfma_f32_32x32x16_bf16(af[j], bf0[j], acc0, 0, 0, 0); acc1 = __builtin_amdgcn_mfma_f32_32x32x16_bf16(af[j], bf1[j], acc1, 0, 0, 0); }
#pragma unroll
            for (int j = 0; j < 4; ++j) { af[j] = an[j]; bf0[j] = bn0[j]; bf1[j] = bn1[j]; }
        }
        const float bs0 = bias1[kv * 256 + 64 * nb + r32], bs1 = bias1[kv * 256 + 64 * nb + 32 + r32];
        LAS bf16_t* hid = (LAS bf16_t*)(lds + C_HID);
#pragma unroll
        for (int r = 0; r < 16; ++r) { const int row = 32 * mb + crow(r, hi);
            hid[row * 264 + 64 * nb + r32] = (bf16_t)f2bf(gelu_tanh(acc0[r] + bs0)); hid[row * 264 + 64 * nb + 32 + r32] = (bf16_t)f2bf(gelu_tanh(acc1[r] + bs1)); }
    }
    __syncthreads();
    if (wid < 4) {
        const int mb = wid & 1, db = wid >> 1;
        f32x16 acc;
#pragma unroll
        for (int r = 0; r < 16; ++r) acc[r] = 0.f;
        const bf16_t* bp = w2t + (size_t)kv * 64 * 256 + (size_t)(32 * db + r32) * 256 + 8 * hi;
#pragma unroll
        for (int s = 0; s < 16; ++s) { const bf16x8 af = *(const LAS bf16x8*)(lds + C_HID + (32 * mb + r32) * 528 + 32 * s + 16 * hi); const bf16x8 bfr = *(const bf16x8*)(bp + 16 * s);
            acc = __builtin_amdgcn_mfma_f32_32x32x16_bf16(af, bfr, acc, 0, 0, 0); }
        const bool rope = (kv == 0) && (db == 0);
        const float inv = powf(500000.0f, -(float)(2 * (r32 & 7)) / 16.0f);
#pragma unroll
        for (int r = 0; r < 16; ++r) { const int cidx = 64 * chalf + 32 * mb + crow(r, hi); float v = acc[r];
            if (rope) { const float vp = __shfl_xor(v, 8); const int cc = cidx < 126 ? cidx : 126; const float ang = (float)a.pos[b * SEQ + 16 * cc + 31] * inv; float sn, cs; sincosf(ang, &sn, &cs);
                if (r32 < 8) v = v * cs - vp * sn; else if (r32 < 16) v = v * cs + vp * sn; }
            kcvc[((((size_t)kv * NB + b) * 128 + cidx) * 2 + g) * 64 + 32 * db + r32] = (cidx < 127) ? (bf16_t)f2bf(v) : (bf16_t)0; }
    }
    __syncthreads();
}
__device__ __forceinline__ void rope_unit(const Ctx& C, const Args& a, int u, bf16_t* proj) {
    for (int i = C.tid; i < 256 * 12; i += NTHR) { const int tok = 256 * u + i / 12, j = i % 12; const int col = j < 8 ? P_NQ + j * 64 : (j < 10 ? P_KS + (j - 8) * 64 : P_KW + (j - 10) * 64);
        rope_rotate(proj + (size_t)tok * LDP + col, a.pos[tok]); }
}
}

#ifndef OPT_FOX
#define OPT_FOX 1
#endif
#ifndef OPT_SB
#define OPT_SB 1
#endif
#ifndef OPT_GLA
#define OPT_GLA 1
#endif
#ifndef OPT_NSA
#define OPT_NSA 1
#endif
#ifndef OPT_PREP
#define OPT_PREP 1
#endif
#ifndef FOX_ABL
#define FOX_ABL 0
#endif
constexpr int CW_Q = 8192;
#define QLOOP(cntptr, total, ...) do { LAS unsigned* qs_ = (LAS unsigned*)(lds + MISC_OFF + 64); unsigned nxt_ = 0u; \
    if (threadIdx.x == 0) nxt_ = atomicAdd((cntptr), 1u); \
    for (;;) { if (threadIdx.x == 0) *qs_ = nxt_; __syncthreads(); const unsigned u = *qs_; if (u >= (unsigned)(total)) break; \
        if (threadIdx.x == 0) nxt_ = atomicAdd((cntptr), 1u); { __VA_ARGS__; } __syncthreads(); } __syncthreads(); } while (0)

template <bool ROPE, int SUB>
__device__ __forceinline__ void phase_C(LAS unsigned char* lds, const Args& a, int l, unsigned* ctl, bf16_t* proj, bf16_t* ys, bf16_t* gqp, float* gdec, float* gds, float* goi) {
    unsigned* qc = ctl + CW_Q + (l * 16) * 64;
    if (SUB & 1)
    { const Ctx C = make_ctx(lds); const bf16_t* w1t = (const bf16_t*)(a.ws + WS_CW1); const bf16_t* w2t = (const bf16_t*)(a.ws + WS_KC + 512 * 1024); const float* bias1 = (const float*)(a.ws + WS_KC + 576 * 1024); bf16_t* kcvc = (bf16_t*)(a.ws + WS_KC);
      QLOOP(qc + 0 * 64, 64, { const int chalf = u & 1, g = (u >> 1) & 1, b = (u >> 2) & 7, kv = (int)(u >> 5); cmpx::cmp_unit(C, a, kv, b, g, chalf, proj, w1t, w2t, bias1, kcvc); }); }
    if (SUB & 2)
    { const Ctx C = make_ctx(lds); QLOOP(qc + 1 * 64, 64, { att::foxprep_unit(C, (int)(u >> 3), (int)(u & 7), proj, a.fox_b_f[l * 8 + (u & 7)], (float*)(a.ws + WS_CUM), (float*)(a.ws + WS_CUM + 524288)); }); }
    if (SUB & 4)
    { const Ctx C = make_ctx(lds); QLOOP(qc + 2 * 64, 1024, { const int c = u & 31, bh = u >> 5; gla::prep_unit(C, a, l, bh >> 2, bh & 3, c, proj, gqp, gdec, gds, goi); }); }
    if (SUB & 8)
    { const Ctx C = make_ctx(lds); QLOOP(qc + 3 * 64, 512, { const int qb = 7 - (int)(u >> 6), bh = u & 63; att::sb_unit(C, bh >> 3, bh & 7, qb, proj, ys); }); }
    if (ROPE) { const Ctx C = make_ctx(lds); QLOOP(qc + 4 * 64, 64, { cmpx::rope_unit(C, a, (int)u, proj); }); }
}
template <int SUB>
__device__ __forceinline__ void phase_D(LAS unsigned char* lds, const Args& a, int l, unsigned* ctl, bf16_t* proj, bf16_t* ys, const bf16_t* kcvc, bf16_t* gqp, float* gdec, float* gds, float* goi) {
    unsigned* qc = ctl + CW_Q + (l * 16 + 8) * 64;
    if (SUB & 16)
    { const Ctx C = make_ctx(lds); QLOOP(qc + 0 * 64, 256, { gla::scan_unit(C, (int)(u >> 5), (int)((u >> 3) & 3), (int)(u & 7), gdec, gds, (bf16_t*)(a.ws + WS_HB)); }); }
    if (SUB & 32)
    { const Ctx C = make_ctx(lds); QLOOP(qc + 1 * 64, 512, { const int qt = 31 - (int)(u >> 4), bg = u & 15; nsa::nsa_unit(C, bg >> 1, bg & 1, qt, proj, kcvc, ys); }); }
    if (SUB & 64)
    { const Ctx C = make_ctx(lds); QLOOP(qc + 2 * 64, 512, { const int qb = 7 - (int)(u >> 6), bh = u & 63; att::fox_unit<0>(C, bh >> 3, bh & 7, qb, proj, (const float*)(a.ws + WS_CUM), (const float*)(a.ws + WS_CUM + 524288), ys); }); }
}
__device__ __forceinline__ void phase_E(LAS unsigned char* lds, const Args& a, int l, bf16_t* proj, bf16_t* ys, const bf16_t* gqp, const float* goi) {
    const Ctx C = make_ctx(lds);
    for (int u = C.bid; u < 256; u += C.G) gla::out_unit(C, a, l, u >> 5, (u >> 3) & 3, u & 7, proj, gqp, (const bf16_t*)(a.ws + WS_HB), goi, ys);
}

__device__ __forceinline__ const Args* args_reload() {
#if defined(__HIP_DEVICE_COMPILE__)
    auto p_ = __builtin_amdgcn_kernarg_segment_ptr(); asm volatile("" : "+s"(p_)); return (const Args*)p_;
#else
    return nullptr;
#endif
}
#define ARGS_RELOAD() args_reload()
__global__ void __launch_bounds__(NTHR, 2) hybrid_fwd(Args a0) {
    extern __shared__ __attribute__((aligned(16))) unsigned char lds_raw[];
    LAS unsigned char* lds = (LAS unsigned char*)lds_raw;
    volatile LAS unsigned* MISC = (volatile LAS unsigned*)(lds + MISC_OFF);
    if (threadIdx.x < 64) MISC[threadIdx.x] = 0u;
    __syncthreads();
#if MK_ONE_LAUNCH
    XcdBarrier bar = xcd_barrier_post((unsigned*)(a0.ws + WS_CTL) + CW_BAR, MISC + 8);
#define GRID_BAR() xcd_barrier(bar)
#else
#define GRID_BAR() do {} while (0)
#endif
#ifndef PH_MASK
#define PH_MASK 0xFFFF
#endif
    const int l_lo = a0.l_lo, l_hi = a0.l_hi, p_lo = a0.p_lo, p_hi = a0.p_hi, do_final = a0.do_final;
#define IN(k) (((PH_MASK >> (k)) & 1) && p_lo <= (k) && (k) < p_hi)
#define WSP(T, off) ((T*)(a.ws + (off)))
#ifndef REP_MASK
#define REP_MASK 0
#endif
#define REP(k) ((REP_MASK >> (k)) & 1)
#define PH0() do { const Args a = *ARGS_RELOAD(); unsigned char* ws = a.ws; const Ctx C = make_ctx(lds); int base = 0; \
            transpose_matrix<true>(C, a.w_in + (size_t)l * DM * DIN, DM, DIN, LDP, WSP(bf16_t, WS_WIN), base); \
            for (int z = 0; z < 4; ++z) transpose_matrix<false>(C, a.w_branch + ((size_t)l * 4 + z) * 512 * DM, 512, DM, DM, WSP(bf16_t, WS_WB) + (size_t)z * DM * 512, base); \
            transpose_matrix<false>(C, a.w_out + (size_t)l * DM * DM, DM, DM, DM, WSP(bf16_t, WS_WO), base); \
            transpose_matrix<false>(C, a.w_ff1 + (size_t)l * DM * DFF, DM, DFF, DFF, WSP(bf16_t, WS_WF1), base); \
            transpose_matrix<false>(C, a.w_ff2 + (size_t)l * DFF * DM, DFF, DM, DM, WSP(bf16_t, WS_WF2), base); \
            transpose_matrix<false>(C, a.cmp_wk1 + (size_t)l * 2048 * 256, 2048, 256, 256, (bf16_t*)(ws + WS_CW1), base); \
            transpose_matrix<false>(C, a.cmp_wv1 + (size_t)l * 2048 * 256, 2048, 256, 256, (bf16_t*)(ws + WS_CW1) + 256 * 2048, base); \
            transpose_matrix<false>(C, a.cmp_wk2 + (size_t)l * 256 * 64, 256, 64, 64, (bf16_t*)(ws + WS_KC + 512 * 1024), base); \
            transpose_matrix<false>(C, a.cmp_wv2 + (size_t)l * 256 * 64, 256, 64, 64, (bf16_t*)(ws + WS_KC + 512 * 1024) + 64 * 256, base); \
            for (int o = C.gw; o < 512; o += C.NGW) { const int kv = o >> 8, n = o & 255; const float* w1 = (kv ? a.cmp_wv1 : a.cmp_wk1) + (size_t)l * 2048 * 256; const float* pe = (kv ? a.cmp_pos_v : a.cmp_pos_k) + (size_t)l * 2048; \
                float s = 0.f; for (int k = C.lane; k < 2048; k += 64) s += pe[k] * w1[(size_t)k * 256 + n]; s = wave_sum(s); if (C.lane == 0) ((float*)(ws + WS_KC + 576 * 1024))[o] = s; } \
            rms_rows_phase(C, (l == 0) ? a.x : a.out, a.norm_mix + l * DM, WSP(bf16_t, WS_HB)); \
            GRID_BAR(); } while (0)
#define PH1() do { const Args a = *ARGS_RELOAD(); \
            pg8::Gemm g{WSP(bf16_t, WS_HB), WSP(bf16_t, WS_WIN), DM, DM, DM, 0, 0}; pg8::StaticOrder S; S.init(M, LDP, gridDim.x, blockIdx.x); \
            pg8::EpiBf16<0> E{WSP(bf16_t, WS_PROJ), LDP}; pg8::gemm_phase(lds, g, S, E); GRID_BAR(); } while (0)
#ifndef REP_SUB
#define REP_SUB 0xF
#endif
#ifndef FOX_ABL
#define FOX_ABL 0
#endif
#define PH2(QOFF, ROPE) do { const Args a = *ARGS_RELOAD(); phase_C<ROPE, (ROPE) ? 0xF : (REP_SUB)>(lds, a, l, WSP(unsigned, WS_CTL) + (QOFF), WSP(bf16_t, WS_PROJ), WSP(bf16_t, WS_YS), WSP(bf16_t, WS_GQP), WSP(float, WS_GKP), WSP(float, WS_GDS), WSP(float, WS_GOI)); GRID_BAR(); } while (0)
#define PH3(QOFF) do { const Args a = *ARGS_RELOAD(); phase_D<((QOFF) != 0) ? (REP_SUB) : 0x70>(lds, a, l, WSP(unsigned, WS_CTL) + (QOFF), WSP(bf16_t, WS_PROJ), WSP(bf16_t, WS_YS), WSP(bf16_t, WS_KC), WSP(bf16_t, WS_GQP), WSP(float, WS_GKP), WSP(float, WS_GDS), WSP(float, WS_GOI)); GRID_BAR(); } while (0)
#define PH4() do { const Args a = *ARGS_RELOAD(); phase_E(lds, a, l, WSP(bf16_t, WS_PROJ), WSP(bf16_t, WS_YS), WSP(bf16_t, WS_GQP), WSP(float, WS_GOI)); GRID_BAR(); } while (0)
#define PH5() do { const Args a = *ARGS_RELOAD(); \
            pg8::Gemm g{WSP(bf16_t, WS_YS), WSP(bf16_t, WS_WB), 512, 512, 512, (size_t)M * 512, (size_t)DM * 512}; pg8::ZOrder S; S.init(M, 2 * DM, gridDim.x, blockIdx.x); S.NZ = 4; \
            pg8::EpiGate E{WSP(bf16_t, WS_PROJ), a.b_gate + (size_t)l * 4 * DM, WSP(bf16_t, WS_MIX)}; pg8::gemm_phase(lds, g, S, E); GRID_BAR(); } while (0)
#define PH6(DUMMY) do { const Args a = *ARGS_RELOAD(); \
            pg8::Gemm g{WSP(bf16_t, WS_MIX), WSP(bf16_t, WS_WO), DM, DM, DM, 0, 0}; pg8::StaticOrder S; S.init(M, DM, gridDim.x, blockIdx.x); \
            pg8::EpiRes E{(l == 0) ? a.x : a.out, (DUMMY) ? WSP(float, WS_MIXF) : a.out, DM}; pg8::gemm_phase(lds, g, S, E); GRID_BAR(); } while (0)
#define PH7() do { const Args a = *ARGS_RELOAD(); const Ctx C = make_ctx(lds); rms_rows_phase(C, a.out, a.norm_ff + l * DM, WSP(bf16_t, WS_HB)); GRID_BAR(); } while (0)
#define PH8() do { const Args a = *ARGS_RELOAD(); \
            pg8::Gemm g{WSP(bf16_t, WS_HB), WSP(bf16_t, WS_WF1), DM, DM, DM, 0, 0}; pg8::StaticOrder S; S.init(M, DFF, gridDim.x, blockIdx.x); \
            pg8::EpiBf16<1> E{WSP(bf16_t, WS_HID), DFF}; pg8::gemm_phase(lds, g, S, E); GRID_BAR(); } while (0)
#define PH9(DUMMY) do { const Args a = *ARGS_RELOAD(); \
            pg8::Gemm g{WSP(bf16_t, WS_HID), WSP(bf16_t, WS_WF2), DFF, DFF, DFF, 0, 0}; pg8::StaticOrder S; S.init(M, DM, gridDim.x, blockIdx.x); \
            pg8::EpiRes E{a.out, (DUMMY) ? WSP(float, WS_MIXF) : a.out, DM}; pg8::gemm_phase(lds, g, S, E); GRID_BAR(); } while (0)
    for (int l = l_lo; l < l_hi; ++l) {
        if (IN(0)) { PH0(); if (REP(0)) PH0(); }
        if (IN(1)) { PH1(); if (REP(1)) PH1(); }
        if (IN(2)) { if (REP(2)) PH2(64 * 1024, false); PH2(0, true); }
        if (IN(3)) { if (REP(3)) PH3(64 * 1024); PH3(0); }
        if (IN(4)) { PH4(); if (REP(4)) PH4(); }
        if (IN(5)) { PH5(); if (REP(5)) PH5(); }
        if (IN(6)) { if (REP(6)) PH6(true); PH6(false); }
        if (IN(7)) { PH7(); if (REP(7)) PH7(); }
        if (IN(8)) { PH8(); if (REP(8)) PH8(); }
        if (IN(9)) { if (REP(9)) PH9(true); PH9(false); }
    }
    if (do_final) { const Args a = *ARGS_RELOAD(); const Ctx C = make_ctx(lds); final_norm_phase(C, a.out, a.norm_final); }
#undef IN
#undef WSP
}

#define NAIVE_CTX() extern __shared__ __attribute__((aligned(16))) unsigned char lds_raw[]; Ctx C; C.lds = (LAS unsigned char*)lds_raw; C.tid = threadIdx.x; C.lane = C.tid & 63; \
    C.wave = __builtin_amdgcn_readfirstlane(C.tid >> 6); C.G = gridDim.x; C.bid = blockIdx.x; C.gw = C.bid * NWAVES + C.wave; C.NGW = C.G * NWAVES; unsigned char* ws = a.ws; \
    bf16_t* ys = (bf16_t*)(ws + WS_YS); bf16_t* proj = (bf16_t*)(ws + WS_PROJ); float* cum = (float*)(ws + WS_CUM); float* ch = (float*)(ws + WS_CH); bf16_t* kcvc = (bf16_t*)(ws + WS_KC); \
    float* gds = (float*)(ws + WS_GDS); float* goi = (float*)(ws + WS_GOI); (void)ys; (void)proj; (void)cum; (void)ch; (void)kcvc; (void)gds; (void)goi;
__global__ void __launch_bounds__(NTHR, 2) k_prepA(Args a) { NAIVE_CTX(); naive_prepA(C, a, a.l_lo, proj, cum, ch); }
__global__ void __launch_bounds__(NTHR, 2) k_prepB(Args a) { NAIVE_CTX(); naive_prepB(C, a, a.l_lo, ch, kcvc); }
__global__ void __launch_bounds__(NTHR, 2) k_gla(Args a) { NAIVE_CTX(); naive_gla(C, a, a.l_lo, proj, goi, ys); }
__global__ void __launch_bounds__(NTHR, 2) k_nsa(Args a) { NAIVE_CTX(); naive_nsa(C, proj, kcvc, (float*)(ws + WS_MIX), ys); }
__global__ void __launch_bounds__(NTHR, 2) k_fox(Args a) { NAIVE_CTX(); naive_fox(C, proj, cum, ys); }
__global__ void __launch_bounds__(NTHR, 2) k_sb(Args a) { NAIVE_CTX(); naive_sb(C, proj, ys); }

extern "C" void kernel_launch(void* const* d_in, const int* in_sizes, int n_in, void* d_out, int out_size, void* d_ws, size_t ws_size, hipStream_t stream) {
    static int grid = 0;
    if (grid == 0) {
        if (n_in != 21 || in_sizes[0] != M * DM || out_size != M * DM || ws_size < WS_END) { fprintf(stderr, "kernel_launch: shape/ws mismatch (n_in %d, ws %zu, need %zu)\n", n_in, ws_size, (size_t)WS_END); grid = -1; return; }
        int dev = 0, cus = 0, per_cu = 0;
        if (hipGetDevice(&dev) != hipSuccess || hipDeviceGetAttribute(&cus, hipDeviceAttributeMultiprocessorCount, dev) != hipSuccess) { grid = -1; return; }
        if (hipFuncSetAttribute((const void*)hybrid_fwd, hipFuncAttributeMaxDynamicSharedMemorySize, LDS_BYTES) != hipSuccess) { grid = -1; return; }
        if (hipOccupancyMaxActiveBlocksPerMultiprocessor(&per_cu, (const void*)hybrid_fwd, NTHR, LDS_BYTES) != hipSuccess || per_cu < 1) { fprintf(stderr, "kernel_launch: occupancy query says %d\n", per_cu); }
        (void)hipGetLastError();
        grid = cus;
    }
    if (grid < 0) return;
    (void)hipMemsetAsync((char*)d_ws + WS_CTL, 0, CTL_BYTES, stream);
    Args a{};
    a.x = (const float*)d_in[0]; a.pos = (const int*)d_in[1]; a.norm_mix = (const float*)d_in[2]; a.w_in = (const float*)d_in[3]; a.b_gate = (const float*)d_in[4];
    a.cmp_pos_k = (const float*)d_in[5]; a.cmp_pos_v = (const float*)d_in[6]; a.cmp_wk1 = (const float*)d_in[7]; a.cmp_wk2 = (const float*)d_in[8]; a.cmp_wv1 = (const float*)d_in[9]; a.cmp_wv2 = (const float*)d_in[10];
    a.gla_w_alpha = (const float*)d_in[11]; a.gla_b_alpha = (const float*)d_in[12]; a.gla_norm = (const float*)d_in[13]; a.fox_b_f = (const float*)d_in[14];
    a.w_branch = (const float*)d_in[15]; a.w_out = (const float*)d_in[16]; a.norm_ff = (const float*)d_in[17]; a.w_ff1 = (const float*)d_in[18]; a.w_ff2 = (const float*)d_in[19]; a.norm_final = (const float*)d_in[20];
    a.out = (float*)d_out; a.ws = (unsigned char*)d_ws; a.pad = 0;
#if MK_ONE_LAUNCH
    a.l_lo = 0; a.l_hi = NL; a.p_lo = 0; a.p_hi = 10; a.do_final = 1;
    hipLaunchKernelGGL(hybrid_fwd, dim3(grid), dim3(NTHR), LDS_BYTES, stream, a);
#else
    for (int l = 0; l < NL; ++l)
        for (int p = 0; p < 10; ++p) { a.l_lo = l; a.l_hi = l + 1; a.p_lo = p; a.p_hi = p + 1; a.do_final = 0;
            if (p == 2 && !OPT_PREP) { hipLaunchKernelGGL(k_prepA, dim3(grid), dim3(NTHR), 0, stream, a); hipLaunchKernelGGL(k_prepB, dim3(grid), dim3(NTHR), 0, stream, a); }
            if (p == 3) {
                if (!OPT_GLA) hipLaunchKernelGGL(k_gla, dim3(32), dim3(NTHR), 8192, stream, a);
                if (!OPT_NSA) hipLaunchKernelGGL(k_nsa, dim3(64), dim3(NTHR), 65536, stream, a);
                if (!OPT_FOX) hipLaunchKernelGGL(k_fox, dim3(grid), dim3(NTHR), 0, stream, a);
                if (!OPT_SB) hipLaunchKernelGGL(k_sb, dim3(grid), dim3(NTHR), 0, stream, a);
            }
            hipLaunchKernelGGL(hybrid_fwd, dim3(grid), dim3(NTHR), LDS_BYTES, stream, a); }
    a.l_lo = 0; a.l_hi = 0; a.p_lo = 0; a.p_hi = 0; a.do_final = 1;
    hipLaunchKernelGGL(hybrid_fwd, dim3(grid), dim3(NTHR), LDS_BYTES, stream, a);
#endif
}
```

```cpp
#include <hip/hip_runtime.h>
#include <cstdio>
#include <cstdint>

#ifndef MK_ONE_LAUNCH
#define MK_ONE_LAUNCH 1
#endif

#define GAS __attribute__((address_space(1)))
#define LAS __attribute__((address_space(3)))
typedef unsigned short bf16_t;
typedef short bf16x8 __attribute__((ext_vector_type(8)));
typedef float f32x4 __attribute__((ext_vector_type(4)));
typedef float f32x2 __attribute__((ext_vector_type(2)));
typedef unsigned u32x4 __attribute__((ext_vector_type(4)));
typedef unsigned u32x2 __attribute__((ext_vector_type(2)));

constexpr int NB = 8, SEQ = 2048, M = NB * SEQ, DM = 1024, NL = 4, DIN = 10032, LDP = 10240, DFF = 4096;
constexpr float EPS = 1e-6f;
constexpr int P_NQ = 0, P_KC = 512, P_VC = 640, P_KS = 768, P_VS = 896, P_KW = 1024, P_VW = 1152;
constexpr int P_SQ = 1280, P_SK = 1792, P_SV = 2304;
constexpr int P_GQ = 2816, P_GK = 3072, P_GV = 3328, P_GG = 3840;
constexpr int P_FQ = 4352, P_FK = 4864, P_FV = 5376;
constexpr int P_GATE = 5888, P_NG = 9984, P_GA = 10008, P_FF = 10024;
__host__ __device__ __forceinline__ int win_src_col(int n) {
    if (n < 1280) return n;
    if (n < 3840) return n + 24;
    if (n < 5888) return n + 40;
    if (n < 9984) return n + 48;
    if (n < 10008) return n - 9984 + 1280;
    if (n < 10024) return n - 10008 + 3864;
    if (n < 10032) return n - 10024 + 5928;
    return -1;
}

constexpr size_t MiB = 1u << 20;
constexpr size_t WS_CTL = 0, CTL_BYTES = 1 * MiB;
constexpr size_t WS_WIN = 1 * MiB;
constexpr size_t WS_WB = 21 * MiB;
constexpr size_t WS_WO = 25 * MiB;
constexpr size_t WS_WF1 = 27 * MiB;
constexpr size_t WS_WF2 = 35 * MiB;
constexpr size_t WS_CW1 = 43 * MiB;
constexpr size_t WS_KC = 45 * MiB;
constexpr size_t WS_CUM = 46 * MiB;
constexpr size_t WS_CH = 47 * MiB;
constexpr size_t WS_HB = 52 * MiB;
constexpr size_t WS_MIX = 84 * MiB;
constexpr size_t WS_YS = 116 * MiB;
constexpr size_t WS_GQP = 180 * MiB;
constexpr size_t WS_GKP = 188 * MiB;
constexpr size_t WS_GKPP = 196 * MiB;
constexpr size_t WS_GDS = 204 * MiB;
constexpr size_t WS_GOI = 236 * MiB;
constexpr size_t WS_MIXF = WS_GDS;
constexpr size_t WS_PROJ = 268 * MiB;
constexpr size_t WS_HID = WS_PROJ;
constexpr size_t WS_END = 588 * MiB;

constexpr int CW_BAR = 4096;

constexpr int RING_BYTES = 131072;
constexpr int MISC_OFF = 146944;
constexpr int LDS_BYTES = 147456;
constexpr int NWAVES = 8, NTHR = 512;

__device__ __forceinline__ unsigned f2bf(float f) { unsigned u = __builtin_bit_cast(unsigned, f); return (u + 0x7fffu + ((u >> 16) & 1u)) >> 16; }
__device__ __forceinline__ unsigned pk2(float lo, float hi) { return f2bf(lo) | (f2bf(hi) << 16); }
__device__ __forceinline__ float bf2f(unsigned short b) { return __builtin_bit_cast(float, ((unsigned)b) << 16); }
__device__ __forceinline__ float bflo(unsigned w) { return __builtin_bit_cast(float, w << 16); }
__device__ __forceinline__ float bfhi(unsigned w) { return __builtin_bit_cast(float, w & 0xffff0000u); }
__device__ __forceinline__ int lane_id() { unsigned z = 0u; asm volatile("" : "+s"(z)); return (int)__builtin_amdgcn_mbcnt_hi(~0u, __builtin_amdgcn_mbcnt_lo(~0u, z)); }
__device__ __forceinline__ float wave_sum(float v) {
#pragma unroll
    for (int o = 1; o < 64; o <<= 1) v += __shfl_xor(v, o);
    return v;
}
__device__ __forceinline__ float sigmoidf_(float x) { return __builtin_amdgcn_rcpf(1.0f + __builtin_amdgcn_exp2f(-1.4426950408889634f * x)); }
__device__ __forceinline__ float softplusf_(float x) { return fmaxf(x, 0.f) + log1pf(__expf(-fabsf(x))); }
__device__ __forceinline__ float logsigmoidf_(float x) { return fminf(x, 0.f) - log1pf(__expf(-fabsf(x))); }

#define XB_TMO      128
#define XB_XCNT(j)  (256  + 64 * (j))
#define XB_XSUB(j)  (1280 + 64 * (j))
#define XB_XGEN(j)  (2304 + 64 * (j))
#define XB_TOP      3328
#define XB_TOPGEN   3392
#define XCD_BAR_WORDS 3456
#define XB_SPIN_CAP (1u << 18)
__device__ __forceinline__ unsigned xb_ld(unsigned* p)              { return __hip_atomic_load(p, __ATOMIC_RELAXED, __HIP_MEMORY_SCOPE_AGENT); }
__device__ __forceinline__ unsigned xb_add(unsigned* p, unsigned v) { return __hip_atomic_fetch_add(p, v, __ATOMIC_RELAXED, __HIP_MEMORY_SCOPE_AGENT); }
__device__ __forceinline__ unsigned xb_xcc_id() { return (unsigned)__builtin_amdgcn_s_getreg((3 << 11) | 20) & 0xFu; }
#define XB_SPIN(cond, bar) do { unsigned _sp = 0; while (cond) { __builtin_amdgcn_s_sleep(1); \
    if ((++_sp & 255u) == 0u) { if (xb_ld(&(bar)[XB_TMO])) break; if (_sp > XB_SPIN_CAP) { atomicAdd(&(bar)[XB_TMO], 1u); break; } } } } while (0)
struct XcdBarrier { unsigned* bar; unsigned x; volatile LAS unsigned* st; };
__device__ __forceinline__ XcdBarrier xcd_barrier_post(unsigned* bar, volatile LAS unsigned* st) {
    XcdBarrier b; b.bar = bar; b.x = xb_xcc_id(); b.st = st;
    if (threadIdx.x == 0) (void)xb_add(&bar[XB_XCNT(b.x)], 1u);
    return b;
}
__device__ __forceinline__ void xcd_barrier_complete(unsigned* bar, unsigned x, unsigned& nloc, unsigned& nx) {
    const unsigned G = gridDim.x * gridDim.y * gridDim.z;
    unsigned sum, cnt, mine, sp = 0u;
    for (;;) {
        sum = 0u; cnt = 0u; mine = 0u;
#pragma unroll
        for (unsigned j = 0; j < 16; ++j) { const unsigned c = xb_ld(&bar[XB_XCNT(j)]); sum += c; cnt += (c > 0u) ? 1u : 0u; mine = (j == x) ? c : mine; }
        if (sum == G) break;
        __builtin_amdgcn_s_sleep(1);
        if ((++sp & 255u) == 0u) { if (xb_ld(&bar[XB_TMO])) break; if (sp > XB_SPIN_CAP) { atomicAdd(&bar[XB_TMO], 1u); break; } }
    }
    nloc = mine > 0u ? mine : 1u; nx = cnt > 0u ? cnt : 1u;
}
__device__ __forceinline__ void xcd_barrier(const XcdBarrier& b, bool t0) {
    asm volatile("s_waitcnt vmcnt(0)" ::: "memory");
    __syncthreads();
    if (t0) {
        unsigned* bar = b.bar;
        __builtin_amdgcn_s_waitcnt(0);
        unsigned nloc = b.st[0], nx = b.st[1];
        if (nloc == 0u) { xcd_barrier_complete(bar, b.x, nloc, nx); b.st[0] = nloc; b.st[1] = nx; }
        const unsigned old = xb_add(&bar[XB_XSUB(b.x)], 1u);
        const unsigned gen = old / nloc;
        if (old + 1u == (gen + 1u) * nloc) {
            __builtin_amdgcn_fence(__ATOMIC_RELEASE, "agent");
            asm volatile("s_waitcnt vmcnt(0)" ::: "memory");
            const unsigned og = xb_add(&bar[XB_TOP], 1u);
            const unsigned tg = og / nx;
            if (og + 1u == (tg + 1u) * nx) xb_add(&bar[XB_TOPGEN], 1u);
            else XB_SPIN(xb_ld(&bar[XB_TOPGEN]) == tg, bar);
            __builtin_amdgcn_fence(__ATOMIC_ACQUIRE, "agent");
            xb_add(&bar[XB_XGEN(b.x)], 1u);
            asm volatile("s_waitcnt vmcnt(0)" ::: "memory");
        } else {
            XB_SPIN(xb_ld(&bar[XB_XGEN(b.x)]) == gen, bar);
            __builtin_amdgcn_fence(__ATOMIC_ACQUIRE, "agent");
            asm volatile("s_waitcnt vmcnt(0)" ::: "memory");
        }
    }
    __syncthreads();
}

namespace pg8 {
constexpr int BM = 256, BK = 64, HALF = 128, HTB = HALF * BK * 2, STAGE_BYTES = 8 * HTB, NXCD = 8, WGM = 8;
__host__ __device__ __forceinline__ int lds_byte(int r, int c) { const int st = (r >> 4) * 2 + (c >> 5), rr = r & 15, cc = c & 31, ob = rr * 64 + cc * 2; return st * 1024 + (ob ^ (((ob >> 9) & 1) << 5)); }
__host__ __device__ __forceinline__ void stage_rc(int b, int& R, int& C) { const int st = b / 1024, sb = b % 1024, swz = sb ^ (((sb >> 9) & 1) << 5); R = (st >> 1) * 16 + swz / 64; C = (st & 1) * 32 + (swz % 64) / 2; }
__host__ __device__ __forceinline__ int perm32(int rho) { const int n = rho >> 4, i = rho & 15; return 8 * (i >> 2) + 4 * n + (i & 3); }

struct Unit { int pm, pn, z; };
struct Gemm { const bf16_t* A; const bf16_t* Bt; int lda, ldb, K; size_t zA, zB; };

struct StaticOrder {
    int nM, nN, nwg, G, c;
    __host__ __device__ void init(int M_, int N_, int G_, int c_) { nM = M_ / BM; nN = N_ / BM; nwg = nM * nN; G = G_; c = c_; }
    __host__ __device__ bool tile(long L, Unit& u) const {
        if (L >= nwg) return false;
        int wgid = (int)L; { const int q = nwg / NXCD, r = nwg % NXCD, xcd = wgid % NXCD, off = wgid / NXCD; wgid = (xcd < r ? xcd * (q + 1) : r * (q + 1) + (xcd - r) * q) + off; }
        const int nig = WGM * nN, gid = wgid / nig, fm = gid * WGM, gsz = (nM - fm) < WGM ? (nM - fm) : WGM;
        u.pm = fm + ((wgid % nig) % gsz); u.pn = (wgid % nig) / gsz; u.z = 0; return true;
    }
    __host__ __device__ bool next(int i, Unit& u) const { return tile((long)i * G + c, u); }
};
struct ZOrder : StaticOrder {
    int NZ;
    __host__ __device__ bool next(int i, Unit& u) const { const int ti = i / NZ; if (!tile((long)ti * G + c, u)) return false; u.z = i - ti * NZ; return true; }
};

__device__ __forceinline__ unsigned cvt_pk_bf16(float lo, float hi) { unsigned r; asm volatile("v_cvt_pk_bf16_f32 %0, %1, %2" : "=v"(r) : "v"(lo), "v"(hi)); return r; }

struct NoState {};
template <int ACT> struct EpiBf16 {
    static constexpr bool PERM = true, HALFN = false; typedef NoState State;
    bf16_t* O; int ldc; const float* rsv;
    __device__ __forceinline__ void operator()(const f32x4 (&acc)[2][2][4][2], NoState&, const Unit& u, int wr, int wc, int fr, int fq) const {
        const int row0 = u.pm * BM + wr * 64 + fr; const int col0 = u.pn * BM + wc * 32 + 8 * fq;
        float rs[2][4];
        if (ACT == 0) {
#pragma unroll
            for (int ai = 0; ai < 2; ++ai)
#pragma unroll
                for (int m = 0; m < 4; ++m) rs[ai][m] = rsv[row0 + ai * HALF + m * 16];
        } else {
#pragma unroll
            for (int ai = 0; ai < 2; ++ai) {
                f32x4 pt[4][4];
#pragma unroll
                for (int m = 0; m < 4; ++m)
#pragma unroll
                    for (int q = 0; q < 4; ++q) pt[m][q] = *(const f32x4*)(rsv + (size_t)(row0 + ai * HALF + m * 16) * 16 + 4 * q);
#pragma unroll
                for (int m = 0; m < 4; ++m) { float t = 0.f;
#pragma unroll
                    for (int q = 0; q < 4; ++q) t += (pt[m][q][0] + pt[m][q][1]) + (pt[m][q][2] + pt[m][q][3]);
                    const float r = rsqrtf(t * (1.0f / DM) + EPS); rs[ai][m] = r * r; }
                asm volatile("" : "+v"(rs[ai][0]), "+v"(rs[ai][1]), "+v"(rs[ai][2]), "+v"(rs[ai][3]));
            }
        }
#pragma unroll
        for (int ai = 0; ai < 2; ++ai)
#pragma unroll
            for (int m = 0; m < 4; ++m) { bf16_t* rowp = O + (size_t)(row0 + ai * HALF + m * 16) * ldc + col0; const float r = rs[ai][m];
#pragma unroll
                for (int bj = 0; bj < 2; ++bj) { f32x4 v0 = acc[ai][bj][m][0], v1 = acc[ai][bj][m][1];
                    if (ACT == 1) {
#pragma unroll
                        for (int j = 0; j < 4; ++j) { const float a = fmaxf(v0[j], 0.f), b = fmaxf(v1[j], 0.f); v0[j] = a * a; v1[j] = b * b; } }
                    v0 = v0 * r; v1 = v1 * r;
                    u32x4 w; w.x = cvt_pk_bf16(v0[0], v0[1]); w.y = cvt_pk_bf16(v0[2], v0[3]); w.z = cvt_pk_bf16(v1[0], v1[1]); w.w = cvt_pk_bf16(v1[2], v1[3]);
                    *(u32x4*)(rowp + bj * HALF) = w; } }
    }
};
struct EpiNull {
    static constexpr bool PERM = true, HALFN = false; typedef NoState State;
    __device__ __forceinline__ void operator()(const f32x4 (&acc)[2][2][4][2], NoState&, const Unit& u, int wr, int wc, int fr, int fq) const {
#pragma unroll
        for (int ai = 0; ai < 2; ++ai)
#pragma unroll
            for (int bj = 0; bj < 2; ++bj)
#pragma unroll
                for (int m = 0; m < 4; ++m)
#pragma unroll
                    for (int n = 0; n < 2; ++n) asm volatile("" :: "v"(acc[ai][bj][m][n]));
    }
};
struct EpiRes {
    static constexpr bool PERM = false, HALFN = false; typedef NoState State;
    const float* base; float* out; int ldc; const float* gain; bf16_t* hb; float* ssq;
    __device__ __forceinline__ void operator()(const f32x4 (&acc)[2][2][4][2], NoState&, const Unit& u, int wr, int wc, int fr, int fq) const {
        const int row0 = u.pm * BM + wr * 64 + fr, col0 = u.pn * BM + wc * 32 + 4 * fq;
        f32x4 gn[2][2];
#pragma unroll
        for (int bj = 0; bj < 2; ++bj)
#pragma unroll
            for (int n = 0; n < 2; ++n) gn[bj][n] = *(const f32x4*)(gain + col0 + bj * HALF + n * 16);
#pragma unroll
        for (int ai = 0; ai < 2; ++ai)
#pragma unroll
            for (int mp = 0; mp < 2; ++mp) {
                f32x4 bs[2][2][2];
#pragma unroll
                for (int mm = 0; mm < 2; ++mm) { const size_t off = (size_t)(row0 + ai * HALF + (2 * mp + mm) * 16) * ldc + col0;
#pragma unroll
                    for (int bj = 0; bj < 2; ++bj)
#pragma unroll
                        for (int n = 0; n < 2; ++n) bs[mm][bj][n] = *(const f32x4*)(base + off + bj * HALF + n * 16); }
#pragma unroll
                for (int mm = 0; mm < 2; ++mm) { const int m = 2 * mp + mm; const int row = row0 + ai * HALF + m * 16; const size_t off = (size_t)row * ldc + col0; float sq = 0.f;
#pragma unroll
                    for (int bj = 0; bj < 2; ++bj)
#pragma unroll
                        for (int n = 0; n < 2; ++n) { const f32x4 xn = bs[mm][bj][n] + acc[ai][bj][m][n]; *(f32x4*)(out + off + bj * HALF + n * 16) = xn;
                            sq += (xn[0] * xn[0] + xn[1] * xn[1]) + (xn[2] * xn[2] + xn[3] * xn[3]);
                            const f32x4 hv = xn * gn[bj][n]; u32x2 w; w.x = cvt_pk_bf16(hv[0], hv[1]); w.y = cvt_pk_bf16(hv[2], hv[3]); *(u32x2*)(hb + off + bj * HALF + n * 16) = w; }
                    sq += __shfl_xor(sq, 16); sq += __shfl_xor(sq, 32);
                    if (fq == 0) ssq[(size_t)row * 16 + 4 * u.pn + wc] = sq; }
            }
    }
};
struct GateSum { f32x4 v[2][4][2]; };
struct EpiGate {
    static constexpr bool PERM = false, HALFN = true; typedef GateSum State;
    const bf16_t* proj; const float* b_gate; bf16_t* mix;
    __device__ __forceinline__ void operator()(const f32x4 (&acc)[2][1][4][2], GateSum& st, const Unit& u, int wr, int wc, int fr, int fq) const {
        const int row0 = u.pm * BM + wr * 64 + fr, col0 = u.pn * HALF + wc * 32 + 4 * fq; const int z = u.z;
        f32x4 bg[2];
#pragma unroll
        for (int n = 0; n < 2; ++n) bg[n] = *(const f32x4*)(b_gate + z * DM + col0 + n * 16);
#pragma unroll
        for (int ai = 0; ai < 2; ++ai) {
            u32x2 gl[4][2];
#pragma unroll
            for (int m = 0; m < 4; ++m)
#pragma unroll
                for (int n = 0; n < 2; ++n) gl[m][n] = *(const u32x2*)(proj + (size_t)(row0 + ai * HALF + m * 16) * LDP + P_GATE + z * DM + col0 + n * 16);
#pragma unroll
            for (int m = 0; m < 4; ++m)
#pragma unroll
                for (int n = 0; n < 2; ++n) { const u32x2 g2 = gl[m][n]; const f32x4 b4 = bg[n]; const f32x4 av = acc[ai][0][m][n];
                    f32x4 t = (z == 0) ? (f32x4){0.f, 0.f, 0.f, 0.f} : st.v[ai][m][n];
                    t[0] += sigmoidf_(bflo(g2.x) + b4[0]) * av[0]; t[1] += sigmoidf_(bfhi(g2.x) + b4[1]) * av[1];
                    t[2] += sigmoidf_(bflo(g2.y) + b4[2]) * av[2]; t[3] += sigmoidf_(bfhi(g2.y) + b4[3]) * av[3];
                    st.v[ai][m][n] = t;
                    if (z == 3) { u32x2 w; w.x = cvt_pk_bf16(t[0], t[1]); w.y = cvt_pk_bf16(t[2], t[3]); *(u32x2*)(mix + (size_t)(row0 + ai * HALF + m * 16) * DM + col0 + n * 16) = w; } }
        }
    }
};

template <class Epi, class Sched>
__device__ __forceinline__ void gemm_phase(LAS unsigned char* lds, const Gemm g, const Sched& S, const Epi& E, int wave_s) {
    asm volatile("" : "+s"(wave_s)); int tid_ = wave_s * 64 + lane_id(); asm volatile("" : "+v"(tid_));
    const int tid = tid_, wid = __builtin_amdgcn_readfirstlane(tid >> 6), lane = tid & 63, wr = wid >> 2, wc = wid & 3, fr = lane & 15, fq = lane >> 4;
    const int K = g.K, nt = K / BK;
    unsigned voffA[2], voffB[2];
#pragma unroll
    for (int i = 0; i < 2; ++i) { int R, C; stage_rc(tid * 16 + i * 8192, R, C); const int Rb = Epi::PERM ? ((R & ~31) + perm32(R & 31)) : R;
        voffA[i] = (unsigned)(R * g.lda + C) * 2u; voffB[i] = (unsigned)(Rb * g.ldb + C) * 2u; }
    const size_t kstep = (size_t)(BK * 2);
    constexpr bool HN = Epi::HALFN; constexpr int NBJ = HN ? 1 : 2;
    const size_t hstepA = (size_t)HALF * g.lda * 2, hstepB = HN ? (size_t)0 : (size_t)HALF * g.ldb * 2, bunit = HN ? (size_t)HALF * g.ldb * 2 : (size_t)2 * HALF * g.ldb * 2;
    const unsigned ldsw = (unsigned)wid * 1024u;
    const int aoff = lds_byte(wr * 64 + fr, fq * 8), boff = lds_byte(wc * 32 + fr, fq * 8);
#define PG8_SA(b, h) (((b) * 2 + (h)) * HTB)
#define PG8_SB(b, h) ((4 + (b) * 2 + (h)) * HTB)
#define PG8_STAGE(bufoff, gbase, voff) do { _Pragma("unroll") for (int _i = 0; _i < 2; ++_i) \
        __builtin_amdgcn_global_load_lds((const unsigned*)((const char*)(gbase) + (voff)[_i]), (LAS unsigned*)(lds + (bufoff) + ldsw + _i * 8192), 16, 0, 0); } while (0)
#define PG8_LDA(dst, b, h) do { _Pragma("unroll") for (int m = 0; m < 4; ++m) _Pragma("unroll") for (int k = 0; k < 2; ++k) dst[m][k] = *(const LAS bf16x8*)(lds + PG8_SA(b, h) + aoff + m * 2048 + k * 1024); } while (0)
#define PG8_LDB(dst, b, h) do { _Pragma("unroll") for (int n = 0; n < 2; ++n) _Pragma("unroll") for (int k = 0; k < 2; ++k) dst[n][k] = *(const LAS bf16x8*)(lds + PG8_SB(b, h) + boff + n * 2048 + k * 1024); } while (0)
#define PG8_MMA(ai, bj, At, Bt) do { __builtin_amdgcn_s_setprio(1); _Pragma("unroll") for (int m = 0; m < 4; ++m) _Pragma("unroll") for (int n = 0; n < 2; ++n) _Pragma("unroll") for (int k = 0; k < 2; ++k) \
        acc[ai][bj][m][n] = __builtin_amdgcn_mfma_f32_16x16x32_bf16(Bt[n][k], At[m][k], acc[ai][bj][m][n], 0, 0, 0); __builtin_amdgcn_s_setprio(0); } while (0)
#define PG8_WAIT_V(n) asm volatile("s_waitcnt vmcnt(" #n ")" ::: "memory")
#define PG8_WAIT_L(n) asm volatile("s_waitcnt lgkmcnt(" #n ")" ::: "memory")
#define PG8_BAR __builtin_amdgcn_s_barrier()
#define PG8_SCHED __builtin_amdgcn_sched_barrier(0)
#define PG8_APTR(u) ((const char*)g.A + ((size_t)(u).z * g.zA) * 2 + (size_t)(u).pm * 2 * hstepA)
#define PG8_BPTR(u) ((const char*)g.Bt + ((size_t)(u).z * g.zB) * 2 + (size_t)(u).pn * bunit)
    Unit cur, nxt; int ui = 0;
    if (!S.next(0, cur)) return;
    f32x4 acc[2][NBJ][4][2]; typename Epi::State est;
#pragma unroll
    for (int a = 0; a < 2; ++a)
#pragma unroll
        for (int b = 0; b < NBJ; ++b)
#pragma unroll
            for (int m = 0; m < 4; ++m)
#pragma unroll
                for (int n = 0; n < 2; ++n) acc[a][b][m][n] = (f32x4){0.f, 0.f, 0.f, 0.f};
    bf16x8 At[4][2], B0[2][2], B1[2][2];
    const char* cA = PG8_APTR(cur); const char* cB = PG8_BPTR(cur);
    PG8_STAGE(PG8_SB(0, 0), cB, voffB); PG8_STAGE(PG8_SA(0, 0), cA, voffA); PG8_STAGE(PG8_SB(0, 1), cB + hstepB, voffB); PG8_STAGE(PG8_SA(0, 1), cA + hstepA, voffA);
    if (wr == 1) PG8_BAR;
    PG8_WAIT_V(4); PG8_BAR;
    PG8_STAGE(PG8_SB(1, 0), cB + kstep, voffB); PG8_STAGE(PG8_SA(1, 0), cA + kstep, voffA); PG8_STAGE(PG8_SB(1, 1), cB + hstepB + kstep, voffB);
    PG8_WAIT_V(6); PG8_BAR;
    for (;;) {
        const bool has_next = S.next(ui + 1, nxt);
        const char* nA = has_next ? PG8_APTR(nxt) : cA; const char* nB = has_next ? PG8_BPTR(nxt) : cB;
        for (int t = 0; t < nt; t += 2) {
            const bool last = (t == nt - 2);
            const char* a1 = cA + (size_t)(t + 1) * kstep;
            const char* a2 = last ? nA : cA + (size_t)(t + 2) * kstep; const char* b2 = last ? nB : cB + (size_t)(t + 2) * kstep;
            const char* a3 = a2 + kstep; const char* b3 = b2 + kstep;
            PG8_LDB(B0, 0, 0); PG8_SCHED; PG8_LDA(At, 0, 0); PG8_STAGE(PG8_SA(1, 1), a1 + hstepA, voffA);
            PG8_WAIT_L(8); PG8_BAR; PG8_WAIT_L(0); PG8_MMA(0, 0, At, B0); PG8_BAR; PG8_SCHED;
            if constexpr (!HN) PG8_LDB(B1, 0, 1); PG8_STAGE(PG8_SB(0, 0), b2, voffB);
            PG8_BAR; PG8_WAIT_L(0); if constexpr (!HN) PG8_MMA(0, 1, At, B1); PG8_BAR;
            PG8_LDA(At, 0, 1); PG8_STAGE(PG8_SA(0, 0), a2, voffA);
            PG8_BAR; PG8_WAIT_L(0); PG8_MMA(1, 0, At, B0); PG8_BAR; PG8_SCHED;
            PG8_STAGE(PG8_SB(0, 1), b2 + hstepB, voffB);
            PG8_WAIT_V(6); PG8_BAR; if constexpr (!HN) PG8_MMA(1, 1, At, B1); PG8_BAR;
            PG8_LDB(B0, 1, 0); PG8_SCHED; PG8_LDA(At, 1, 0); PG8_STAGE(PG8_SA(0, 1), a2 + hstepA, voffA);
            PG8_WAIT_L(8); PG8_BAR; PG8_WAIT_L(0); PG8_MMA(0, 0, At, B0); PG8_BAR; PG8_SCHED;
            if constexpr (!HN) PG8_LDB(B1, 1, 1); PG8_STAGE(PG8_SB(1, 0), b3, voffB);
            PG8_BAR; PG8_WAIT_L(0); if constexpr (!HN) PG8_MMA(0, 1, At, B1); PG8_BAR;
            PG8_LDA(At, 1, 1); PG8_STAGE(PG8_SA(1, 0), a3, voffA);
            PG8_BAR; PG8_WAIT_L(0); PG8_MMA(1, 0, At, B0); PG8_BAR; PG8_SCHED;
            PG8_STAGE(PG8_SB(1, 1), b3 + hstepB, voffB);
            PG8_WAIT_V(6); PG8_BAR; if constexpr (!HN) PG8_MMA(1, 1, At, B1); PG8_BAR;
        }
        E(acc, est, cur, wr, wc, fr, fq);
        if (!has_next) break;
#pragma unroll
        for (int a = 0; a < 2; ++a)
#pragma unroll
            for (int b = 0; b < NBJ; ++b)
#pragma unroll
                for (int m = 0; m < 4; ++m)
#pragma unroll
                    for (int n = 0; n < 2; ++n) acc[a][b][m][n] = (f32x4){0.f, 0.f, 0.f, 0.f};
        cur = nxt; cA = nA; cB = nB; ++ui;
    }
    PG8_WAIT_V(0);
    if (wr == 0) PG8_BAR;
    PG8_BAR;
#undef PG8_SA
#undef PG8_SB
#undef PG8_STAGE
#undef PG8_LDA
#undef PG8_LDB
#undef PG8_MMA
#undef PG8_WAIT_V
#undef PG8_WAIT_L
#undef PG8_BAR
#undef PG8_SCHED
#undef PG8_APTR
#undef PG8_BPTR
}
}

struct Args {
    const float* x; const int* pos; const float* norm_mix; const float* w_in; const float* b_gate;
    const float* cmp_pos_k; const float* cmp_pos_v; const float* cmp_wk1; const float* cmp_wk2; const float* cmp_wv1; const float* cmp_wv2;
    const float* gla_w_alpha; const float* gla_b_alpha; const float* gla_norm; const float* fox_b_f;
    const float* w_branch; const float* w_out; const float* norm_ff; const float* w_ff1; const float* w_ff2; const float* norm_final;
    float* out; unsigned char* ws;
    int l_lo, l_hi, p_lo, p_hi, do_final, pad;
};

struct Ctx { LAS unsigned char* lds; int tid, lane, wave, G, bid, gw, NGW; };
__device__ __forceinline__ Ctx make_ctx(LAS unsigned char* lds, int wave_s) {
    Ctx C; asm volatile("" : "+s"(wave_s)); int t = wave_s * 64 + lane_id(); asm volatile("" : "+v"(t));
    C.lds = lds; C.tid = t; C.lane = t & 63; C.wave = __builtin_amdgcn_readfirstlane(t >> 6); C.G = gridDim.x; C.bid = blockIdx.x; C.gw = C.bid * NWAVES + C.wave; C.NGW = C.G * NWAVES; return C;
}

template <bool MAP>
__device__ __forceinline__ void transpose_item(const float* W, int Nsrc, int Kdim, bf16_t* WT, LAS float* scr, int k0, int n0, int lane) {
    const int kr = lane >> 4, nq = lane & 15; const int nn = n0 + 4 * nq; const int sc = MAP ? win_src_col(nn) : nn;
    f32x4 v[16];
#pragma unroll
    for (int i = 0; i < 16; ++i) v[i] = (sc >= 0) ? *(const f32x4*)(W + (size_t)(k0 + 4 * i + kr) * Nsrc + sc) : (f32x4){0.f, 0.f, 0.f, 0.f};
#pragma unroll
    for (int i = 0; i < 16; ++i) { const int k = 4 * i + kr;
#pragma unroll
        for (int j = 0; j < 4; ++j) scr[(4 * nq + j) * 65 + k] = v[i][j]; }
    asm volatile("s_waitcnt lgkmcnt(0)" ::: "memory");
#pragma unroll
    for (int c = 0; c < 8; ++c) { const LAS float* sp = scr + lane * 65 + 8 * c;
        u32x4 o; o.x = pk2(sp[0], sp[1]); o.y = pk2(sp[2], sp[3]); o.z = pk2(sp[4], sp[5]); o.w = pk2(sp[6], sp[7]);
        *(u32x4*)(WT + (size_t)(n0 + lane) * Kdim + k0 + 8 * c) = o; }
    asm volatile("s_waitcnt lgkmcnt(0)" ::: "memory");
}
template <bool MAP>
__device__ __forceinline__ void transpose_matrix(const Ctx& C, const float* W, int Kdim, int Nsrc, int Ndst, bf16_t* WT, int& base) {
    LAS float* scr = (LAS float*)(C.lds + C.wave * 16640);
    const int nblk = Ndst / 64, items = (Kdim / 64) * nblk;
    int first = (C.gw - base % C.NGW + C.NGW) % C.NGW;
    for (int it = first; it < items; it += C.NGW) { const int kb = it / nblk, nb = it % nblk; transpose_item<MAP>(W, Nsrc, Kdim, WT, scr, 64 * kb, 64 * nb, C.lane); }
    base += items;
}
__device__ __forceinline__ void xg_rows_phase(const Ctx& C, const float* x, const float* g, bf16_t* hb, float* rstd) {
    for (int m = C.gw; m < M; m += C.NGW) {
        const f32x4* xr = (const f32x4*)(x + (size_t)m * DM) + C.lane; const f32x4* gr = (const f32x4*)g + C.lane;
        f32x4 v[4]; float s = 0.f;
#pragma unroll
        for (int j = 0; j < 4; ++j) { v[j] = xr[64 * j]; s += (v[j].x * v[j].x + v[j].y * v[j].y) + (v[j].z * v[j].z + v[j].w * v[j].w); }
        s = wave_sum(s); if (C.lane == 0) rstd[m] = rsqrtf(s * (1.f / DM) + EPS);
        unsigned long long* o8 = (unsigned long long*)(hb + (size_t)m * DM) + C.lane;
#pragma unroll
        for (int j = 0; j < 4; ++j) { const f32x4 gg = gr[64 * j]; o8[64 * j] = (unsigned long long)pk2(v[j].x * gg.x, v[j].y * gg.y) | ((unsigned long long)pk2(v[j].z * gg.z, v[j].w * gg.w) << 32); }
    }
}
__device__ __forceinline__ void final_norm_phase(const Ctx& C, float* x, const float* g) {
    for (int m = C.gw; m < M; m += C.NGW) {
        f32x4* xr = (f32x4*)(x + (size_t)m * DM) + C.lane; const f32x4* gr = (const f32x4*)g + C.lane;
        f32x4 v[4]; float s = 0.f;
#pragma unroll
        for (int j = 0; j < 4; ++j) { v[j] = xr[64 * j]; s += (v[j].x * v[j].x + v[j].y * v[j].y) + (v[j].z * v[j].z + v[j].w * v[j].w); }
        const float r = rsqrtf(wave_sum(s) * (1.f / DM) + EPS);
#pragma unroll
        for (int j = 0; j < 4; ++j) xr[64 * j] = v[j] * r * gr[64 * j];
    }
}

__device__ __forceinline__ void ld8(const bf16_t* p, float (&o)[8]) {
    const u32x4 w = *(const u32x4*)p;
    o[0] = bflo(w.x); o[1] = bfhi(w.x); o[2] = bflo(w.y); o[3] = bfhi(w.y); o[4] = bflo(w.z); o[5] = bfhi(w.z); o[6] = bflo(w.w); o[7] = bfhi(w.w);
}
__device__ __forceinline__ float dot64(const float (&q)[64], const bf16_t* k) {
    float s = 0.f;
#pragma unroll
    for (int c = 0; c < 8; ++c) { float kv[8]; ld8(k + 8 * c, kv);
#pragma unroll
        for (int j = 0; j < 8; ++j) s += q[8 * c + j] * kv[j]; }
    return s;
}
__device__ __forceinline__ void axpy64(float (&acc)[64], float p, const bf16_t* v) {
#pragma unroll
    for (int c = 0; c < 8; ++c) { float vv[8]; ld8(v + 8 * c, vv);
#pragma unroll
        for (int j = 0; j < 8; ++j) acc[8 * c + j] += p * vv[j]; }
}
__device__ __forceinline__ void ldq64(float (&q)[64], const bf16_t* p, float scale) {
#pragma unroll
    for (int c = 0; c < 8; ++c) { float t[8]; ld8(p + 8 * c, t);
#pragma unroll
        for (int j = 0; j < 8; ++j) q[8 * c + j] = t[j] * scale; }
}
struct OS { float m, l; };
#define OS_STEP(sc) do { const float mn_ = fmaxf(st.m, (sc)); const float al_ = __expf(st.m - mn_); const float p_ = __expf((sc) - mn_); st.l = st.l * al_ + p_; \
    _Pragma("unroll") for (int d_ = 0; d_ < 64; ++d_) acc[d_] *= al_; axpy64(acc, p_, vrow); st.m = mn_; } while (0)

__device__ __forceinline__ void rope_rotate(bf16_t* p, int posv) {
    u32x4 a = *(u32x4*)p, b = *(u32x4*)(p + 8);
    float x1[8] = {bflo(a.x), bfhi(a.x), bflo(a.y), bfhi(a.y), bflo(a.z), bfhi(a.z), bflo(a.w), bfhi(a.w)};
    float x2[8] = {bflo(b.x), bfhi(b.x), bflo(b.y), bfhi(b.y), bflo(b.z), bfhi(b.z), bflo(b.w), bfhi(b.w)};
    float o1[8], o2[8];
#pragma unroll
    for (int i = 0; i < 8; ++i) { const float inv = powf(500000.0f, -(float)(2 * i) / 16.0f); const float ang = (float)posv * inv; float sn, cs; sincosf(ang, &sn, &cs);
        o1[i] = x1[i] * cs - x2[i] * sn; o2[i] = x2[i] * cs + x1[i] * sn; }
    a.x = pk2(o1[0], o1[1]); a.y = pk2(o1[2], o1[3]); a.z = pk2(o1[4], o1[5]); a.w = pk2(o1[6], o1[7]);
    b.x = pk2(o2[0], o2[1]); b.y = pk2(o2[2], o2[3]); b.z = pk2(o2[4], o2[5]); b.w = pk2(o2[6], o2[7]);
    *(u32x4*)p = a; *(u32x4*)(p + 8) = b;
}
__device__ __forceinline__ float gelu_tanh(float x) { const float u = 0.7978845608028654f * (x + 0.044715f * x * x * x); return 0.5f * x * (1.0f + tanhf(u)); }

__device__ __forceinline__ void naive_prepA(const Ctx& C, const Args& a, int l, bf16_t* proj, float* cum, float* ch) {
    const int gt = C.bid * NTHR + C.tid, NT = C.G * NTHR;
    for (int i = gt; i < M * 12; i += NT) { const int tok = i / 12, j = i % 12; const int col = j < 8 ? P_NQ + j * 64 : (j < 10 ? P_KS + (j - 8) * 64 : P_KW + (j - 10) * 64);
        rope_rotate(proj + (size_t)tok * LDP + col, a.pos[tok]); }
    for (int bh = C.gw; bh < NB * 8; bh += C.NGW) { const int b = bh >> 3, h = bh & 7; const float bf = a.fox_b_f[l * 8 + h];
        float loc[32]; float run = 0.f;
#pragma unroll
        for (int i = 0; i < 32; ++i) { const int s = C.lane * 32 + i; const float f = bf2f(proj[(size_t)(b * SEQ + s) * LDP + P_FF + h]); run += logsigmoidf_(f + bf); loc[i] = run; }
        float incl = run;
#pragma unroll
        for (int o = 1; o < 64; o <<= 1) { const float t = __shfl_up(incl, o); if (C.lane >= o) incl += t; }
        const float excl = incl - run;
#pragma unroll
        for (int i = 0; i < 32; ++i) cum[(size_t)bh * SEQ + C.lane * 32 + i] = excl + loc[i]; }
    const int NCH = 2 * NB * 127 * 2 * 256;
    for (int i = gt; i < NCH; i += NT) { const int j = i & 255; int r = i >> 8; const int g = r & 1; r >>= 1; const int c = r % 127; r /= 127; const int b = r % NB; const int kv = r / NB;
        const float* w1 = (kv ? a.cmp_wv1 : a.cmp_wk1) + (size_t)l * 2048 * 256; const float* pe = (kv ? a.cmp_pos_v : a.cmp_pos_k) + (size_t)l * 32 * 64;
        const int col = (kv ? P_VC : P_KC) + g * 64; float s = 0.f;
        for (int ll = 0; ll < 32; ++ll) { const bf16_t* xr = proj + (size_t)(b * SEQ + 16 * c + ll) * LDP + col;
            for (int d8 = 0; d8 < 8; ++d8) { float xv[8]; ld8(xr + 8 * d8, xv);
#pragma unroll
                for (int d = 0; d < 8; ++d) s += (xv[d] + pe[ll * 64 + d8 * 8 + d]) * w1[(size_t)(ll * 64 + d8 * 8 + d) * 256 + j]; } }
        ch[i] = gelu_tanh(s); }
}
__device__ __forceinline__ void naive_prepB(const Ctx& C, const Args& a, int l, const float* ch, bf16_t* kcvc) {
    const int gt = C.bid * NTHR + C.tid, NT = C.G * NTHR; const int NO = 2 * NB * 127 * 2 * 64;
    for (int i = gt; i < 2 * NB * 128; i += NT) { const int kv = i / (NB * 128), b = (i / 128) % NB, e = i % 128; kcvc[((((size_t)kv * NB + b) * 128 + 127) * 2) * 64 + e] = 0; }
    for (int i = gt; i < NO; i += NT) { const int d = i & 63; int r = i >> 6; const int g = r & 1; r >>= 1; const int c = r % 127; r /= 127; const int b = r % NB; const int kv = r / NB;
        const float* w2 = (kv ? a.cmp_wv2 : a.cmp_wk2) + (size_t)l * 256 * 64; const float* hrow = ch + ((((size_t)kv * NB + b) * 127 + c) * 2 + g) * 256;
        float v = 0.f, vp = 0.f; const int dp = (d < 8) ? d + 8 : d - 8;
        for (int j = 0; j < 256; ++j) { const float hv = hrow[j]; v += hv * w2[j * 64 + d]; if (d < 16) vp += hv * w2[j * 64 + dp]; }
        if (kv == 0 && d < 16) { const int i8 = d & 7; const float inv = powf(500000.0f, -(float)(2 * i8) / 16.0f); const float ang = (float)a.pos[b * SEQ + 16 * c + 31] * inv; float sn, cs; sincosf(ang, &sn, &cs);
            v = (d < 8) ? (v * cs - vp * sn) : (v * cs + vp * sn); }
        kcvc[((((size_t)kv * NB + b) * 128 + c) * 2 + g) * 64 + d] = (bf16_t)f2bf(v); }
}

__device__ __forceinline__ void naive_fox(const Ctx& C, const bf16_t* proj, const float* cum, bf16_t* ys) {
    for (int blk = C.bid; blk < NB * 8 * 4; blk += C.G) { const int bh = blk >> 2, b = bh >> 3, h = bh & 7; const int t = (blk & 3) * 512 + C.tid;
        const size_t rowb = (size_t)b * SEQ; float q[64]; ldq64(q, proj + (rowb + t) * LDP + P_FQ + h * 64, 0.125f);
        const float ct = cum[(size_t)bh * SEQ + t]; float acc[64];
#pragma unroll
        for (int d = 0; d < 64; ++d) acc[d] = 0.f;
        OS st; st.m = -1e30f; st.l = 0.f; const int tmax = t | 63;
        for (int s = 0; s <= tmax; ++s) { const bf16_t* krow = proj + (rowb + s) * LDP + P_FK + h * 64; const bf16_t* vrow = proj + (rowb + s) * LDP + P_FV + h * 64;
            if (s <= t) { const float sc = dot64(q, krow) + ct - cum[(size_t)bh * SEQ + s]; OS_STEP(sc); } }
        const float il = 1.f / st.l; bf16_t* o = ys + ((size_t)3 * M + rowb + t) * 512 + h * 64;
#pragma unroll
        for (int d = 0; d < 64; d += 2) *(unsigned*)(o + d) = pk2(acc[d] * il, acc[d + 1] * il); }
}
__device__ __forceinline__ void naive_sb(const Ctx& C, const bf16_t* proj, bf16_t* ys) {
    for (int blk = C.bid; blk < NB * 8 * 4; blk += C.G) { const int bh = blk >> 2, b = bh >> 3, h = bh & 7; const int t = (blk & 3) * 512 + C.tid;
        const size_t rowb = (size_t)b * SEQ; float q[64]; ldq64(q, proj + (rowb + t) * LDP + P_SQ + h * 64, 0.125f);
        float acc[64];
#pragma unroll
        for (int d = 0; d < 64; ++d) acc[d] = 0.f;
        float R = 0.f; const int tmax = t | 63;
        for (int s = tmax - 1; s >= 0; --s) { const bf16_t* krow = proj + (rowb + s) * LDP + P_SK + h * 64; const bf16_t* vrow = proj + (rowb + s) * LDP + P_SV + h * 64;
            if (s < t) { const float z = dot64(q, krow); const float sp = softplusf_(z); const float av = __expf(z - sp - R); axpy64(acc, av, vrow); R += sp; } }
        bf16_t* o = ys + ((size_t)1 * M + rowb + t) * 512 + h * 64;
#pragma unroll
        for (int d = 0; d < 64; d += 2) *(unsigned*)(o + d) = pk2(acc[d], acc[d + 1]); }
}
__device__ __forceinline__ void naive_gla(const Ctx& C, const Args& a, int l, const bf16_t* proj, float* obuf, bf16_t* ys) {
    LAS float* red = (LAS float*)C.lds;
    for (int bh = C.bid; bh < NB * 4; bh += C.G) { const int b = bh >> 2, h = bh & 3; const int kk = C.tid >> 3, vs = C.tid & 7; const size_t rowb = (size_t)b * SEQ;
        float wa[16];
#pragma unroll
        for (int r = 0; r < 16; ++r) wa[r] = a.gla_w_alpha[(size_t)l * 16 * 256 + r * 256 + h * 64 + kk];
        const float ba = a.gla_b_alpha[l * 256 + h * 64 + kk];
        float stt[16];
#pragma unroll
        for (int i = 0; i < 16; ++i) stt[i] = 0.f;
        for (int t = 0; t < SEQ; ++t) { const bf16_t* pr = proj + (rowb + t) * LDP;
            float al[16]; { float t0[8], t1[8]; ld8(pr + P_GA, t0); ld8(pr + P_GA + 8, t1);
#pragma unroll
                for (int r = 0; r < 8; ++r) { al[r] = t0[r]; al[8 + r] = t1[r]; } }
            float xa = ba;
#pragma unroll
            for (int r = 0; r < 16; ++r) xa += al[r] * wa[r];
            const float dec = __expf(logsigmoidf_(xa) * (1.0f / 16.0f));
            const float kv = bf2f(pr[P_GK + h * 64 + kk]), qv = bf2f(pr[P_GQ + h * 64 + kk]) * 0.125f;
            float vv[16]; { float t0[8], t1[8]; ld8(pr + P_GV + h * 128 + vs * 16, t0); ld8(pr + P_GV + h * 128 + vs * 16 + 8, t1);
#pragma unroll
                for (int r = 0; r < 8; ++r) { vv[r] = t0[r]; vv[8 + r] = t1[r]; } }
            float po[16];
#pragma unroll
            for (int i = 0; i < 16; ++i) { stt[i] = dec * stt[i] + kv * vv[i]; po[i] = qv * stt[i]; }
#pragma unroll
            for (int i = 0; i < 16; ++i) { po[i] += __shfl_xor(po[i], 8); po[i] += __shfl_xor(po[i], 16); po[i] += __shfl_xor(po[i], 32); }
            LAS float* rb = red + (t & 1) * 1024 + C.wave * 128;
            if (C.lane < 8) {
#pragma unroll
                for (int i = 0; i < 16; ++i) rb[C.lane * 16 + i] = po[i]; }
            __syncthreads();
            if (C.tid < 128) { float s = 0.f;
#pragma unroll
                for (int w = 0; w < 8; ++w) s += red[(t & 1) * 1024 + w * 128 + C.tid];
                obuf[(rowb + t) * 512 + h * 128 + C.tid] = s; } }
        __syncthreads();
        for (int t = C.wave; t < SEQ; t += NWAVES) { const float* orow = obuf + (rowb + t) * 512 + h * 128; const float o0 = orow[C.lane], o1 = orow[C.lane + 64];
            const float ss = wave_sum(o0 * o0 + o1 * o1); const float r = rsqrtf(ss * (1.f / 128.f) + EPS);
            const bf16_t* gp = proj + (rowb + t) * LDP + P_GG + h * 128; const float g0 = bf2f(gp[C.lane]), g1 = bf2f(gp[C.lane + 64]);
            const float n0 = a.gla_norm[l * 128 + C.lane], n1 = a.gla_norm[l * 128 + C.lane + 64];
            bf16_t* yo = ys + ((size_t)2 * M + rowb + t) * 512 + h * 128;
            yo[C.lane] = (bf16_t)f2bf(o0 * r * n0 * (g0 * sigmoidf_(g0))); yo[C.lane + 64] = (bf16_t)f2bf(o1 * r * n1 * (g1 * sigmoidf_(g1))); }
        __syncthreads(); }
}
__device__ __forceinline__ void naive_nsa(const Ctx& C, const bf16_t* proj, const bf16_t* kcvc, float* yf, bf16_t* ys) {
    LAS float* imp = (LAS float*)C.lds;
    for (int blk = C.bid; blk < NB * 2 * 4; blk += C.G) { const int bg = blk >> 2, b = bg >> 1, g = bg & 1; const int t = (blk & 3) * 512 + C.tid; const size_t rowb = (size_t)b * SEQ;
        const bf16_t* prow = proj + (rowb + t) * LDP;
#pragma unroll
        for (int j = 0; j < 32; ++j) imp[j * 512 + C.tid] = 0.f;
        const int ncv = (t >= 31) ? ((t - 31) / 16 + 1) : 0; const int tw = t | 63; const int ncv_w = (tw >= 31) ? ((tw - 31) / 16 + 1) : 0;
        const bf16_t* kc = kcvc + (((size_t)0 * NB + b) * 128 * 2 + g) * 64; const bf16_t* vc = kcvc + (((size_t)1 * NB + b) * 128 * 2 + g) * 64;
        for (int hp = 0; hp < 4; ++hp) { const int h = g * 4 + hp; float q[64]; ldq64(q, prow + P_NQ + h * 64, 0.125f);
            float m = -1e30f, lsum = 0.f;
            for (int c = 0; c < ncv_w; ++c) if (c < ncv) { const float sc = dot64(q, kc + (size_t)c * 128); const float mn = fmaxf(m, sc); lsum = lsum * __expf(m - mn) + __expf(sc - mn); m = mn; }
            float acc[64];
#pragma unroll
            for (int d = 0; d < 64; ++d) acc[d] = 0.f;
            const float il = (ncv > 0) ? 1.f / lsum : 0.f;
            for (int c = 0; c < ncv_w; ++c) if (c < ncv) { const float sc = dot64(q, kc + (size_t)c * 128); const float p = __expf(sc - m) * il; axpy64(acc, p, vc + (size_t)c * 128);
                const int j = c >> 2, r = c & 3;
                if (r < 3) imp[j * 512 + C.tid] += p; else { imp[j * 512 + C.tid] += 0.5f * p; imp[(j + 1) * 512 + C.tid] += 0.5f * p; } }
            const float gc = sigmoidf_(bf2f(prow[P_NG + h * 3 + 0])); float* yo = yf + (rowb + t) * 512 + h * 64;
#pragma unroll
            for (int d = 0; d < 64; ++d) yo[d] = gc * acc[d]; }
        const int jt = t >> 6;
#pragma unroll
        for (int j = 0; j < 32; ++j) { float v = imp[j * 512 + C.tid]; if (j == 0 || j == jt) v = __builtin_inff(); else if (64 * j > t) v = -__builtin_inff(); imp[j * 512 + C.tid] = v; }
        unsigned sel = 0u;
        for (int j = 0; j < 32; ++j) { const float vj = imp[j * 512 + C.tid]; int rank = 0;
            for (int j2 = 0; j2 < 32; ++j2) { const float v2 = imp[j2 * 512 + C.tid]; rank += (v2 > vj || (v2 == vj && j2 < j)) ? 1 : 0; }
            if (rank < 8) sel |= (1u << j); }
        const int twmin = t & ~63;
        for (int hp = 0; hp < 4; ++hp) { const int h = g * 4 + hp; float q[64]; ldq64(q, prow + P_NQ + h * 64, 0.125f);
            float* yo = yf + (rowb + t) * 512 + h * 64;
            { float acc[64];
#pragma unroll
              for (int d = 0; d < 64; ++d) acc[d] = 0.f;
              OS st; st.m = -1e30f; st.l = 0.f;
              for (int s = 0; s <= tw; ++s) { if (s <= t && ((sel >> (s >> 6)) & 1u)) { const bf16_t* krow = proj + (rowb + s) * LDP + P_KS + g * 64; const bf16_t* vrow = proj + (rowb + s) * LDP + P_VS + g * 64;
                    const float sc = dot64(q, krow); OS_STEP(sc); } }
              const float gs = sigmoidf_(bf2f(prow[P_NG + h * 3 + 1])) / st.l;
#pragma unroll
              for (int d = 0; d < 64; ++d) yo[d] += gs * acc[d]; }
            { float acc[64];
#pragma unroll
              for (int d = 0; d < 64; ++d) acc[d] = 0.f;
              OS st; st.m = -1e30f; st.l = 0.f; const int slo = (twmin - 255) > 0 ? (twmin - 255) : 0;
              for (int s = slo; s <= tw; ++s) { if (s <= t && s > t - 256) { const bf16_t* krow = proj + (rowb + s) * LDP + P_KW + g * 64; const bf16_t* vrow = proj + (rowb + s) * LDP + P_VW + g * 64;
                    const float sc = dot64(q, krow); OS_STEP(sc); } }
              const float gw = sigmoidf_(bf2f(prow[P_NG + h * 3 + 2])) / st.l; bf16_t* o = ys + ((size_t)0 * M + rowb + t) * 512 + h * 64;
#pragma unroll
              for (int d = 0; d < 64; d += 2) *(unsigned*)(o + d) = pk2(yo[d] + gw * acc[d], yo[d + 1] + gw * acc[d + 1]); } }
        __syncthreads(); }
}

namespace att {
typedef float f32x16 __attribute__((ext_vector_type(16)));
typedef short s16x4 __attribute__((ext_vector_type(4)));
constexpr float LOG2E = 1.4426950408889634f;
constexpr float CS = 0.125f * LOG2E;
constexpr int SLOT = 16384;
constexpr int L_RING = 0, L_WSF = 65536, L_OST = 67584, L_X = 100352;
#define RING_WAIT() do { asm volatile("s_waitcnt vmcnt(4) lgkmcnt(0)" ::: "memory"); __builtin_amdgcn_s_barrier(); asm volatile("" ::: "memory"); } while (0)
#define RING_DRAIN() do { asm volatile("s_waitcnt vmcnt(0) lgkmcnt(0)" ::: "memory"); __builtin_amdgcn_s_barrier(); asm volatile("" ::: "memory"); } while (0)
__device__ __forceinline__ int crow(int r, int hi) { return (r & 3) + 8 * (r >> 2) + 4 * hi; }
__device__ __forceinline__ unsigned cvtpk(float lo, float hi) { unsigned r; asm volatile("v_cvt_pk_bf16_f32 %0, %1, %2" : "=v"(r) : "v"(lo), "v"(hi)); return r; }
__device__ __forceinline__ float swap_half(float v) { return __shfl_xor(v, 32); }

__device__ __forceinline__ void dma_kv(LAS unsigned char* slot, const bf16_t* kbase, const bf16_t* vbase, int pitch, int wid, int lane) {
    const bf16_t* ks = kbase + (size_t)lane * pitch + wid * 8;
    const bf16_t* vs = vbase + (size_t)(16 * (wid & 3) + (lane >> 2)) * pitch + (wid >> 2) * 32 + (lane & 3) * 8;
    __builtin_amdgcn_global_load_lds((const unsigned*)ks, (LAS unsigned*)(slot + wid * 1024), 16, 0, 0);
    __builtin_amdgcn_global_load_lds((const unsigned*)vs, (LAS unsigned*)(slot + 8192 + wid * 1024), 16, 0, 0);
}
template <int NB = 8>
__device__ __forceinline__ void qkt(f32x16& p0, f32x16& p1, const LAS unsigned char* kslot, const bf16x8 (&qr)[4], int r32, int hi) {
    const LAS unsigned char* kb = kslot + hi * 1024 + r32 * 16;
    const f32x16 z = {0.f, 0.f, 0.f, 0.f, 0.f, 0.f, 0.f, 0.f, 0.f, 0.f, 0.f, 0.f, 0.f, 0.f, 0.f, 0.f};
    p0 = z; p1 = z;
#pragma unroll
    for (int g = 0; g < 8 / NB; ++g) {
        bf16x8 kf[NB];
#pragma unroll
        for (int j = 0; j < NB / 2; ++j) { const int d0 = g * (NB / 2) + j; kf[2 * j] = *(const LAS bf16x8*)(kb + d0 * 2048); kf[2 * j + 1] = *(const LAS bf16x8*)(kb + d0 * 2048 + 512); }
        __builtin_amdgcn_sched_barrier(0);
#pragma unroll
        for (int j = 0; j < NB / 2; ++j) { const int d0 = g * (NB / 2) + j;
            p0 = __builtin_amdgcn_mfma_f32_32x32x16_bf16(kf[2 * j], qr[d0], p0, 0, 0, 0);
            p1 = __builtin_amdgcn_mfma_f32_32x32x16_bf16(kf[2 * j + 1], qr[d0], p1, 0, 0, 0); }
    }
}
typedef short v4i16_t __attribute__((ext_vector_type(4)));
__device__ __forceinline__ s16x4 vtr(const LAS unsigned char* p) { return __builtin_bit_cast(s16x4, __builtin_amdgcn_ds_read_tr16_b64_v4i16((LAS v4i16_t*)p)); }
__device__ __forceinline__ bf16x8 vfrag(const LAS unsigned char* vslot, int dh, int ks, int lane) {
    const int hi = lane >> 5;
    const LAS unsigned char* p = vslot + dh * 4096 + ks * 1024 + ((lane >> 4) & 1) * 32 + (lane & 3) * 8 + (4 * hi + ((lane & 15) >> 2)) * 64;
    const s16x4 lo = vtr(p), hh = vtr(p + 512);
    return (bf16x8){lo[0], lo[1], lo[2], lo[3], hh[0], hh[1], hh[2], hh[3]};
}
__device__ __forceinline__ void pack_p(const f32x16& p0, const f32x16& p1, bf16x8 (&pa)[4]) {
    u32x4 w;
    w.x = cvtpk(p0[0], p0[1]); w.y = cvtpk(p0[2], p0[3]); w.z = cvtpk(p0[4], p0[5]); w.w = cvtpk(p0[6], p0[7]); pa[0] = __builtin_bit_cast(bf16x8, w);
    w.x = cvtpk(p0[8], p0[9]); w.y = cvtpk(p0[10], p0[11]); w.z = cvtpk(p0[12], p0[13]); w.w = cvtpk(p0[14], p0[15]); pa[1] = __builtin_bit_cast(bf16x8, w);
    w.x = cvtpk(p1[0], p1[1]); w.y = cvtpk(p1[2], p1[3]); w.z = cvtpk(p1[4], p1[5]); w.w = cvtpk(p1[6], p1[7]); pa[2] = __builtin_bit_cast(bf16x8, w);
    w.x = cvtpk(p1[8], p1[9]); w.y = cvtpk(p1[10], p1[11]); w.z = cvtpk(p1[12], p1[13]); w.w = cvtpk(p1[14], p1[15]); pa[3] = __builtin_bit_cast(bf16x8, w);
}
__device__ __forceinline__ void pv(f32x16 (&o)[2], const LAS unsigned char* vslot, const bf16x8 (&pa)[4], int lane) {
    const int hi = lane >> 5;
    const unsigned vb = (unsigned)(uintptr_t)vslot + ((lane >> 4) & 1) * 32 + (lane & 3) * 8 + (4 * hi + ((lane & 15) >> 2)) * 64;
#define PV_HALF(D0) do { s16x4 l0, l1, l2, l3, h0, h1, h2, h3; \
        asm volatile("ds_read_b64_tr_b16 %0, %8 offset:%c9\n\tds_read_b64_tr_b16 %4, %8 offset:%c10\n\tds_read_b64_tr_b16 %1, %8 offset:%c11\n\tds_read_b64_tr_b16 %5, %8 offset:%c12\n\t" \
                     "ds_read_b64_tr_b16 %2, %8 offset:%c13\n\tds_read_b64_tr_b16 %6, %8 offset:%c14\n\tds_read_b64_tr_b16 %3, %8 offset:%c15\n\tds_read_b64_tr_b16 %7, %8 offset:%c16\n\ts_waitcnt lgkmcnt(0)" \
                     : "=&v"(l0), "=&v"(l1), "=&v"(l2), "=&v"(l3), "=&v"(h0), "=&v"(h1), "=&v"(h2), "=&v"(h3) \
                     : "v"(vb), "i"((D0) * 4096), "i"((D0) * 4096 + 512), "i"((D0) * 4096 + 1024), "i"((D0) * 4096 + 1536), "i"((D0) * 4096 + 2048), "i"((D0) * 4096 + 2560), "i"((D0) * 4096 + 3072), "i"((D0) * 4096 + 3584) : "memory"); \
        __builtin_amdgcn_sched_barrier(0); \
        o[D0] = __builtin_amdgcn_mfma_f32_32x32x16_bf16(pa[0], ((bf16x8){l0[0], l0[1], l0[2], l0[3], h0[0], h0[1], h0[2], h0[3]}), o[D0], 0, 0, 0); \
        o[D0] = __builtin_amdgcn_mfma_f32_32x32x16_bf16(pa[1], ((bf16x8){l1[0], l1[1], l1[2], l1[3], h1[0], h1[1], h1[2], h1[3]}), o[D0], 0, 0, 0); \
        o[D0] = __builtin_amdgcn_mfma_f32_32x32x16_bf16(pa[2], ((bf16x8){l2[0], l2[1], l2[2], l2[3], h2[0], h2[1], h2[2], h2[3]}), o[D0], 0, 0, 0); \
        o[D0] = __builtin_amdgcn_mfma_f32_32x32x16_bf16(pa[3], ((bf16x8){l3[0], l3[1], l3[2], l3[3], h3[0], h3[1], h3[2], h3[3]}), o[D0], 0, 0, 0); } while (0)
    PV_HALF(0); PV_HALF(1);
#undef PV_HALF
}
__device__ __forceinline__ float rowmax32(const f32x16& p0, const f32x16& p1) {
    float a = fmaxf(p0[0], p1[0]);
#pragma unroll
    for (int r = 1; r < 16; ++r) a = fmaxf(a, fmaxf(p0[r], p1[r]));
    return fmaxf(a, swap_half(a));
}
__device__ __forceinline__ void scale_rows(f32x16 (&o)[2], float f, LAS float* wsf, int r32, int hi) {
    if (hi == 0) wsf[r32] = f;
    asm volatile("s_waitcnt lgkmcnt(0)" ::: "memory");
#pragma unroll
    for (int g4 = 0; g4 < 4; ++g4) { const f32x4 fv = *(const LAS f32x4*)(wsf + 8 * g4 + 4 * hi);
#pragma unroll
        for (int j = 0; j < 4; ++j) { o[0][4 * g4 + j] *= fv[j]; o[1][4 * g4 + j] *= fv[j]; } }
    asm volatile("s_waitcnt lgkmcnt(0)" ::: "memory");
}
template <bool RAW>
__device__ __forceinline__ void softmax_tile(f32x16& p0, f32x16& p1, float& m, float& l, f32x16 (&o)[2], LAS float* wsf, int r32, int hi) {
    const float sc = RAW ? CS : 1.0f;
    const float mx = rowmax32(p0, p1);
    const float mnew = fmaxf(m, mx);
    if (__any(mnew > m)) { const float al = __builtin_amdgcn_exp2f((m - mnew) * sc); l *= al; scale_rows(o, al, wsf, r32, hi); }
    m = mnew;
    const float nm = -m * sc; float s = 0.f;
#pragma unroll
    for (int r = 0; r < 16; ++r) { p0[r] = __builtin_amdgcn_exp2f(__builtin_fmaf(p0[r], sc, nm)); p1[r] = __builtin_amdgcn_exp2f(__builtin_fmaf(p1[r], sc, nm)); s += p0[r] + p1[r]; }
    l += s;
}
__device__ __forceinline__ void store_o(const f32x16 (&o)[2], LAS unsigned char* ost_w, bf16_t* dst, int pitch, int lane) {
    const int r32 = lane & 31, hi = lane >> 5;
    LAS bf16_t* stg = (LAS bf16_t*)ost_w;
#pragma unroll
    for (int r = 0; r < 16; ++r) { const int orow = crow(r, hi);
#pragma unroll
        for (int d0 = 0; d0 < 2; ++d0) stg[orow * 64 + d0 * 32 + r32] = (bf16_t)f2bf(o[d0][r]); }
    asm volatile("s_waitcnt lgkmcnt(0)" ::: "memory");
#pragma unroll
    for (int i = 0; i < 4; ++i) { const int row = i * 8 + (lane >> 3), ch = lane & 7; const u32x4 v = *(const LAS u32x4*)(stg + row * 64 + ch * 8); *(u32x4*)(dst + (size_t)row * pitch + ch * 8) = v; }
    asm volatile("s_waitcnt lgkmcnt(0)" ::: "memory");
}
__device__ __forceinline__ void load_q(bf16x8 (&qr)[4], const bf16_t* qrow, int hi) {
#pragma unroll
    for (int d0 = 0; d0 < 4; ++d0) qr[d0] = *(const bf16x8*)(qrow + d0 * 16 + hi * 8);
}

__device__ __forceinline__ void foxprep_unit(const Ctx& C, int b, int h, const bf16_t* proj, float bfh, float* cum, float* knm) {
    LAS unsigned char* lds = C.lds; const int lane = C.lane, wid = C.wave, tid = C.tid;
    LAS float* wtot = (LAS float*)(lds + L_X); LAS float* tmax = (LAS float*)(lds + L_X + 64);
    const size_t rowb = (size_t)b * SEQ; const int bh = b * 8 + h;
    float c4[4]; float run = 0.f; float nmax = 0.f;
#pragma unroll
    for (int i = 0; i < 4; ++i) { const int s = 4 * tid + i; const bf16_t* pr = proj + (rowb + s) * LDP;
        run += logsigmoidf_(bf2f(pr[P_FF + h]) + bfh); c4[i] = run;
        float n2 = 0.f;
#pragma unroll
        for (int c = 0; c < 8; ++c) { float kv[8]; ld8(pr + P_FK + h * 64 + 8 * c, kv);
#pragma unroll
            for (int j = 0; j < 8; ++j) n2 += kv[j] * kv[j]; }
        nmax = fmaxf(nmax, n2); }
    float incl = run;
#pragma unroll
    for (int o = 1; o < 64; o <<= 1) { const float t = __shfl_up(incl, o); if (lane >= o) incl += t; }
    if (lane == 63) wtot[wid] = incl;
    nmax = fmaxf(nmax, __shfl_xor(nmax, 1)); nmax = fmaxf(nmax, __shfl_xor(nmax, 2)); nmax = fmaxf(nmax, __shfl_xor(nmax, 4)); nmax = fmaxf(nmax, __shfl_xor(nmax, 8));
    if ((tid & 15) == 0) tmax[tid >> 4] = sqrtf(nmax);
    __syncthreads();
    float off = incl - run;
#pragma unroll
    for (int w = 0; w < 8; ++w) off += (w < wid) ? wtot[w] : 0.f;
#pragma unroll
    for (int i = 0; i < 4; ++i) cum[(size_t)bh * SEQ + 4 * tid + i] = off + c4[i];
    if (tid == 0) { float pm = 0.f; for (int t = 0; t < 32; ++t) { pm = fmaxf(pm, tmax[t]); knm[bh * 32 + t] = pm; } }
    __syncthreads();
}
template <int ABL>
__device__ __forceinline__ void fox_unit(const Ctx& C, int b, int h, int qb, const bf16_t* proj, const float* cum, const float* knm, bf16_t* ys) {
    LAS unsigned char* lds = C.lds; const int lane = C.lane, wid = C.wave, r32 = lane & 31, hi = lane >> 5, tid = C.tid;
    LAS float* cumL = (LAS float*)(lds + L_X);
    LAS float* pmL = (LAS float*)(lds + L_X + 8192);
    LAS unsigned* votes = (LAS unsigned*)(lds + L_X + 8192 + 128);
    LAS float* wsf = (LAS float*)(lds + L_WSF) + wid * 64;
    const size_t rowb = (size_t)b * SEQ; const int Q0 = qb * 256, NT = 4 * qb + 4, bh = b * 8 + h;
    const bf16_t* kb = proj + rowb * LDP + P_FK + h * 64; const bf16_t* vb = proj + rowb * LDP + P_FV + h * 64;
#define FOX_DMA(i_) do { const int tt_ = (NT - 1 - (i_)) > 0 ? (NT - 1 - (i_)) : 0; dma_kv(lds + L_RING + ((i_) & 3) * SLOT, kb + (size_t)tt_ * 64 * LDP, vb + (size_t)tt_ * 64 * LDP, LDP, wid, lane); } while (0)
    const float cref = cum[(size_t)bh * SEQ + Q0];
    { const f32x4 c4 = *(const f32x4*)(cum + (size_t)bh * SEQ + 4 * tid); f32x4 o4;
#pragma unroll
      for (int i = 0; i < 4; ++i) o4[i] = (cref - c4[i]) * LOG2E;
      *(LAS f32x4*)(cumL + 4 * tid) = o4; }
    if (tid < 32) pmL[tid] = knm[bh * 32 + tid];
    bf16x8 qr[4]; load_q(qr, proj + (rowb + Q0 + 32 * wid + r32) * LDP + P_FQ + h * 64, hi);
    float qn = 0.f;
#pragma unroll
    for (int d0 = 0; d0 < 4; ++d0)
#pragma unroll
        for (int j = 0; j < 8; ++j) { const float v = bf2f((unsigned short)qr[d0][j]); qn += v * v; }
    qn += swap_half(qn); const float qs = sqrtf(qn) * CS;
    f32x16 o[2];
#pragma unroll
    for (int r = 0; r < 16; ++r) { o[0][r] = 0.f; o[1][r] = 0.f; }
    float m = -1e30f, l = 0.f; bool done = false; const int my_last = 4 * qb + (wid >> 1); const int qidx = Q0 + 32 * wid + r32;
    __syncthreads();
    FOX_DMA(0); FOX_DMA(1); FOX_DMA(2);
    for (int it = 0; it < NT; ++it) {
        const int t = NT - 1 - it;
        RING_WAIT();
        if (it > 0) { unsigned all = 1u;
#pragma unroll
            for (int w = 0; w < 8; ++w) all &= votes[((it - 1) & 1) * 8 + w];
            if (all) break; }
        FOX_DMA(it + 3);
        LAS unsigned char* slot = lds + L_RING + (it & 3) * SLOT;
        if (t <= my_last && !done) {
            f32x16 p0, p1; qkt(p0, p1, slot, qr, r32, hi);
#pragma unroll
            for (int g4 = 0; g4 < 4; ++g4) { const f32x4 b0 = *(const LAS f32x4*)(cumL + 64 * t + 8 * g4 + 4 * hi), b1 = *(const LAS f32x4*)(cumL + 64 * t + 32 + 8 * g4 + 4 * hi);
#pragma unroll
                for (int j = 0; j < 4; ++j) { p0[4 * g4 + j] = __builtin_fmaf(p0[4 * g4 + j], CS, b0[j]); p1[4 * g4 + j] = __builtin_fmaf(p1[4 * g4 + j], CS, b1[j]); } }
            if (t == my_last) {
#pragma unroll
                for (int r = 0; r < 16; ++r) { const int kv = 64 * t + crow(r, hi); if (kv > qidx) p0[r] = -__builtin_inff(); if (kv + 32 > qidx) p1[r] = -__builtin_inff(); } }
            softmax_tile<false>(p0, p1, m, l, o, wsf, r32, hi);
            bf16x8 pa[4]; pack_p(p0, p1, pa);
            pv(o, slot + 8192, pa, lane);
            if (t > 0) { const float bound = qs * pmL[t - 1] + cumL[64 * t - 1]; done = __all(bound < m - 40.0f); }
        }
        if (lane == 0) votes[(it & 1) * 8 + wid] = (done || t == 0) ? 1u : 0u;
    }
    RING_DRAIN();
#undef FOX_DMA
    l += swap_half(l);
    scale_rows(o, 1.0f / l, wsf, r32, hi);
    store_o(o, lds + L_OST + wid * 4096, ys + ((size_t)3 * M + rowb + Q0 + 32 * wid) * 512 + h * 64, 512, lane);
    __syncthreads();
}

__device__ __forceinline__ void sb_unit(const Ctx& C, int b, int h, int qb, const bf16_t* proj, bf16_t* ys) {
    LAS unsigned char* lds = C.lds; const int lane = C.lane, wid = C.wave, r32 = lane & 31, hi = lane >> 5;
    LAS unsigned* votes = (LAS unsigned*)(lds + L_X);
    const size_t rowb = (size_t)b * SEQ; const int Q0 = qb * 256, NT = 4 * qb + 4;
    const bf16_t* kb = proj + rowb * LDP + P_SK + h * 64; const bf16_t* vb = proj + rowb * LDP + P_SV + h * 64;
#define SB_DMA(i_) do { const int tt_ = (NT - 1 - (i_)) > 0 ? (NT - 1 - (i_)) : 0; dma_kv(lds + L_RING + ((i_) & 3) * SLOT, kb + (size_t)tt_ * 64 * LDP, vb + (size_t)tt_ * 64 * LDP, LDP, wid, lane); } while (0)
    bf16x8 qr[4]; load_q(qr, proj + (rowb + Q0 + 32 * wid + r32) * LDP + P_SQ + h * 64, hi);
    bf16x8 ua[2], ones;
#pragma unroll
    for (int s = 0; s < 2; ++s)
#pragma unroll
        for (int e = 0; e < 8; ++e) ua[s][e] = ((16 * s + 8 * (e >> 2) + 4 * hi + (e & 3)) >= r32) ? (short)0x3F80 : (short)0;
#pragma unroll
    for (int e = 0; e < 8; ++e) ones[e] = (short)0x3F80;
    f32x16 o[2];
#pragma unroll
    for (int r = 0; r < 16; ++r) { o[0][r] = 0.f; o[1][r] = 0.f; }
    float R2 = 0.f; bool done = false; const int my_first = 4 * qb + (wid >> 1); const int qidx = Q0 + 32 * wid + r32;
    __syncthreads();
    SB_DMA(0); SB_DMA(1); SB_DMA(2);
    for (int it = 0; it < NT; ++it) {
        const int t = NT - 1 - it;
        RING_WAIT();
        if (it > 0) { unsigned all = 1u;
#pragma unroll
            for (int w = 0; w < 8; ++w) all &= votes[((it - 1) & 1) * 8 + w];
            if (all) break; }
        SB_DMA(it + 3);
        LAS unsigned char* slot = lds + L_RING + (it & 3) * SLOT;
        if (t <= my_first && !done) {
            f32x16 z0, z1; qkt(z0, z1, slot, qr, r32, hi);
            f32x16 sp0, sp1;
#pragma unroll
            for (int r = 0; r < 16; ++r) { z0[r] *= CS; z1[r] *= CS;
                sp0[r] = __builtin_amdgcn_logf(1.0f + __builtin_amdgcn_exp2f(fminf(z0[r], 100.f))); sp1[r] = __builtin_amdgcn_logf(1.0f + __builtin_amdgcn_exp2f(fminf(z1[r], 100.f))); }
            if (t == my_first) {
#pragma unroll
                for (int r = 0; r < 16; ++r) { const int kv = 64 * t + crow(r, hi); if (kv >= qidx) { sp0[r] = 0.f; z0[r] = -__builtin_inff(); } if (kv + 32 >= qidx) { sp1[r] = 0.f; z1[r] = -__builtin_inff(); } } }
            bf16x8 spa[4]; pack_p(sp0, sp1, spa);
            f32x16 S0, S1;
#pragma unroll
            for (int r = 0; r < 16; ++r) { S0[r] = R2; S1[r] = R2; }
            S0 = __builtin_amdgcn_mfma_f32_32x32x16_bf16(ua[0], spa[0], S0, 0, 0, 0); S0 = __builtin_amdgcn_mfma_f32_32x32x16_bf16(ua[1], spa[1], S0, 0, 0, 0);
            S0 = __builtin_amdgcn_mfma_f32_32x32x16_bf16(ones, spa[2], S0, 0, 0, 0); S0 = __builtin_amdgcn_mfma_f32_32x32x16_bf16(ones, spa[3], S0, 0, 0, 0);
            S1 = __builtin_amdgcn_mfma_f32_32x32x16_bf16(ua[0], spa[2], S1, 0, 0, 0); S1 = __builtin_amdgcn_mfma_f32_32x32x16_bf16(ua[1], spa[3], S1, 0, 0, 0);
            f32x16 a0, a1;
#pragma unroll
            for (int r = 0; r < 16; ++r) { a0[r] = __builtin_amdgcn_exp2f(z0[r] - S0[r]); a1[r] = __builtin_amdgcn_exp2f(z1[r] - S1[r]); }
            bf16x8 pa[4]; pack_p(a0, a1, pa);
            pv(o, slot + 8192, pa, lane);
            R2 = __shfl(S0[0], r32);
            done = __all(R2 > 126.0f);
        }
        if (lane == 0) votes[(it & 1) * 8 + wid] = done ? 1u : 0u;
    }
    RING_DRAIN();
#undef SB_DMA
    store_o(o, lds + L_OST + wid * 4096, ys + ((size_t)1 * M + rowb + Q0 + 32 * wid) * 512 + h * 64, 512, lane);
    __syncthreads();
}
}
namespace gla {
using att::f32x16; using att::crow; using att::cvtpk; using att::vfrag;
constexpr int G_LA = 0;
constexpr int G_SEG = 16640;
constexpr int G_WA = 18688;
constexpr int G_QP = 22784;
constexpr int G_KP = 30976;
constexpr int G_KPP = 39168;
constexpr int G_V = 47360;
__device__ __forceinline__ void prep_unit(const Ctx& C, const Args& a, int l, int b, int h, int c, const bf16_t* proj, bf16_t* gqp, float* gdec, float* gds, float* goi) {
    LAS unsigned char* lds = C.lds; const int tid = C.tid, lane = C.lane, wid = C.wave, r32 = lane & 31, hi = lane >> 5;
    LAS float* LA = (LAS float*)(lds + G_LA); LAS float* SEG = (LAS float*)(lds + G_SEG); LAS float* WA = (LAS float*)(lds + G_WA);
    const size_t rowb = (size_t)b * SEQ; const int T0 = 64 * c; const int unit = (b * 4 + h) * 32 + c;
    for (int i = tid; i < 1024; i += NTHR) WA[i] = a.gla_w_alpha[(size_t)l * 16 * 256 + (i >> 6) * 256 + h * 64 + (i & 63)];
    __syncthreads();
    {
        const int t = tid >> 3, k0 = (tid & 7) * 8; const bf16_t* pr = proj + (rowb + T0 + t) * LDP;
        float al[16]; { float t0[8], t1[8]; ld8(pr + P_GA, t0); ld8(pr + P_GA + 8, t1);
#pragma unroll
            for (int r = 0; r < 8; ++r) { al[r] = t0[r]; al[8 + r] = t1[r]; } }
#pragma unroll
        for (int i = 0; i < 8; ++i) { float x = a.gla_b_alpha[l * 256 + h * 64 + k0 + i];
#pragma unroll
            for (int r = 0; r < 16; ++r) x += al[r] * WA[r * 64 + k0 + i];
            LA[t * 65 + k0 + i] = logsigmoidf_(x) * (1.0f / 16.0f); }
    }
    __syncthreads();
    {
        const int k = tid & 63, seg = tid >> 6; float v[8]; float run = 0.f;
#pragma unroll
        for (int i = 0; i < 8; ++i) { run += LA[(8 * seg + i) * 65 + k]; v[i] = run; }
        SEG[seg * 64 + k] = run;
        __syncthreads();
        float off = 0.f;
#pragma unroll
        for (int s = 0; s < 8; ++s) off += (s < seg) ? SEG[s * 64 + k] : 0.f;
#pragma unroll
        for (int i = 0; i < 8; ++i) LA[(8 * seg + i) * 65 + k] = v[i] + off;
    }
    __syncthreads();
    {
        const int t = tid >> 3, ks = tid & 7, k0 = ks * 8; const bf16_t* pr = proj + (rowb + T0 + t) * LDP;
        float qv[8], kv[8]; ld8(pr + P_GQ + h * 64 + k0, qv); ld8(pr + P_GK + h * 64 + k0, kv);
        float qp[8], kp[8], kpp[8];
#pragma unroll
        for (int i = 0; i < 8; ++i) { const float bb = LA[t * 65 + k0 + i], bl = LA[63 * 65 + k0 + i]; qp[i] = qv[i] * 0.125f * __expf(bb); kp[i] = kv[i] * __expf(-bb); kpp[i] = kv[i] * __expf(bl - bb);
            if (t == 63) gdec[(size_t)unit * 64 + k0 + i] = __expf(bl); }
        u32x4 w; w.x = pk2(qp[0], qp[1]); w.y = pk2(qp[2], qp[3]); w.z = pk2(qp[4], qp[5]); w.w = pk2(qp[6], qp[7]);
        *(LAS u32x4*)(lds + G_QP + ks * 1024 + t * 16) = w; *(u32x4*)(gqp + (rowb + T0 + t) * 256 + h * 64 + k0) = w;
        w.x = pk2(kp[0], kp[1]); w.y = pk2(kp[2], kp[3]); w.z = pk2(kp[4], kp[5]); w.w = pk2(kp[6], kp[7]);
        *(LAS u32x4*)(lds + G_KP + ks * 1024 + t * 16) = w;
        w.x = pk2(kpp[0], kpp[1]); w.y = pk2(kpp[2], kpp[3]); w.z = pk2(kpp[4], kpp[5]); w.w = pk2(kpp[6], kpp[7]);
        *(LAS u32x4*)(lds + G_KPP + (ks >> 2) * 4096 + t * 64 + (ks & 3) * 16) = w;
        const int vs = tid & 7; const u32x4 v0 = *(const u32x4*)(pr + P_GV + h * 128 + vs * 16), v1 = *(const u32x4*)(pr + P_GV + h * 128 + vs * 16 + 8);
        const int vbk = vs >> 1; LAS unsigned char* vp = lds + G_V + (vbk >> 1) * 8192 + (vbk & 1) * 4096 + t * 64 + (vs & 1) * 32;
        *(LAS u32x4*)vp = v0; *(LAS u32x4*)(vp + 16) = v1;
    }
    __syncthreads();
    {
        const int tb = wid & 1, vb = wid >> 1;
        bf16x8 qf[4];
#pragma unroll
        for (int d0 = 0; d0 < 4; ++d0) qf[d0] = *(const LAS bf16x8*)(lds + G_QP + (2 * d0 + hi) * 1024 + (32 * tb + r32) * 16);
        f32x16 o;
#pragma unroll
        for (int r = 0; r < 16; ++r) o[r] = 0.f;
        for (int sb = 0; sb <= tb; ++sb) {
            f32x16 s;
#pragma unroll
            for (int r = 0; r < 16; ++r) s[r] = 0.f;
#pragma unroll
            for (int d0 = 0; d0 < 4; ++d0) { const bf16x8 kf = *(const LAS bf16x8*)(lds + G_KP + (2 * d0 + hi) * 1024 + (32 * sb + r32) * 16); s = __builtin_amdgcn_mfma_f32_32x32x16_bf16(kf, qf[d0], s, 0, 0, 0); }
            if (sb == tb) {
#pragma unroll
                for (int r = 0; r < 16; ++r) if (crow(r, hi) > r32) s[r] = 0.f; }
            u32x4 w; bf16x8 pa0, pa1;
            w.x = cvtpk(s[0], s[1]); w.y = cvtpk(s[2], s[3]); w.z = cvtpk(s[4], s[5]); w.w = cvtpk(s[6], s[7]); pa0 = __builtin_bit_cast(bf16x8, w);
            w.x = cvtpk(s[8], s[9]); w.y = cvtpk(s[10], s[11]); w.z = cvtpk(s[12], s[13]); w.w = cvtpk(s[14], s[15]); pa1 = __builtin_bit_cast(bf16x8, w);
            const LAS unsigned char* vimg = lds + G_V + (vb >> 1) * 8192;
            o = __builtin_amdgcn_mfma_f32_32x32x16_bf16(pa0, vfrag(vimg, vb & 1, 2 * sb, lane), o, 0, 0, 0);
            o = __builtin_amdgcn_mfma_f32_32x32x16_bf16(pa1, vfrag(vimg, vb & 1, 2 * sb + 1, lane), o, 0, 0, 0);
        }
        float* op = goi + (rowb + T0 + 32 * tb) * 512 + h * 128 + vb * 32 + r32;
#pragma unroll
        for (int r = 0; r < 16; ++r) op[(size_t)crow(r, hi) * 512] = o[r];
        const int kb = wid & 1; f32x16 d;
#pragma unroll
        for (int r = 0; r < 16; ++r) d[r] = 0.f;
        const LAS unsigned char* vimg = lds + G_V + (vb >> 1) * 8192;
#pragma unroll
        for (int ks = 0; ks < 4; ++ks) d = __builtin_amdgcn_mfma_f32_32x32x16_bf16(vfrag(vimg, vb & 1, ks, lane), vfrag(lds + G_KPP, kb, ks, lane), d, 0, 0, 0);
        float* dp = gds + (size_t)unit * 8192 + (size_t)(32 * vb) * 64 + 32 * kb + r32;
#pragma unroll
        for (int r = 0; r < 16; ++r) dp[crow(r, hi) * 64] = d[r];
    }
    __syncthreads();
}

__device__ __forceinline__ void scan_unit(const Ctx& C, int b, int h, int e, const float* gdec, const float* gds, bf16_t* sall) {
    const int tid = C.tid; const int v = 16 * e + (tid >> 5), k2 = (tid & 31) * 2; const int bh = b * 4 + h;
    f32x2 ds[32], dc[32];
#pragma unroll
    for (int c = 0; c < 32; ++c) { const size_t unit = (size_t)bh * 32 + c; ds[c] = *(const f32x2*)(gds + unit * 8192 + v * 64 + k2); dc[c] = *(const f32x2*)(gdec + unit * 64 + k2); }
    float s0 = 0.f, s1 = 0.f;
#pragma unroll
    for (int c = 0; c < 32; ++c) { const size_t unit = (size_t)bh * 32 + c; *(unsigned*)(sall + (unit * 128 + v) * 64 + k2) = pk2(s0, s1); s0 = dc[c].x * s0 + ds[c].x; s1 = dc[c].y * s1 + ds[c].y; }
}
__device__ __forceinline__ void out_unit(const Ctx& C, const Args& a, int l, int b, int h, int cg, const bf16_t* proj, const bf16_t* gqp, const bf16_t* sall, const float* goi, bf16_t* ys) {
    const int lane = C.lane, wid = C.wave, r32 = lane & 31, hi = lane >> 5;
    const int c = 4 * cg + (wid >> 1), tb = wid & 1; const size_t unit = (size_t)(b * 4 + h) * 32 + c; const size_t tok = (size_t)b * SEQ + 64 * c + 32 * tb + r32;
    bf16x8 qf[4];
#pragma unroll
    for (int s = 0; s < 4; ++s) qf[s] = *(const bf16x8*)(gqp + tok * 256 + h * 64 + 16 * s + 8 * hi);
    f32x16 acc[4];
#pragma unroll
    for (int vb = 0; vb < 4; ++vb) {
#pragma unroll
        for (int g4 = 0; g4 < 4; ++g4) { const f32x4 o4 = *(const f32x4*)(goi + tok * 512 + h * 128 + 32 * vb + 8 * g4 + 4 * hi);
#pragma unroll
            for (int j = 0; j < 4; ++j) acc[vb][4 * g4 + j] = o4[j]; }
#pragma unroll
        for (int s = 0; s < 4; ++s) { const bf16x8 af = *(const bf16x8*)(sall + (unit * 128 + 32 * vb + r32) * 64 + 16 * s + 8 * hi); acc[vb] = __builtin_amdgcn_mfma_f32_32x32x16_bf16(af, qf[s], acc[vb], 0, 0, 0); }
    }
    float ssq = 0.f;
#pragma unroll
    for (int vb = 0; vb < 4; ++vb)
#pragma unroll
        for (int r = 0; r < 16; ++r) ssq += acc[vb][r] * acc[vb][r];
    ssq += att::swap_half(ssq);
    const float rstd = rsqrtf(ssq * (1.0f / 128.0f) + EPS);
#pragma unroll
    for (int vb = 0; vb < 4; ++vb) { bf16_t* yo = ys + ((size_t)2 * M + tok) * 512 + h * 128 + 32 * vb + 4 * hi;
#pragma unroll
        for (int g4 = 0; g4 < 4; ++g4) { const u32x2 gt = *(const u32x2*)(proj + tok * LDP + P_GG + h * 128 + 32 * vb + 8 * g4 + 4 * hi); const f32x4 ng = *(const f32x4*)(a.gla_norm + l * 128 + 32 * vb + 8 * g4 + 4 * hi);
            const float g0 = bflo(gt.x), g1 = bfhi(gt.x), g2 = bflo(gt.y), g3 = bfhi(gt.y);
            u32x2 w; w.x = cvtpk(acc[vb][4 * g4] * rstd * ng[0] * g0 * sigmoidf_(g0), acc[vb][4 * g4 + 1] * rstd * ng[1] * g1 * sigmoidf_(g1));
            w.y = cvtpk(acc[vb][4 * g4 + 2] * rstd * ng[2] * g2 * sigmoidf_(g2), acc[vb][4 * g4 + 3] * rstd * ng[3] * g3 * sigmoidf_(g3));
            *(u32x2*)(yo + 8 * g4) = w; } }
}
}
namespace nsa {
using namespace att;
constexpr int N_GT = 67584, N_SELW = 70656, N_LIST = 70656 + 256, N_IMPS = 71168, N_IMPM = 79616, N_OST = N_IMPM;
__device__ __forceinline__ void nsa_unit(const Ctx& C, int b, int g, int qt, const bf16_t* proj, const bf16_t* kcvc, bf16_t* ys) {
    LAS unsigned char* lds = C.lds; const int tid = C.tid, lane = C.lane, wid = C.wave, r32 = lane & 31, hi = lane >> 5;
    const int hp = wid & 3, qs = wid >> 2, h = 4 * g + hp; const size_t rowb = (size_t)b * SEQ; const int T0 = 64 * qt, jd = qt;
    const int qidx = 32 * qs + r32, qtok = T0 + qidx;
    LAS float* wsf = (LAS float*)(lds + L_WSF) + wid * 64; LAS float* GT = (LAS float*)(lds + N_GT) + wid * 96;
    LAS unsigned* SELW = (LAS unsigned*)(lds + N_SELW); LAS unsigned* LIST = (LAS unsigned*)(lds + N_LIST);
    LAS float* IMPS = (LAS float*)(lds + N_IMPS); LAS float* IMPM = (LAS float*)(lds + N_IMPM) + wid * 1056;
    const bf16_t* kc = kcvc + (((size_t)0 * NB + b) * 128 * 2 + g) * 64; const bf16_t* vc = kcvc + (((size_t)1 * NB + b) * 128 * 2 + g) * 64;
    const int ncmax = (T0 + 63 >= 31) ? ((T0 + 63 - 31) / 16 + 1) : 0;
    const int nct = (ncmax + 63) >> 6;
    if (nct > 0) dma_kv(lds + L_RING, kc, vc, 128, wid, lane);
    if (nct > 1) dma_kv(lds + L_RING + SLOT, kc + 64 * 128, vc + 64 * 128, 128, wid, lane);
    const bf16_t* prow = proj + (rowb + qtok) * LDP;
    bf16x8 qr[4]; load_q(qr, prow + P_NQ + h * 64, hi);
    if (hi == 0) {
#pragma unroll
        for (int i = 0; i < 3; ++i) GT[i * 32 + r32] = sigmoidf_(bf2f(prow[P_NG + h * 3 + i])); }
    asm volatile("s_waitcnt vmcnt(0)" ::: "memory");
    __syncthreads();
    f32x16 yacc[2];
#pragma unroll
    for (int r = 0; r < 16; ++r) { yacc[0][r] = 0.f; yacc[1][r] = 0.f; }
    {
        const int ncv = (qtok >= 31) ? ((qtok - 31) / 16 + 1) : 0;
        f32x16 p[4];
#pragma unroll
        for (int i = 0; i < 4; ++i)
#pragma unroll
            for (int r = 0; r < 16; ++r) p[i][r] = -__builtin_inff();
        if (nct > 0) qkt<4>(p[0], p[1], lds + L_RING, qr, r32, hi);
        if (nct > 1) qkt<4>(p[2], p[3], lds + L_RING + SLOT, qr, r32, hi);
#pragma unroll
        for (int i = 0; i < 4; ++i)
#pragma unroll
            for (int r = 0; r < 16; ++r) if (32 * i + crow(r, hi) >= ncv) p[i][r] = -__builtin_inff();
        float mx = fmaxf(rowmax32(p[0], p[1]), rowmax32(p[2], p[3]));
        const float msafe = (mx == -__builtin_inff()) ? 0.f : mx; const float nm = -msafe * CS; float s = 0.f;
#pragma unroll
        for (int i = 0; i < 4; ++i)
#pragma unroll
            for (int r = 0; r < 16; ++r) { p[i][r] = __builtin_amdgcn_exp2f(__builtin_fmaf(p[i][r], CS, nm)); s += p[i][r]; }
        s += swap_half(s);
        const float il = (s > 0.f) ? 1.0f / s : 0.f;
#pragma unroll
        for (int i = 0; i < 4; ++i)
#pragma unroll
            for (int r = 0; r < 16; ++r) p[i][r] *= il;
        float prevc = 0.f;
#pragma unroll
        for (int i = 0; i < 4; ++i)
#pragma unroll
            for (int g4 = 0; g4 < 4; ++g4) { const int j = 8 * i + 2 * g4 + hi; const float c3 = 0.5f * p[i][4 * g4 + 3]; const float pc = swap_half(c3);
                IMPM[r32 * 33 + j] = p[i][4 * g4] + p[i][4 * g4 + 1] + p[i][4 * g4 + 2] + c3 + (hi ? pc : prevc); prevc = pc; }
        f32x16 oc[2];
#pragma unroll
        for (int r = 0; r < 16; ++r) { oc[0][r] = 0.f; oc[1][r] = 0.f; }
        bf16x8 pa[4];
        if (nct > 0) { pack_p(p[0], p[1], pa); pv(oc, lds + L_RING + 8192, pa, lane); }
        if (nct > 1) { pack_p(p[2], p[3], pa); pv(oc, lds + L_RING + SLOT + 8192, pa, lane); }
#pragma unroll
        for (int g4 = 0; g4 < 4; ++g4) { const f32x4 gv = *(const LAS f32x4*)(GT + 0 * 32 + 8 * g4 + 4 * hi);
#pragma unroll
            for (int j = 0; j < 4; ++j) { yacc[0][4 * g4 + j] = oc[0][4 * g4 + j] * gv[j]; yacc[1][4 * g4 + j] = oc[1][4 * g4 + j] * gv[j]; } }
    }
    __syncthreads();
    {
        const int q = tid >> 3, part = tid & 7, qsq = q >> 5, rq = q & 31, t = T0 + q;
#pragma unroll
        for (int jj = 0; jj < 4; ++jj) { const int j = 4 * part + jj; float v = 0.f;
#pragma unroll
            for (int hh = 0; hh < 4; ++hh) { const LAS float* pm = (const LAS float*)(lds + N_IMPM) + (qsq * 4 + hh) * 1056 + rq * 33; v += pm[j]; }
            if (j == 0 || j == (t >> 6)) v = __builtin_inff(); else if (64 * j > t) v = -__builtin_inff();
            IMPS[q * 33 + j] = v; }
        __syncthreads();
        unsigned bits = 0u;
#pragma unroll
        for (int jj = 0; jj < 4; ++jj) { const int j = 4 * part + jj; const float vj = IMPS[q * 33 + j]; int rank = 0;
#pragma unroll 8
            for (int j2 = 0; j2 < 32; ++j2) { const float v2 = IMPS[q * 33 + j2]; rank += (v2 > vj || (v2 == vj && j2 < j)) ? 1 : 0; }
            if (rank < 8) bits |= 1u << j; }
        bits |= __shfl_xor(bits, 1); bits |= __shfl_xor(bits, 2); bits |= __shfl_xor(bits, 4);
        if (part == 0) SELW[q] = bits;
        __syncthreads();
        if (wid == 0) {
            unsigned un = SELW[lane];
#pragma unroll
            for (int o = 1; o < 64; o <<= 1) un |= __shfl_xor(un, o);
            if (lane == 0) { int n = 0; for (int j = 0; j <= jd; ++j) if ((un >> j) & 1u) LIST[1 + n++] = (unsigned)j;
                for (int j = (jd - 4 > 0 ? jd - 4 : 0); j <= jd; ++j) LIST[1 + n++] = 0x100u | (unsigned)j;
                LIST[0] = (unsigned)n; }
        }
        __syncthreads();
    }
    {
        const int n = (int)LIST[0]; const unsigned selq = SELW[qidx];
        const bf16_t* ksb = proj + rowb * LDP + P_KS + g * 64; const bf16_t* vsb = proj + rowb * LDP + P_VS + g * 64;
        const bf16_t* kwb = proj + rowb * LDP + P_KW + g * 64; const bf16_t* vwb = proj + rowb * LDP + P_VW + g * 64;
        f32x16 o[2];
#pragma unroll
        for (int r = 0; r < 16; ++r) { o[0][r] = 0.f; o[1][r] = 0.f; }
        float m = -1e30f, l = 0.f; int mode = 0;
        { const unsigned e0 = LIST[1]; const int j0 = e0 & 0xff; const bool w0 = (e0 >> 8) != 0; dma_kv(lds + L_RING, (w0 ? kwb : ksb) + (size_t)j0 * 64 * LDP, (w0 ? vwb : vsb) + (size_t)j0 * 64 * LDP, LDP, wid, lane); }
        asm volatile("s_waitcnt vmcnt(0)" ::: "memory");
        __syncthreads();
        for (int i = 0; i < n; ++i) {
            const unsigned e = LIST[1 + i]; const int j = e & 0xff; const int md = e >> 8;
            LAS unsigned char* slot = lds + L_RING + (i & 1) * SLOT;
            if (i + 1 < n) { const unsigned e1 = LIST[2 + i]; const int j1 = e1 & 0xff; const bool w1 = (e1 >> 8) != 0;
                dma_kv(lds + L_RING + ((i + 1) & 1) * SLOT, (w1 ? kwb : ksb) + (size_t)j1 * 64 * LDP, (w1 ? vwb : vsb) + (size_t)j1 * 64 * LDP, LDP, wid, lane); }
            if (md != mode) {
                l += swap_half(l);
                const float f = GT[1 * 32 + r32] / l;
                scale_rows(o, f, wsf, r32, hi);
#pragma unroll
                for (int r = 0; r < 16; ++r) { yacc[0][r] += o[0][r]; yacc[1][r] += o[1][r]; o[0][r] = 0.f; o[1][r] = 0.f; }
                m = -1e30f; l = 0.f; mode = md;
            }
            const bool allowed = (md != 0) || (((selq >> j) & 1u) != 0u);
            if (__any(allowed)) {
                f32x16 p0, p1; qkt<4>(p0, p1, slot, qr, r32, hi);
                const bool diag = (j == jd), first = (md != 0) && (j == jd - 4);
#pragma unroll
                for (int r = 0; r < 16; ++r) { const int k0 = crow(r, hi), k1 = k0 + 32;
                    bool v0 = allowed, v1 = allowed;
                    if (diag) { v0 = v0 && (k0 <= qidx); v1 = v1 && (k1 <= qidx); }
                    if (first) { v0 = v0 && (k0 > qidx); v1 = v1 && (k1 > qidx); }
                    if (!v0) p0[r] = -__builtin_inff(); if (!v1) p1[r] = -__builtin_inff(); }
                softmax_tile<true>(p0, p1, m, l, o, wsf, r32, hi);
                bf16x8 pa[4]; pack_p(p0, p1, pa);
                pv(o, slot + 8192, pa, lane);
            }
            asm volatile("s_waitcnt vmcnt(0)" ::: "memory");
            __syncthreads();
        }
        l += swap_half(l);
        const float f = GT[2 * 32 + r32] / l;
        scale_rows(o, f, wsf, r32, hi);
#pragma unroll
        for (int r = 0; r < 16; ++r) { yacc[0][r] += o[0][r]; yacc[1][r] += o[1][r]; }
    }
    store_o(yacc, lds + N_OST + wid * 4096, ys + ((size_t)0 * M + rowb + T0 + 32 * qs) * 512 + h * 64, 512, lane);
    __syncthreads();
}
}
namespace cmpx {
using att::f32x16; using att::crow;
constexpr int C_HID = 0;
__device__ __forceinline__ void cmp_unit(const Ctx& C, const Args& a, int kv, int b, int g, int chalf, const bf16_t* proj, const bf16_t* w1t, const bf16_t* w2t, const float* bias1, bf16_t* kcvc) {
    LAS unsigned char* lds = C.lds; const int lane = C.lane, wid = C.wave, r32 = lane & 31, hi = lane >> 5;
    const size_t rowb = (size_t)b * SEQ;
    {
        const int mb = wid & 1, nb = wid >> 1; const int c = 64 * chalf + 32 * mb + r32, cl = c < 126 ? c : 126;
        const bf16_t* ap = proj + (rowb + 16 * cl) * LDP + (kv ? P_VC : P_KC) + g * 64 + 8 * hi;
        const bf16_t* b0p = w1t + (size_t)kv * 256 * 2048 + (size_t)(64 * nb + r32) * 2048 + 8 * hi; const bf16_t* b1p = b0p + 32 * 2048;
        f32x16 acc0, acc1;
#pragma unroll
        for (int r = 0; r < 16; ++r) { acc0[r] = 0.f; acc1[r] = 0.f; }
        bf16x8 af[4], bf0[4], bf1[4];
#pragma unroll
        for (int j = 0; j < 4; ++j) { af[j] = *(const bf16x8*)(ap + 16 * j); bf0[j] = *(const bf16x8*)(b0p + 16 * j); bf1[j] = *(const bf16x8*)(b1p + 16 * j); }
        for (int ll = 0; ll < 32; ++ll) {
            bf16x8 an[4], bn0[4], bn1[4]; const int ln = ll < 31 ? ll + 1 : 31;
#pragma unroll
            for (int j = 0; j < 4; ++j) { an[j] = *(const bf16x8*)(ap + (size_t)ln * LDP + 16 * j); bn0[j] = *(const bf16x8*)(b0p + 64 * ln + 16 * j); bn1[j] = *(const bf16x8*)(b1p + 64 * ln + 16 * j); }
#pragma unroll
            for (int j = 0; j < 4; ++j) { acc0 = __builtin_amdgcn_mfma_f32_32x32x16_bf16(af[j], bf0[j], acc0, 0, 0, 0); acc1 = __builtin_amdgcn_mfma_f32_32x32x16_bf16(af[j], bf1[j], acc1, 0, 0, 0); }
#pragma unroll
            for (int j = 0; j < 4; ++j) { af[j] = an[j]; bf0[j] = bn0[j]; bf1[j] = bn1[j]; }
        }
        const float bs0 = bias1[kv * 256 + 64 * nb + r32], bs1 = bias1[kv * 256 + 64 * nb + 32 + r32];
        LAS bf16_t* hid = (LAS bf16_t*)(lds + C_HID);
#pragma unroll
        for (int r = 0; r < 16; ++r) { const int row = 32 * mb + crow(r, hi);
            hid[row * 264 + 64 * nb + r32] = (bf16_t)f2bf(gelu_tanh(acc0[r] + bs0)); hid[row * 264 + 64 * nb + 32 + r32] = (bf16_t)f2bf(gelu_tanh(acc1[r] + bs1)); }
    }
    __syncthreads();
    if (wid < 4) {
        const int mb = wid & 1, db = wid >> 1;
        f32x16 acc;
#pragma unroll
        for (int r = 0; r < 16; ++r) acc[r] = 0.f;
        const bf16_t* bp = w2t + (size_t)kv * 64 * 256 + (size_t)(32 * db + r32) * 256 + 8 * hi;
#pragma unroll
        for (int s = 0; s < 16; ++s) { const bf16x8 af = *(const LAS bf16x8*)(lds + C_HID + (32 * mb + r32) * 528 + 32 * s + 16 * hi); const bf16x8 bfr = *(const bf16x8*)(bp + 16 * s);
            acc = __builtin_amdgcn_mfma_f32_32x32x16_bf16(af, bfr, acc, 0, 0, 0); }
        const bool rope = (kv == 0) && (db == 0);
        const float inv = powf(500000.0f, -(float)(2 * (r32 & 7)) / 16.0f);
#pragma unroll
        for (int r = 0; r < 16; ++r) { const int cidx = 64 * chalf + 32 * mb + crow(r, hi); float v = acc[r];
            if (rope) { const float vp = __shfl_xor(v, 8); const int cc = cidx < 126 ? cidx : 126; const float ang = (float)a.pos[b * SEQ + 16 * cc + 31] * inv; float sn, cs; sincosf(ang, &sn, &cs);
                if (r32 < 8) v = v * cs - vp * sn; else if (r32 < 16) v = v * cs + vp * sn; }
            kcvc[((((size_t)kv * NB + b) * 128 + cidx) * 2 + g) * 64 + 32 * db + r32] = (cidx < 127) ? (bf16_t)f2bf(v) : (bf16_t)0; }
    }
    __syncthreads();
}
__device__ __forceinline__ void rope_unit(const Ctx& C, const Args& a, int u, bf16_t* proj) {
    for (int i = C.tid; i < 256 * 12; i += NTHR) { const int tok = 256 * u + i / 12, j = i % 12; const int col = j < 8 ? P_NQ + j * 64 : (j < 10 ? P_KS + (j - 8) * 64 : P_KW + (j - 10) * 64);
        rope_rotate(proj + (size_t)tok * LDP + col, a.pos[tok]); }
}
}

#ifndef OPT_FOX
#define OPT_FOX 1
#endif
#ifndef OPT_SB
#define OPT_SB 1
#endif
#ifndef OPT_GLA
#define OPT_GLA 1
#endif
#ifndef OPT_NSA
#define OPT_NSA 1
#endif
#ifndef OPT_PREP
#define OPT_PREP 1
#endif
#ifndef FOX_ABL
#define FOX_ABL 0
#endif
constexpr int CW_Q = 8192;
#define QLOOP(cntptr, total, ...) do { LAS unsigned* qs_ = (LAS unsigned*)(lds + MISC_OFF + 64); unsigned nxt_ = 0u; \
    if (C.tid == 0) nxt_ = atomicAdd((cntptr), 1u); \
    for (;;) { if (C.tid == 0) *qs_ = nxt_; __syncthreads(); const unsigned u = *qs_; if (u >= (unsigned)(total)) break; \
        if (C.tid == 0) nxt_ = atomicAdd((cntptr), 1u); { __VA_ARGS__; } __syncthreads(); } __syncthreads(); } while (0)

template <bool ROPE, int SUB>
__device__ __forceinline__ void phase_C(LAS unsigned char* lds, int wave_s, const Args& a, int l, unsigned* ctl, bf16_t* proj, bf16_t* ys, bf16_t* gqp, float* gdec, float* gds, float* goi) {
    unsigned* qc = ctl + CW_Q + (l * 16) * 64;
    if (SUB & 1)
    { const Ctx C = make_ctx(lds, wave_s); const bf16_t* w1t = (const bf16_t*)(a.ws + WS_CW1); const bf16_t* w2t = (const bf16_t*)(a.ws + WS_KC + 512 * 1024); const float* bias1 = (const float*)(a.ws + WS_KC + 576 * 1024); bf16_t* kcvc = (bf16_t*)(a.ws + WS_KC);
      QLOOP(qc + 0 * 64, 64, { const int chalf = u & 1, g = (u >> 1) & 1, b = (u >> 2) & 7, kv = (int)(u >> 5); cmpx::cmp_unit(C, a, kv, b, g, chalf, proj, w1t, w2t, bias1, kcvc); }); }
    if (SUB & 2)
    { const Ctx C = make_ctx(lds, wave_s); QLOOP(qc + 1 * 64, 64, { att::foxprep_unit(C, (int)(u >> 3), (int)(u & 7), proj, a.fox_b_f[l * 8 + (u & 7)], (float*)(a.ws + WS_CUM), (float*)(a.ws + WS_CUM + 524288)); }); }
    if (SUB & 4)
    { const Ctx C = make_ctx(lds, wave_s); QLOOP(qc + 2 * 64, 1024, { const int c = u & 31, bh = u >> 5; gla::prep_unit(C, a, l, bh >> 2, bh & 3, c, proj, gqp, gdec, gds, goi); }); }
    if (SUB & 8)
    { const Ctx C = make_ctx(lds, wave_s); QLOOP(qc + 3 * 64, 512, { const int qb = 7 - (int)(u >> 6), bh = u & 63; att::sb_unit(C, bh >> 3, bh & 7, qb, proj, ys); }); }
    if (ROPE) { const Ctx C = make_ctx(lds, wave_s); QLOOP(qc + 4 * 64, 64, { cmpx::rope_unit(C, a, (int)u, proj); }); }
}
template <int SUB>
__device__ __forceinline__ void phase_D(LAS unsigned char* lds, int wave_s, const Args& a, int l, unsigned* ctl, bf16_t* proj, bf16_t* ys, const bf16_t* kcvc, bf16_t* gqp, float* gdec, float* gds, float* goi) {
    unsigned* qc = ctl + CW_Q + (l * 16 + 8) * 64;
    if (SUB & 16)
    { const Ctx C = make_ctx(lds, wave_s); QLOOP(qc + 0 * 64, 256, { gla::scan_unit(C, (int)(u >> 5), (int)((u >> 3) & 3), (int)(u & 7), gdec, gds, (bf16_t*)(a.ws + WS_HB)); }); }
    if (SUB & 32)
    { const Ctx C = make_ctx(lds, wave_s); QLOOP(qc + 1 * 64, 512, { const int qt = 31 - (int)(u >> 4), bg = u & 15; nsa::nsa_unit(C, bg >> 1, bg & 1, qt, proj, kcvc, ys); }); }
    if (SUB & 64)
    { const Ctx C = make_ctx(lds, wave_s); QLOOP(qc + 2 * 64, 512, { const int qb = 7 - (int)(u >> 6), bh = u & 63; att::fox_unit<0>(C, bh >> 3, bh & 7, qb, proj, (const float*)(a.ws + WS_CUM), (const float*)(a.ws + WS_CUM + 524288), ys); }); }
}
__device__ __forceinline__ void phase_E(LAS unsigned char* lds, int wave_s, const Args& a, int l, bf16_t* proj, bf16_t* ys, const bf16_t* gqp, const float* goi) {
    const Ctx C = make_ctx(lds, wave_s);
    for (int u = C.bid; u < 256; u += C.G) gla::out_unit(C, a, l, u >> 5, (u >> 3) & 3, u & 7, proj, gqp, (const bf16_t*)(a.ws + WS_HB), goi, ys);
}

__device__ __forceinline__ const Args* args_reload() {
#if defined(__HIP_DEVICE_COMPILE__)
    auto p_ = __builtin_amdgcn_kernarg_segment_ptr(); asm volatile("" : "+s"(p_)); return (const Args*)p_;
#else
    return nullptr;
#endif
}
#define ARGS_RELOAD() args_reload()
__global__ void __launch_bounds__(NTHR, 2) hybrid_fwd(Args a0) {
    extern __shared__ __attribute__((aligned(16))) unsigned char lds_raw[];
    LAS unsigned char* lds = (LAS unsigned char*)lds_raw;
    volatile LAS unsigned* MISC = (volatile LAS unsigned*)(lds + MISC_OFF);
    const int wave_s = __builtin_amdgcn_readfirstlane((int)threadIdx.x >> 6);
    if (threadIdx.x < 64) MISC[threadIdx.x] = 0u;
    __syncthreads();
#if MK_ONE_LAUNCH
    XcdBarrier bar = xcd_barrier_post((unsigned*)(a0.ws + WS_CTL) + CW_BAR, MISC + 8);
#define GRID_BAR() xcd_barrier(bar, wave_s == 0 && lane_id() == 0)
#else
#define GRID_BAR() do {} while (0)
#endif
#ifndef PH_MASK
#define PH_MASK 0xFFFF
#endif
    const int l_lo = a0.l_lo, l_hi = a0.l_hi, p_lo = a0.p_lo, p_hi = a0.p_hi, do_final = a0.do_final;
#define IN(k) (((PH_MASK >> (k)) & 1) && p_lo <= (k) && (k) < p_hi)
#define WSP(T, off) ((T*)(a.ws + (off)))
#ifndef REP_MASK
#define REP_MASK 0
#endif
#define REP(k) ((REP_MASK >> (k)) & 1)
#define PH0() do { const Args a = *ARGS_RELOAD(); unsigned char* ws = a.ws; const Ctx C = make_ctx(lds, wave_s); int base = 0; \
            transpose_matrix<true>(C, a.w_in + (size_t)l * DM * DIN, DM, DIN, LDP, WSP(bf16_t, WS_WIN), base); \
            for (int z = 0; z < 4; ++z) transpose_matrix<false>(C, a.w_branch + ((size_t)l * 4 + z) * 512 * DM, 512, DM, DM, WSP(bf16_t, WS_WB) + (size_t)z * DM * 512, base); \
            transpose_matrix<false>(C, a.w_out + (size_t)l * DM * DM, DM, DM, DM, WSP(bf16_t, WS_WO), base); \
            transpose_matrix<false>(C, a.w_ff1 + (size_t)l * DM * DFF, DM, DFF, DFF, WSP(bf16_t, WS_WF1), base); \
            transpose_matrix<false>(C, a.w_ff2 + (size_t)l * DFF * DM, DFF, DM, DM, WSP(bf16_t, WS_WF2), base); \
            transpose_matrix<false>(C, a.cmp_wk1 + (size_t)l * 2048 * 256, 2048, 256, 256, (bf16_t*)(ws + WS_CW1), base); \
            transpose_matrix<false>(C, a.cmp_wv1 + (size_t)l * 2048 * 256, 2048, 256, 256, (bf16_t*)(ws + WS_CW1) + 256 * 2048, base); \
            transpose_matrix<false>(C, a.cmp_wk2 + (size_t)l * 256 * 64, 256, 64, 64, (bf16_t*)(ws + WS_KC + 512 * 1024), base); \
            transpose_matrix<false>(C, a.cmp_wv2 + (size_t)l * 256 * 64, 256, 64, 64, (bf16_t*)(ws + WS_KC + 512 * 1024) + 64 * 256, base); \
            for (int o = C.gw; o < 512; o += C.NGW) { const int kv = o >> 8, n = o & 255; const float* w1 = (kv ? a.cmp_wv1 : a.cmp_wk1) + (size_t)l * 2048 * 256; const float* pe = (kv ? a.cmp_pos_v : a.cmp_pos_k) + (size_t)l * 2048; \
                float s = 0.f; for (int k = C.lane; k < 2048; k += 64) s += pe[k] * w1[(size_t)k * 256 + n]; s = wave_sum(s); if (C.lane == 0) ((float*)(ws + WS_KC + 576 * 1024))[o] = s; } \
            if (l == 0) xg_rows_phase(C, a.x, a.norm_mix, WSP(bf16_t, WS_HB), WSP(float, WS_CH + 2 * MiB)); \
            else for (int m = C.bid * NTHR + C.tid; m < M; m += C.G * NTHR) { const f32x4* p = (const f32x4*)(WSP(float, WS_CH) + (size_t)m * 16); float t = 0.f; \
                     _Pragma("unroll") for (int q = 0; q < 4; ++q) { const f32x4 v = p[q]; t += (v[0] + v[1]) + (v[2] + v[3]); } WSP(float, WS_CH + 2 * MiB)[m] = rsqrtf(t * (1.0f / DM) + EPS); } \
            GRID_BAR(); } while (0)
#define PH1() do { const Args a = *ARGS_RELOAD(); \
            pg8::Gemm g{WSP(bf16_t, WS_HB), WSP(bf16_t, WS_WIN), DM, DM, DM, 0, 0}; pg8::StaticOrder S; S.init(M, LDP, gridDim.x, blockIdx.x); \
            pg8::EpiBf16<0> E{WSP(bf16_t, WS_PROJ), LDP, WSP(float, WS_CH + 2 * MiB)}; pg8::gemm_phase(lds, g, S, E, wave_s); GRID_BAR(); } while (0)
#ifndef REP_SUB
#define REP_SUB 0xF
#endif
#ifndef FOX_ABL
#define FOX_ABL 0
#endif
#define PH1N() do { const Args a = *ARGS_RELOAD(); \
            pg8::Gemm g{WSP(bf16_t, WS_HB), WSP(bf16_t, WS_WIN), DM, DM, DM, 0, 0}; pg8::StaticOrder S; S.init(M, LDP, gridDim.x, blockIdx.x); \
            pg8::EpiNull E{}; pg8::gemm_phase(lds, g, S, E, wave_s); GRID_BAR(); } while (0)
#define PH2(QOFF, ROPE) do { const Args a = *ARGS_RELOAD(); phase_C<ROPE, (ROPE) ? 0xF : (REP_SUB)>(lds, wave_s, a, l, WSP(unsigned, WS_CTL) + (QOFF), WSP(bf16_t, WS_PROJ), WSP(bf16_t, WS_YS), WSP(bf16_t, WS_GQP), WSP(float, WS_GKP), WSP(float, WS_GDS), WSP(float, WS_GOI)); GRID_BAR(); } while (0)
#define PH3(QOFF) do { const Args a = *ARGS_RELOAD(); phase_D<((QOFF) != 0) ? (REP_SUB) : 0x70>(lds, wave_s, a, l, WSP(unsigned, WS_CTL) + (QOFF), WSP(bf16_t, WS_PROJ), WSP(bf16_t, WS_YS), WSP(bf16_t, WS_KC), WSP(bf16_t, WS_GQP), WSP(float, WS_GKP), WSP(float, WS_GDS), WSP(float, WS_GOI)); GRID_BAR(); } while (0)
#define PH4() do { const Args a = *ARGS_RELOAD(); phase_E(lds, wave_s, a, l, WSP(bf16_t, WS_PROJ), WSP(bf16_t, WS_YS), WSP(bf16_t, WS_GQP), WSP(float, WS_GOI)); GRID_BAR(); } while (0)
#define PH5() do { const Args a = *ARGS_RELOAD(); \
            pg8::Gemm g{WSP(bf16_t, WS_YS), WSP(bf16_t, WS_WB), 512, 512, 512, (size_t)M * 512, (size_t)DM * 512}; pg8::ZOrder S; S.init(M, 2 * DM, gridDim.x, blockIdx.x); S.NZ = 4; \
            pg8::EpiGate E{WSP(bf16_t, WS_PROJ), a.b_gate + (size_t)l * 4 * DM, WSP(bf16_t, WS_MIX)}; pg8::gemm_phase(lds, g, S, E, wave_s); GRID_BAR(); } while (0)
#define PH6(DUMMY) do { const Args a = *ARGS_RELOAD(); \
            pg8::Gemm g{WSP(bf16_t, WS_MIX), WSP(bf16_t, WS_WO), DM, DM, DM, 0, 0}; pg8::StaticOrder S; S.init(M, DM, gridDim.x, blockIdx.x); \
            pg8::EpiRes E{(l == 0) ? a.x : a.out, (DUMMY) ? WSP(float, WS_MIXF) : a.out, DM, a.norm_ff + l * DM, WSP(bf16_t, WS_HB), WSP(float, WS_CH + 1 * MiB)}; pg8::gemm_phase(lds, g, S, E, wave_s); GRID_BAR(); } while (0)
#define PH8() do { const Args a = *ARGS_RELOAD(); \
            pg8::Gemm g{WSP(bf16_t, WS_HB), WSP(bf16_t, WS_WF1), DM, DM, DM, 0, 0}; pg8::StaticOrder S; S.init(M, DFF, gridDim.x, blockIdx.x); \
            pg8::EpiBf16<1> E{WSP(bf16_t, WS_HID), DFF, WSP(float, WS_CH + 1 * MiB)}; pg8::gemm_phase(lds, g, S, E, wave_s); GRID_BAR(); } while (0)
#define PH9(DUMMY) do { const Args a = *ARGS_RELOAD(); \
            pg8::Gemm g{WSP(bf16_t, WS_HID), WSP(bf16_t, WS_WF2), DFF, DFF, DFF, 0, 0}; pg8::StaticOrder S; S.init(M, DM, gridDim.x, blockIdx.x); \
            pg8::EpiRes E{a.out, (DUMMY) ? WSP(float, WS_MIXF) : a.out, DM, a.norm_mix + (l + 1 < NL ? l + 1 : l) * DM, WSP(bf16_t, WS_HB), WSP(float, WS_CH)}; pg8::gemm_phase(lds, g, S, E, wave_s); GRID_BAR(); } while (0)
    for (int l = l_lo; l < l_hi; ++l) {
        if (IN(0)) { PH0(); if (REP(0)) PH0(); }
        if (IN(1)) { PH1(); if (REP(1)) PH1(); if (REP(11)) PH1N(); }
        if (IN(2)) { if (REP(2)) PH2(64 * 1024, false); PH2(0, true); }
        if (IN(3)) { if (REP(3)) PH3(64 * 1024); PH3(0); }
        if (IN(4)) { PH4(); if (REP(4)) PH4(); }
        if (IN(5)) { PH5(); if (REP(5)) PH5(); }
        if (IN(6)) { if (REP(6)) PH6(true); PH6(false); }
        if (IN(8)) { PH8(); if (REP(8)) PH8(); }
        if (IN(9)) { if (REP(9)) PH9(true); PH9(false); }
    }
    if (do_final) { const Args a = *ARGS_RELOAD(); const Ctx C = make_ctx(lds, wave_s); final_norm_phase(C, a.out, a.norm_final); }
#undef IN
#undef WSP
}

#define NAIVE_CTX() extern __shared__ __attribute__((aligned(16))) unsigned char lds_raw[]; Ctx C; C.lds = (LAS unsigned char*)lds_raw; C.tid = threadIdx.x; C.lane = C.tid & 63; \
    C.wave = __builtin_amdgcn_readfirstlane(C.tid >> 6); C.G = gridDim.x; C.bid = blockIdx.x; C.gw = C.bid * NWAVES + C.wave; C.NGW = C.G * NWAVES; unsigned char* ws = a.ws; \
    bf16_t* ys = (bf16_t*)(ws + WS_YS); bf16_t* proj = (bf16_t*)(ws + WS_PROJ); float* cum = (float*)(ws + WS_CUM); float* ch = (float*)(ws + WS_CH); bf16_t* kcvc = (bf16_t*)(ws + WS_KC); \
    float* gds = (float*)(ws + WS_GDS); float* goi = (float*)(ws + WS_GOI); (void)ys; (void)proj; (void)cum; (void)ch; (void)kcvc; (void)gds; (void)goi;
__global__ void __launch_bounds__(NTHR, 2) k_prepA(Args a) { NAIVE_CTX(); naive_prepA(C, a, a.l_lo, proj, cum, ch); }
__global__ void __launch_bounds__(NTHR, 2) k_prepB(Args a) { NAIVE_CTX(); naive_prepB(C, a, a.l_lo, ch, kcvc); }
__global__ void __launch_bounds__(NTHR, 2) k_gla(Args a) { NAIVE_CTX(); naive_gla(C, a, a.l_lo, proj, goi, ys); }
__global__ void __launch_bounds__(NTHR, 2) k_nsa(Args a) { NAIVE_CTX(); naive_nsa(C, proj, kcvc, (float*)(ws + WS_MIX), ys); }
__global__ void __launch_bounds__(NTHR, 2) k_fox(Args a) { NAIVE_CTX(); naive_fox(C, proj, cum, ys); }
__global__ void __launch_bounds__(NTHR, 2) k_sb(Args a) { NAIVE_CTX(); naive_sb(C, proj, ys); }

extern "C" void kernel_launch(void* const* d_in, const int* in_sizes, int n_in, void* d_out, int out_size, void* d_ws, size_t ws_size, hipStream_t stream) {
    static int grid = 0;
    if (grid == 0) {
        if (n_in != 21 || in_sizes[0] != M * DM || out_size != M * DM || ws_size < WS_END) { fprintf(stderr, "kernel_launch: shape/ws mismatch (n_in %d, ws %zu, need %zu)\n", n_in, ws_size, (size_t)WS_END); grid = -1; return; }
        int dev = 0, cus = 0, per_cu = 0;
        if (hipGetDevice(&dev) != hipSuccess || hipDeviceGetAttribute(&cus, hipDeviceAttributeMultiprocessorCount, dev) != hipSuccess) { grid = -1; return; }
        if (hipFuncSetAttribute((const void*)hybrid_fwd, hipFuncAttributeMaxDynamicSharedMemorySize, LDS_BYTES) != hipSuccess) { grid = -1; return; }
        if (hipOccupancyMaxActiveBlocksPerMultiprocessor(&per_cu, (const void*)hybrid_fwd, NTHR, LDS_BYTES) != hipSuccess || per_cu < 1) { fprintf(stderr, "kernel_launch: occupancy query says %d\n", per_cu); }
        (void)hipGetLastError();
        grid = cus;
    }
    if (grid < 0) return;
    (void)hipMemsetAsync((char*)d_ws + WS_CTL, 0, CTL_BYTES, stream);
    Args a{};
    a.x = (const float*)d_in[0]; a.pos = (const int*)d_in[1]; a.norm_mix = (const float*)d_in[2]; a.w_in = (const float*)d_in[3]; a.b_gate = (const float*)d_in[4];
    a.cmp_pos_k = (const float*)d_in[5]; a.cmp_pos_v = (const float*)d_in[6]; a.cmp_wk1 = (const float*)d_in[7]; a.cmp_wk2 = (const float*)d_in[8]; a.cmp_wv1 = (const float*)d_in[9]; a.cmp_wv2 = (const float*)d_in[10];
    a.gla_w_alpha = (const float*)d_in[11]; a.gla_b_alpha = (const float*)d_in[12]; a.gla_norm = (const float*)d_in[13]; a.fox_b_f = (const float*)d_in[14];
    a.w_branch = (const float*)d_in[15]; a.w_out = (const float*)d_in[16]; a.norm_ff = (const float*)d_in[17]; a.w_ff1 = (const float*)d_in[18]; a.w_ff2 = (const float*)d_in[19]; a.norm_final = (const float*)d_in[20];
    a.out = (float*)d_out; a.ws = (unsigned char*)d_ws; a.pad = 0;
#if MK_ONE_LAUNCH
    a.l_lo = 0; a.l_hi = NL; a.p_lo = 0; a.p_hi = 10; a.do_final = 1;
    hipLaunchKernelGGL(hybrid_fwd, dim3(grid), dim3(NTHR), LDS_BYTES, stream, a);
#else
    for (int l = 0; l < NL; ++l)
        for (int p = 0; p < 10; ++p) { a.l_lo = l; a.l_hi = l + 1; a.p_lo = p; a.p_hi = p + 1; a.do_final = 0;
            if (p == 2 && !OPT_PREP) { hipLaunchKernelGGL(k_prepA, dim3(grid), dim3(NTHR), 0, stream, a); hipLaunchKernelGGL(k_prepB, dim3(grid), dim3(NTHR), 0, stream, a); }
            if (p == 3) {
                if (!OPT_GLA) hipLaunchKernelGGL(k_gla, dim3(32), dim3(NTHR), 8192, stream, a);
                if (!OPT_NSA) hipLaunchKernelGGL(k_nsa, dim3(64), dim3(NTHR), 65536, stream, a);
                if (!OPT_FOX) hipLaunchKernelGGL(k_fox, dim3(grid), dim3(NTHR), 0, stream, a);
                if (!OPT_SB) hipLaunchKernelGGL(k_sb, dim3(grid), dim3(NTHR), 0, stream, a);
            }
            hipLaunchKernelGGL(hybrid_fwd, dim3(grid), dim3(NTHR), LDS_BYTES, stream, a); }
    a.l_lo = 0; a.l_hi = 0; a.p_lo = 0; a.p_hi = 0; a.do_final = 1;
    hipLaunchKernelGGL(hybrid_fwd, dim3(grid), dim3(NTHR), LDS_BYTES, stream, a);
#endif
}
```

```cpp
#include <hip/hip_runtime.h>
#include <cstdio>
#include <cstdint>

#ifndef MK_ONE_LAUNCH
#define MK_ONE_LAUNCH 1
#endif

#define GAS __attribute__((address_space(1)))
#define LAS __attribute__((address_space(3)))
typedef unsigned short bf16_t;
typedef short bf16x8 __attribute__((ext_vector_type(8)));
typedef float f32x4 __attribute__((ext_vector_type(4)));
typedef float f32x2 __attribute__((ext_vector_type(2)));
typedef unsigned u32x4 __attribute__((ext_vector_type(4)));
typedef unsigned u32x2 __attribute__((ext_vector_type(2)));

constexpr int NB = 8, SEQ = 2048, M = NB * SEQ, DM = 1024, NL = 4, DIN = 10032, LDP = 10240, DFF = 4096;
constexpr float EPS = 1e-6f;
constexpr int P_NQ = 0, P_KC = 512, P_VC = 640, P_KS = 768, P_VS = 896, P_KW = 1024, P_VW = 1152;
constexpr int P_SQ = 1280, P_SK = 1792, P_SV = 2304;
constexpr int P_GQ = 2816, P_GK = 3072, P_GV = 3328, P_GG = 3840;
constexpr int P_FQ = 4352, P_FK = 4864, P_FV = 5376;
constexpr int P_GATE = 5888, P_NG = 9984, P_GA = 10008, P_FF = 10024;
__host__ __device__ __forceinline__ int win_src_col(int n) {
    if (n < 1280) return n;
    if (n < 3840) return n + 24;
    if (n < 5888) return n + 40;
    if (n < 9984) return n + 48;
    if (n < 10008) return n - 9984 + 1280;
    if (n < 10024) return n - 10008 + 3864;
    if (n < 10032) return n - 10024 + 5928;
    return -1;
}

constexpr size_t MiB = 1u << 20;
constexpr size_t WS_CTL = 0, CTL_BYTES = 1 * MiB;
constexpr size_t WS_WIN = 1 * MiB;
constexpr size_t WS_WB = 21 * MiB;
constexpr size_t WS_WO = 25 * MiB;
constexpr size_t WS_WF1 = 27 * MiB;
constexpr size_t WS_WF2 = 35 * MiB;
constexpr size_t WS_CW1 = 43 * MiB;
constexpr size_t WS_KC = 45 * MiB;
constexpr size_t WS_CUM = 46 * MiB;
constexpr size_t WS_CH = 47 * MiB;
constexpr size_t WS_HB = 52 * MiB;
constexpr size_t WS_MIX = 84 * MiB;
constexpr size_t WS_YS = 116 * MiB;
constexpr size_t WS_GQP = 180 * MiB;
constexpr size_t WS_GKP = 188 * MiB;
constexpr size_t WS_GKPP = 196 * MiB;
constexpr size_t WS_GDS = 204 * MiB;
constexpr size_t WS_GOI = 236 * MiB;
constexpr size_t WS_MIXF = WS_GDS;
constexpr size_t WS_PROJ = 268 * MiB;
constexpr size_t WS_HID = WS_PROJ;
constexpr size_t WS_END = 588 * MiB;

constexpr int CW_BAR = 4096;

constexpr int RING_BYTES = 131072;
constexpr int MISC_OFF = 146944;
constexpr int LDS_BYTES = 147456;
constexpr int NWAVES = 8, NTHR = 512;

__device__ __forceinline__ unsigned f2bf(float f) { unsigned u = __builtin_bit_cast(unsigned, f); return (u + 0x7fffu + ((u >> 16) & 1u)) >> 16; }
__device__ __forceinline__ unsigned pk2(float lo, float hi) { return f2bf(lo) | (f2bf(hi) << 16); }
__device__ __forceinline__ float bf2f(unsigned short b) { return __builtin_bit_cast(float, ((unsigned)b) << 16); }
__device__ __forceinline__ float bflo(unsigned w) { return __builtin_bit_cast(float, w << 16); }
__device__ __forceinline__ float bfhi(unsigned w) { return __builtin_bit_cast(float, w & 0xffff0000u); }
__device__ __forceinline__ int lane_id() { unsigned z = 0u; asm volatile("" : "+s"(z)); return (int)__builtin_amdgcn_mbcnt_hi(~0u, __builtin_amdgcn_mbcnt_lo(~0u, z)); }
__device__ __forceinline__ float wave_sum(float v) {
#pragma unroll
    for (int o = 1; o < 64; o <<= 1) v += __shfl_xor(v, o);
    return v;
}
__device__ __forceinline__ float sigmoidf_(float x) { return __builtin_amdgcn_rcpf(1.0f + __builtin_amdgcn_exp2f(-1.4426950408889634f * x)); }
__device__ __forceinline__ float softplusf_(float x) { return fmaxf(x, 0.f) + log1pf(__expf(-fabsf(x))); }
__device__ __forceinline__ float logsigmoidf_(float x) { return fminf(x, 0.f) - log1pf(__expf(-fabsf(x))); }

#define XB_TMO      128
#define XB_XCNT(j)  (256  + 64 * (j))
#define XB_XSUB(j)  (1280 + 64 * (j))
#define XB_XGEN(j)  (2304 + 64 * (j))
#define XB_TOP      3328
#define XB_TOPGEN   3392
#define XCD_BAR_WORDS 3456
#define XB_SPIN_CAP (1u << 18)
__device__ __forceinline__ unsigned xb_ld(unsigned* p)              { return __hip_atomic_load(p, __ATOMIC_RELAXED, __HIP_MEMORY_SCOPE_AGENT); }
__device__ __forceinline__ unsigned xb_add(unsigned* p, unsigned v) { return __hip_atomic_fetch_add(p, v, __ATOMIC_RELAXED, __HIP_MEMORY_SCOPE_AGENT); }
__device__ __forceinline__ unsigned xb_xcc_id() { return (unsigned)__builtin_amdgcn_s_getreg((3 << 11) | 20) & 0xFu; }
#define XB_SPIN(cond, bar) do { unsigned _sp = 0; while (cond) { __builtin_amdgcn_s_sleep(1); \
    if ((++_sp & 255u) == 0u) { if (xb_ld(&(bar)[XB_TMO])) break; if (_sp > XB_SPIN_CAP) { atomicAdd(&(bar)[XB_TMO], 1u); break; } } } } while (0)
struct XcdBarrier { unsigned* bar; unsigned x; volatile LAS unsigned* st; };
__device__ __forceinline__ XcdBarrier xcd_barrier_post(unsigned* bar, volatile LAS unsigned* st) {
    XcdBarrier b; b.bar = bar; b.x = xb_xcc_id(); b.st = st;
    if (threadIdx.x == 0) (void)xb_add(&bar[XB_XCNT(b.x)], 1u);
    return b;
}
__device__ __forceinline__ void xcd_barrier_complete(unsigned* bar, unsigned x, unsigned& nloc, unsigned& nx) {
    const unsigned G = gridDim.x * gridDim.y * gridDim.z;
    unsigned sum, cnt, mine, sp = 0u;
    for (;;) {
        sum = 0u; cnt = 0u; mine = 0u;
#pragma unroll
        for (unsigned j = 0; j < 16; ++j) { const unsigned c = xb_ld(&bar[XB_XCNT(j)]); sum += c; cnt += (c > 0u) ? 1u : 0u; mine = (j == x) ? c : mine; }
        if (sum == G) break;
        __builtin_amdgcn_s_sleep(1);
        if ((++sp & 255u) == 0u) { if (xb_ld(&bar[XB_TMO])) break; if (sp > XB_SPIN_CAP) { atomicAdd(&bar[XB_TMO], 1u); break; } }
    }
    nloc = mine > 0u ? mine : 1u; nx = cnt > 0u ? cnt : 1u;
}
__device__ __forceinline__ void xcd_barrier(const XcdBarrier& b, bool t0) {
    asm volatile("s_waitcnt vmcnt(0)" ::: "memory");
    __syncthreads();
    if (t0) {
        unsigned* bar = b.bar;
        __builtin_amdgcn_s_waitcnt(0);
        unsigned nloc = b.st[0], nx = b.st[1];
        if (nloc == 0u) { xcd_barrier_complete(bar, b.x, nloc, nx); b.st[0] = nloc; b.st[1] = nx; }
        const unsigned old = xb_add(&bar[XB_XSUB(b.x)], 1u);
        const unsigned gen = old / nloc;
        if (old + 1u == (gen + 1u) * nloc) {
            __builtin_amdgcn_fence(__ATOMIC_RELEASE, "agent");
            asm volatile("s_waitcnt vmcnt(0)" ::: "memory");
            const unsigned og = xb_add(&bar[XB_TOP], 1u);
            const unsigned tg = og / nx;
            if (og + 1u == (tg + 1u) * nx) xb_add(&bar[XB_TOPGEN], 1u);
            else XB_SPIN(xb_ld(&bar[XB_TOPGEN]) == tg, bar);
            __builtin_amdgcn_fence(__ATOMIC_ACQUIRE, "agent");
            xb_add(&bar[XB_XGEN(b.x)], 1u);
            asm volatile("s_waitcnt vmcnt(0)" ::: "memory");
        } else {
            XB_SPIN(xb_ld(&bar[XB_XGEN(b.x)]) == gen, bar);
            __builtin_amdgcn_fence(__ATOMIC_ACQUIRE, "agent");
            asm volatile("s_waitcnt vmcnt(0)" ::: "memory");
        }
    }
    __syncthreads();
}

namespace pg8 {
constexpr int BM = 256, BK = 64, HALF = 128, HTB = HALF * BK * 2, STAGE_BYTES = 8 * HTB, NXCD = 8, WGM = 8;
__host__ __device__ __forceinline__ int lds_byte(int r, int c) { const int st = (r >> 4) * 2 + (c >> 5), rr = r & 15, cc = c & 31, ob = rr * 64 + cc * 2; return st * 1024 + (ob ^ (((ob >> 9) & 1) << 5)); }
__host__ __device__ __forceinline__ void stage_rc(int b, int& R, int& C) { const int st = b / 1024, sb = b % 1024, swz = sb ^ (((sb >> 9) & 1) << 5); R = (st >> 1) * 16 + swz / 64; C = (st & 1) * 32 + (swz % 64) / 2; }
__host__ __device__ __forceinline__ int perm32(int rho) { const int n = rho >> 4, i = rho & 15; return 8 * (i >> 2) + 4 * n + (i & 3); }

struct Unit { int pm, pn, z; };
struct Gemm { const bf16_t* A; const bf16_t* Bt; int lda, ldb, K; size_t zA, zB; };

struct StaticOrder {
    int nM, nN, nwg, G, c;
    __host__ __device__ void init(int M_, int N_, int G_, int c_) { nM = M_ / BM; nN = N_ / BM; nwg = nM * nN; G = G_; c = c_; }
    __host__ __device__ bool tile(long L, Unit& u) const {
        if (L >= nwg) return false;
        int wgid = (int)L; { const int q = nwg / NXCD, r = nwg % NXCD, xcd = wgid % NXCD, off = wgid / NXCD; wgid = (xcd < r ? xcd * (q + 1) : r * (q + 1) + (xcd - r) * q) + off; }
        const int nig = WGM * nN, gid = wgid / nig, fm = gid * WGM, gsz = (nM - fm) < WGM ? (nM - fm) : WGM;
        u.pm = fm + ((wgid % nig) % gsz); u.pn = (wgid % nig) / gsz; u.z = 0; return true;
    }
    __host__ __device__ bool next(int i, Unit& u) const { return tile((long)i * G + c, u); }
};
struct ZOrder : StaticOrder {
    int NZ;
    __host__ __device__ bool next(int i, Unit& u) const { const int ti = i / NZ; if (!tile((long)ti * G + c, u)) return false; u.z = i - ti * NZ; return true; }
};

__device__ __forceinline__ unsigned cvt_pk_bf16(float lo, float hi) { unsigned r; asm volatile("v_cvt_pk_bf16_f32 %0, %1, %2" : "=v"(r) : "v"(lo), "v"(hi)); return r; }

struct NoState {};
template <int ACT> struct EpiBf16 {
    static constexpr bool PERM = true, HALFN = false; typedef NoState State;
    bf16_t* O; int ldc; const float* rsv;
    __device__ __forceinline__ void operator()(const f32x4 (&acc)[2][2][4][2], NoState&, const Unit& u, int wr, int wc, int fr, int fq) const {
        const int row0 = u.pm * BM + wr * 64 + fr; const int col0 = u.pn * BM + wc * 32 + 8 * fq;
        float rs[2][4];
        if (ACT == 0) {
#pragma unroll
            for (int ai = 0; ai < 2; ++ai)
#pragma unroll
                for (int m = 0; m < 4; ++m) rs[ai][m] = rsv[row0 + ai * HALF + m * 16];
        } else {
#pragma unroll
            for (int ai = 0; ai < 2; ++ai) {
                f32x4 pt[4][4];
#pragma unroll
                for (int m = 0; m < 4; ++m)
#pragma unroll
                    for (int q = 0; q < 4; ++q) pt[m][q] = *(const f32x4*)(rsv + (size_t)(row0 + ai * HALF + m * 16) * 16 + 4 * q);
#pragma unroll
                for (int m = 0; m < 4; ++m) { float t = 0.f;
#pragma unroll
                    for (int q = 0; q < 4; ++q) t += (pt[m][q][0] + pt[m][q][1]) + (pt[m][q][2] + pt[m][q][3]);
                    const float r = rsqrtf(t * (1.0f / DM) + EPS); rs[ai][m] = r * r; }
                asm volatile("" : "+v"(rs[ai][0]), "+v"(rs[ai][1]), "+v"(rs[ai][2]), "+v"(rs[ai][3]));
            }
        }
#pragma unroll
        for (int ai = 0; ai < 2; ++ai)
#pragma unroll
            for (int m = 0; m < 4; ++m) { bf16_t* rowp = O + (size_t)(row0 + ai * HALF + m * 16) * ldc + col0; const float r = rs[ai][m];
#pragma unroll
                for (int bj = 0; bj < 2; ++bj) { f32x4 v0 = acc[ai][bj][m][0], v1 = acc[ai][bj][m][1];
                    if (ACT == 1) {
#pragma unroll
                        for (int j = 0; j < 4; ++j) { const float a = fmaxf(v0[j], 0.f), b = fmaxf(v1[j], 0.f); v0[j] = a * a; v1[j] = b * b; } }
                    v0 = v0 * r; v1 = v1 * r;
                    u32x4 w; w.x = cvt_pk_bf16(v0[0], v0[1]); w.y = cvt_pk_bf16(v0[2], v0[3]); w.z = cvt_pk_bf16(v1[0], v1[1]); w.w = cvt_pk_bf16(v1[2], v1[3]);
                    *(u32x4*)(rowp + bj * HALF) = w; } }
    }
};
struct EpiNull {
    static constexpr bool PERM = true, HALFN = false; typedef NoState State;
    __device__ __forceinline__ void operator()(const f32x4 (&acc)[2][2][4][2], NoState&, const Unit& u, int wr, int wc, int fr, int fq) const {
#pragma unroll
        for (int ai = 0; ai < 2; ++ai)
#pragma unroll
            for (int bj = 0; bj < 2; ++bj)
#pragma unroll
                for (int m = 0; m < 4; ++m)
#pragma unroll
                    for (int n = 0; n < 2; ++n) asm volatile("" :: "v"(acc[ai][bj][m][n]));
    }
};
struct EpiRes {
    static constexpr bool PERM = false, HALFN = false; typedef NoState State;
    const float* base; float* out; int ldc; const float* gain; bf16_t* hb; float* ssq;
    __device__ __forceinline__ void operator()(const f32x4 (&acc)[2][2][4][2], NoState&, const Unit& u, int wr, int wc, int fr, int fq) const {
        const int row0 = u.pm * BM + wr * 64 + fr, col0 = u.pn * BM + wc * 32 + 4 * fq;
        f32x4 gn[2][2];
#pragma unroll
        for (int bj = 0; bj < 2; ++bj)
#pragma unroll
            for (int n = 0; n < 2; ++n) gn[bj][n] = *(const f32x4*)(gain + col0 + bj * HALF + n * 16);
#pragma unroll
        for (int ai = 0; ai < 2; ++ai)
#pragma unroll
            for (int mp = 0; mp < 2; ++mp) {
                f32x4 bs[2][2][2];
#pragma unroll
                for (int mm = 0; mm < 2; ++mm) { const size_t off = (size_t)(row0 + ai * HALF + (2 * mp + mm) * 16) * ldc + col0;
#pragma unroll
                    for (int bj = 0; bj < 2; ++bj)
#pragma unroll
                        for (int n = 0; n < 2; ++n) bs[mm][bj][n] = *(const f32x4*)(base + off + bj * HALF + n * 16); }
#pragma unroll
                for (int mm = 0; mm < 2; ++mm) { const int m = 2 * mp + mm; const int row = row0 + ai * HALF + m * 16; const size_t off = (size_t)row * ldc + col0; float sq = 0.f;
#pragma unroll
                    for (int bj = 0; bj < 2; ++bj)
#pragma unroll
                        for (int n = 0; n < 2; ++n) { const f32x4 xn = bs[mm][bj][n] + acc[ai][bj][m][n]; *(f32x4*)(out + off + bj * HALF + n * 16) = xn;
                            sq += (xn[0] * xn[0] + xn[1] * xn[1]) + (xn[2] * xn[2] + xn[3] * xn[3]);
                            const f32x4 hv = xn * gn[bj][n]; u32x2 w; w.x = cvt_pk_bf16(hv[0], hv[1]); w.y = cvt_pk_bf16(hv[2], hv[3]); *(u32x2*)(hb + off + bj * HALF + n * 16) = w; }
                    sq += __shfl_xor(sq, 16); sq += __shfl_xor(sq, 32);
                    if (fq == 0) ssq[(size_t)row * 16 + 4 * u.pn + wc] = sq; }
            }
    }
};
struct GateSum { f32x4 v[2][4][2]; };
struct EpiGate {
    static constexpr bool PERM = false, HALFN = true; typedef GateSum State;
    const bf16_t* proj; const float* b_gate; bf16_t* mix;
    __device__ __forceinline__ void operator()(const f32x4 (&acc)[2][1][4][2], GateSum& st, const Unit& u, int wr, int wc, int fr, int fq) const {
        const int row0 = u.pm * BM + wr * 64 + fr, col0 = u.pn * HALF + wc * 32 + 4 * fq; const int z = u.z;
        f32x4 bg[2];
#pragma unroll
        for (int n = 0; n < 2; ++n) bg[n] = *(const f32x4*)(b_gate + z * DM + col0 + n * 16);
#pragma unroll
        for (int ai = 0; ai < 2; ++ai) {
            u32x2 gl[4][2];
#pragma unroll
            for (int m = 0; m < 4; ++m)
#pragma unroll
                for (int n = 0; n < 2; ++n) gl[m][n] = *(const u32x2*)(proj + (size_t)(row0 + ai * HALF + m * 16) * LDP + P_GATE + z * DM + col0 + n * 16);
#pragma unroll
            for (int m = 0; m < 4; ++m)
#pragma unroll
                for (int n = 0; n < 2; ++n) { const u32x2 g2 = gl[m][n]; const f32x4 b4 = bg[n]; const f32x4 av = acc[ai][0][m][n];
                    f32x4 t = (z == 0) ? (f32x4){0.f, 0.f, 0.f, 0.f} : st.v[ai][m][n];
                    t[0] += sigmoidf_(bflo(g2.x) + b4[0]) * av[0]; t[1] += sigmoidf_(bfhi(g2.x) + b4[1]) * av[1];
                    t[2] += sigmoidf_(bflo(g2.y) + b4[2]) * av[2]; t[3] += sigmoidf_(bfhi(g2.y) + b4[3]) * av[3];
                    st.v[ai][m][n] = t;
                    if (z == 3) { u32x2 w; w.x = cvt_pk_bf16(t[0], t[1]); w.y = cvt_pk_bf16(t[2], t[3]); *(u32x2*)(mix + (size_t)(row0 + ai * HALF + m * 16) * DM + col0 + n * 16) = w; } }
        }
    }
};

template <class Epi, class Sched>
__device__ __forceinline__ void gemm_phase(LAS unsigned char* lds, const Gemm g, const Sched& S, const Epi& E, int wave_s) {
    asm volatile("" : "+s"(wave_s)); int tid_ = wave_s * 64 + lane_id(); asm volatile("" : "+v"(tid_));
    const int tid = tid_, wid = __builtin_amdgcn_readfirstlane(tid >> 6), lane = tid & 63, wr = wid >> 2, wc = wid & 3, fr = lane & 15, fq = lane >> 4;
    const int K = g.K, nt = K / BK;
    unsigned voffA[2], voffB[2];
#pragma unroll
    for (int i = 0; i < 2; ++i) { int R, C; stage_rc(tid * 16 + i * 8192, R, C); const int Rb = Epi::PERM ? ((R & ~31) + perm32(R & 31)) : R;
        voffA[i] = (unsigned)(R * g.lda + C) * 2u; voffB[i] = (unsigned)(Rb * g.ldb + C) * 2u; }
    const size_t kstep = (size_t)(BK * 2);
    constexpr bool HN = Epi::HALFN; constexpr int NBJ = HN ? 1 : 2;
    const size_t hstepA = (size_t)HALF * g.lda * 2, hstepB = HN ? (size_t)0 : (size_t)HALF * g.ldb * 2, bunit = HN ? (size_t)HALF * g.ldb * 2 : (size_t)2 * HALF * g.ldb * 2;
    const unsigned ldsw = (unsigned)wid * 1024u;
    const int aoff = lds_byte(wr * 64 + fr, fq * 8), boff = lds_byte(wc * 32 + fr, fq * 8);
#define PG8_SA(b, h) (((b) * 2 + (h)) * HTB)
#define PG8_SB(b, h) ((4 + (b) * 2 + (h)) * HTB)
#define PG8_STAGE(bufoff, gbase, voff) do { _Pragma("unroll") for (int _i = 0; _i < 2; ++_i) \
        __builtin_amdgcn_global_load_lds((const unsigned*)((const char*)(gbase) + (voff)[_i]), (LAS unsigned*)(lds + (bufoff) + ldsw + _i * 8192), 16, 0, 0); } while (0)
#define PG8_LDA(dst, b, h) do { _Pragma("unroll") for (int m = 0; m < 4; ++m) _Pragma("unroll") for (int k = 0; k < 2; ++k) dst[m][k] = *(const LAS bf16x8*)(lds + PG8_SA(b, h) + aoff + m * 2048 + k * 1024); } while (0)
#define PG8_LDB(dst, b, h) do { _Pragma("unroll") for (int n = 0; n < 2; ++n) _Pragma("unroll") for (int k = 0; k < 2; ++k) dst[n][k] = *(const LAS bf16x8*)(lds + PG8_SB(b, h) + boff + n * 2048 + k * 1024); } while (0)
#define PG8_MMA(ai, bj, At, Bt) do { __builtin_amdgcn_s_setprio(1); _Pragma("unroll") for (int m = 0; m < 4; ++m) _Pragma("unroll") for (int n = 0; n < 2; ++n) _Pragma("unroll") for (int k = 0; k < 2; ++k) \
        acc[ai][bj][m][n] = __builtin_amdgcn_mfma_f32_16x16x32_bf16(Bt[n][k], At[m][k], acc[ai][bj][m][n], 0, 0, 0); __builtin_amdgcn_s_setprio(0); } while (0)
#define PG8_WAIT_V(n) asm volatile("s_waitcnt vmcnt(" #n ")" ::: "memory")
#define PG8_WAIT_L(n) asm volatile("s_waitcnt lgkmcnt(" #n ")" ::: "memory")
#define PG8_BAR __builtin_amdgcn_s_barrier()
#define PG8_SCHED __builtin_amdgcn_sched_barrier(0)
#define PG8_APTR(u) ((const char*)g.A + ((size_t)(u).z * g.zA) * 2 + (size_t)(u).pm * 2 * hstepA)
#define PG8_BPTR(u) ((const char*)g.Bt + ((size_t)(u).z * g.zB) * 2 + (size_t)(u).pn * bunit)
    Unit cur, nxt; int ui = 0;
    if (!S.next(0, cur)) return;
    f32x4 acc[2][NBJ][4][2]; typename Epi::State est;
#pragma unroll
    for (int a = 0; a < 2; ++a)
#pragma unroll
        for (int b = 0; b < NBJ; ++b)
#pragma unroll
            for (int m = 0; m < 4; ++m)
#pragma unroll
                for (int n = 0; n < 2; ++n) acc[a][b][m][n] = (f32x4){0.f, 0.f, 0.f, 0.f};
    bf16x8 At[4][2], B0[2][2], B1[2][2];
    const char* cA = PG8_APTR(cur); const char* cB = PG8_BPTR(cur);
    PG8_STAGE(PG8_SB(0, 0), cB, voffB); PG8_STAGE(PG8_SB(0, 1), cB + hstepB, voffB); PG8_STAGE(PG8_SA(0, 0), cA, voffA); PG8_STAGE(PG8_SA(0, 1), cA + hstepA, voffA);
    if (wr == 1) PG8_BAR;
    PG8_WAIT_V(2); PG8_BAR;
    PG8_STAGE(PG8_SB(1, 0), cB + kstep, voffB); PG8_STAGE(PG8_SA(1, 0), cA + kstep, voffA); PG8_STAGE(PG8_SB(1, 1), cB + hstepB + kstep, voffB);
    PG8_WAIT_V(6); PG8_BAR;
    for (;;) {
        const bool has_next = S.next(ui + 1, nxt);
        const char* nA = has_next ? PG8_APTR(nxt) : cA; const char* nB = has_next ? PG8_BPTR(nxt) : cB;
        for (int t = 0; t < nt; t += 2) {
            const bool last = (t == nt - 2);
            const char* a1 = cA + (size_t)(t + 1) * kstep;
            const char* a2 = last ? nA : cA + (size_t)(t + 2) * kstep; const char* b2 = last ? nB : cB + (size_t)(t + 2) * kstep;
            const char* a3 = a2 + kstep; const char* b3 = b2 + kstep;
            PG8_LDB(B0, 0, 0); if constexpr (!HN) PG8_LDB(B1, 0, 1); PG8_SCHED; PG8_LDA(At, 0, 0); PG8_STAGE(PG8_SA(1, 1), a1 + hstepA, voffA);
            PG8_WAIT_V(8); PG8_WAIT_L(0); PG8_BAR; PG8_MMA(0, 0, At, B0); if constexpr (!HN) PG8_MMA(0, 1, At, B1); PG8_BAR; PG8_SCHED;
            PG8_LDA(At, 0, 1); PG8_STAGE(PG8_SB(0, 0), b2, voffB); PG8_STAGE(PG8_SB(0, 1), b2 + hstepB, voffB); PG8_STAGE(PG8_SA(0, 0), a2, voffA);
            PG8_WAIT_V(8); PG8_WAIT_L(0); PG8_BAR; PG8_MMA(1, 0, At, B0); if constexpr (!HN) PG8_MMA(1, 1, At, B1); PG8_BAR; PG8_SCHED;
            PG8_LDB(B0, 1, 0); if constexpr (!HN) PG8_LDB(B1, 1, 1); PG8_SCHED; PG8_LDA(At, 1, 0); PG8_STAGE(PG8_SA(0, 1), a2 + hstepA, voffA);
            PG8_WAIT_V(8); PG8_WAIT_L(0); PG8_BAR; PG8_MMA(0, 0, At, B0); if constexpr (!HN) PG8_MMA(0, 1, At, B1); PG8_BAR; PG8_SCHED;
            PG8_LDA(At, 1, 1); PG8_STAGE(PG8_SB(1, 0), b3, voffB); PG8_STAGE(PG8_SB(1, 1), b3 + hstepB, voffB); PG8_STAGE(PG8_SA(1, 0), a3, voffA);
            PG8_WAIT_V(8); PG8_WAIT_L(0); PG8_BAR; PG8_MMA(1, 0, At, B0); if constexpr (!HN) PG8_MMA(1, 1, At, B1); PG8_BAR; PG8_SCHED;
        }
        if (wr == 0) PG8_BAR;
        E(acc, est, cur, wr, wc, fr, fq);
        if (!has_next) break;
#pragma unroll
        for (int a = 0; a < 2; ++a)
#pragma unroll
            for (int b = 0; b < NBJ; ++b)
#pragma unroll
                for (int m = 0; m < 4; ++m)
#pragma unroll
                    for (int n = 0; n < 2; ++n) acc[a][b][m][n] = (f32x4){0.f, 0.f, 0.f, 0.f};
        cur = nxt; cA = nA; cB = nB; ++ui;
        if (wr == 1) PG8_BAR;
    }
    PG8_WAIT_V(0);
    PG8_BAR;
#undef PG8_SA
#undef PG8_SB
#undef PG8_STAGE
#undef PG8_LDA
#undef PG8_LDB
#undef PG8_MMA
#undef PG8_WAIT_V
#undef PG8_WAIT_L
#undef PG8_BAR
#undef PG8_SCHED
#undef PG8_APTR
#undef PG8_BPTR
}
}

struct Args {
    const float* x; const int* pos; const float* norm_mix; const float* w_in; const float* b_gate;
    const float* cmp_pos_k; const float* cmp_pos_v; const float* cmp_wk1; const float* cmp_wk2; const float* cmp_wv1; const float* cmp_wv2;
    const float* gla_w_alpha; const float* gla_b_alpha; const float* gla_norm; const float* fox_b_f;
    const float* w_branch; const float* w_out; const float* norm_ff; const float* w_ff1; const float* w_ff2; const float* norm_final;
    float* out; unsigned char* ws;
    int l_lo, l_hi, p_lo, p_hi, do_final, pad;
};

struct Ctx { LAS unsigned char* lds; int tid, lane, wave, G, bid, gw, NGW; };
__device__ __forceinline__ Ctx make_ctx(LAS unsigned char* lds, int wave_s) {
    Ctx C; asm volatile("" : "+s"(wave_s)); int t = wave_s * 64 + lane_id(); asm volatile("" : "+v"(t));
    C.lds = lds; C.tid = t; C.lane = t & 63; C.wave = __builtin_amdgcn_readfirstlane(t >> 6); C.G = gridDim.x; C.bid = blockIdx.x; C.gw = C.bid * NWAVES + C.wave; C.NGW = C.G * NWAVES; return C;
}

template <bool MAP>
__device__ __forceinline__ void transpose_item(const float* W, int Nsrc, int Kdim, bf16_t* WT, LAS float* scr, int k0, int n0, int lane) {
    const int kr = lane >> 4, nq = lane & 15; const int nn = n0 + 4 * nq; const int sc = MAP ? win_src_col(nn) : nn;
    f32x4 v[16];
#pragma unroll
    for (int i = 0; i < 16; ++i) v[i] = (sc >= 0) ? *(const f32x4*)(W + (size_t)(k0 + 4 * i + kr) * Nsrc + sc) : (f32x4){0.f, 0.f, 0.f, 0.f};
#pragma unroll
    for (int i = 0; i < 16; ++i) { const int k = 4 * i + kr;
#pragma unroll
        for (int j = 0; j < 4; ++j) scr[(4 * nq + j) * 65 + k] = v[i][j]; }
    asm volatile("s_waitcnt lgkmcnt(0)" ::: "memory");
#pragma unroll
    for (int c = 0; c < 8; ++c) { const LAS float* sp = scr + lane * 65 + 8 * c;
        u32x4 o; o.x = pk2(sp[0], sp[1]); o.y = pk2(sp[2], sp[3]); o.z = pk2(sp[4], sp[5]); o.w = pk2(sp[6], sp[7]);
        *(u32x4*)(WT + (size_t)(n0 + lane) * Kdim + k0 + 8 * c) = o; }
    asm volatile("s_waitcnt lgkmcnt(0)" ::: "memory");
}
template <bool MAP>
__device__ __forceinline__ void transpose_matrix(const Ctx& C, const float* W, int Kdim, int Nsrc, int Ndst, bf16_t* WT, int& base) {
    LAS float* scr = (LAS float*)(C.lds + C.wave * 16640);
    const int nblk = Ndst / 64, items = (Kdim / 64) * nblk;
    int first = (C.gw - base % C.NGW + C.NGW) % C.NGW;
    for (int it = first; it < items; it += C.NGW) { const int kb = it / nblk, nb = it % nblk; transpose_item<MAP>(W, Nsrc, Kdim, WT, scr, 64 * kb, 64 * nb, C.lane); }
    base += items;
}
__device__ __forceinline__ void xg_rows_phase(const Ctx& C, const float* x, const float* g, bf16_t* hb, float* rstd) {
    for (int m = C.gw; m < M; m += C.NGW) {
        const f32x4* xr = (const f32x4*)(x + (size_t)m * DM) + C.lane; const f32x4* gr = (const f32x4*)g + C.lane;
        f32x4 v[4]; float s = 0.f;
#pragma unroll
        for (int j = 0; j < 4; ++j) { v[j] = xr[64 * j]; s += (v[j].x * v[j].x + v[j].y * v[j].y) + (v[j].z * v[j].z + v[j].w * v[j].w); }
        s = wave_sum(s); if (C.lane == 0) rstd[m] = rsqrtf(s * (1.f / DM) + EPS);
        unsigned long long* o8 = (unsigned long long*)(hb + (size_t)m * DM) + C.lane;
#pragma unroll
        for (int j = 0; j < 4; ++j) { const f32x4 gg = gr[64 * j]; o8[64 * j] = (unsigned long long)pk2(v[j].x * gg.x, v[j].y * gg.y) | ((unsigned long long)pk2(v[j].z * gg.z, v[j].w * gg.w) << 32); }
    }
}
__device__ __forceinline__ void final_norm_phase(const Ctx& C, float* x, const float* g) {
    for (int m = C.gw; m < M; m += C.NGW) {
        f32x4* xr = (f32x4*)(x + (size_t)m * DM) + C.lane; const f32x4* gr = (const f32x4*)g + C.lane;
        f32x4 v[4]; float s = 0.f;
#pragma unroll
        for (int j = 0; j < 4; ++j) { v[j] = xr[64 * j]; s += (v[j].x * v[j].x + v[j].y * v[j].y) + (v[j].z * v[j].z + v[j].w * v[j].w); }
        const float r = rsqrtf(wave_sum(s) * (1.f / DM) + EPS);
#pragma unroll
        for (int j = 0; j < 4; ++j) xr[64 * j] = v[j] * r * gr[64 * j];
    }
}

__device__ __forceinline__ void ld8(const bf16_t* p, float (&o)[8]) {
    const u32x4 w = *(const u32x4*)p;
    o[0] = bflo(w.x); o[1] = bfhi(w.x); o[2] = bflo(w.y); o[3] = bfhi(w.y); o[4] = bflo(w.z); o[5] = bfhi(w.z); o[6] = bflo(w.w); o[7] = bfhi(w.w);
}
__device__ __forceinline__ float dot64(const float (&q)[64], const bf16_t* k) {
    float s = 0.f;
#pragma unroll
    for (int c = 0; c < 8; ++c) { float kv[8]; ld8(k + 8 * c, kv);
#pragma unroll
        for (int j = 0; j < 8; ++j) s += q[8 * c + j] * kv[j]; }
    return s;
}
__device__ __forceinline__ void axpy64(float (&acc)[64], float p, const bf16_t* v) {
#pragma unroll
    for (int c = 0; c < 8; ++c) { float vv[8]; ld8(v + 8 * c, vv);
#pragma unroll
        for (int j = 0; j < 8; ++j) acc[8 * c + j] += p * vv[j]; }
}
__device__ __forceinline__ void ldq64(float (&q)[64], const bf16_t* p, float scale) {
#pragma unroll
    for (int c = 0; c < 8; ++c) { float t[8]; ld8(p + 8 * c, t);
#pragma unroll
        for (int j = 0; j < 8; ++j) q[8 * c + j] = t[j] * scale; }
}
struct OS { float m, l; };
#define OS_STEP(sc) do { const float mn_ = fmaxf(st.m, (sc)); const float al_ = __expf(st.m - mn_); const float p_ = __expf((sc) - mn_); st.l = st.l * al_ + p_; \
    _Pragma("unroll") for (int d_ = 0; d_ < 64; ++d_) acc[d_] *= al_; axpy64(acc, p_, vrow); st.m = mn_; } while (0)

__device__ __forceinline__ void rope_rotate(bf16_t* p, int posv) {
    u32x4 a = *(u32x4*)p, b = *(u32x4*)(p + 8);
    float x1[8] = {bflo(a.x), bfhi(a.x), bflo(a.y), bfhi(a.y), bflo(a.z), bfhi(a.z), bflo(a.w), bfhi(a.w)};
    float x2[8] = {bflo(b.x), bfhi(b.x), bflo(b.y), bfhi(b.y), bflo(b.z), bfhi(b.z), bflo(b.w), bfhi(b.w)};
    float o1[8], o2[8];
#pragma unroll
    for (int i = 0; i < 8; ++i) { const float inv = powf(500000.0f, -(float)(2 * i) / 16.0f); const float ang = (float)posv * inv; float sn, cs; sincosf(ang, &sn, &cs);
        o1[i] = x1[i] * cs - x2[i] * sn; o2[i] = x2[i] * cs + x1[i] * sn; }
    a.x = pk2(o1[0], o1[1]); a.y = pk2(o1[2], o1[3]); a.z = pk2(o1[4], o1[5]); a.w = pk2(o1[6], o1[7]);
    b.x = pk2(o2[0], o2[1]); b.y = pk2(o2[2], o2[3]); b.z = pk2(o2[4], o2[5]); b.w = pk2(o2[6], o2[7]);
    *(u32x4*)p = a; *(u32x4*)(p + 8) = b;
}
__device__ __forceinline__ float gelu_tanh(float x) { const float u = 0.7978845608028654f * (x + 0.044715f * x * x * x); return 0.5f * x * (1.0f + tanhf(u)); }

__device__ __forceinline__ void naive_prepA(const Ctx& C, const Args& a, int l, bf16_t* proj, float* cum, float* ch) {
    const int gt = C.bid * NTHR + C.tid, NT = C.G * NTHR;
    for (int i = gt; i < M * 12; i += NT) { const int tok = i / 12, j = i % 12; const int col = j < 8 ? P_NQ + j * 64 : (j < 10 ? P_KS + (j - 8) * 64 : P_KW + (j - 10) * 64);
        rope_rotate(proj + (size_t)tok * LDP + col, a.pos[tok]); }
    for (int bh = C.gw; bh < NB * 8; bh += C.NGW) { const int b = bh >> 3, h = bh & 7; const float bf = a.fox_b_f[l * 8 + h];
        float loc[32]; float run = 0.f;
#pragma unroll
        for (int i = 0; i < 32; ++i) { const int s = C.lane * 32 + i; const float f = bf2f(proj[(size_t)(b * SEQ + s) * LDP + P_FF + h]); run += logsigmoidf_(f + bf); loc[i] = run; }
        float incl = run;
#pragma unroll
        for (int o = 1; o < 64; o <<= 1) { const float t = __shfl_up(incl, o); if (C.lane >= o) incl += t; }
        const float excl = incl - run;
#pragma unroll
        for (int i = 0; i < 32; ++i) cum[(size_t)bh * SEQ + C.lane * 32 + i] = excl + loc[i]; }
    const int NCH = 2 * NB * 127 * 2 * 256;
    for (int i = gt; i < NCH; i += NT) { const int j = i & 255; int r = i >> 8; const int g = r & 1; r >>= 1; const int c = r % 127; r /= 127; const int b = r % NB; const int kv = r / NB;
        const float* w1 = (kv ? a.cmp_wv1 : a.cmp_wk1) + (size_t)l * 2048 * 256; const float* pe = (kv ? a.cmp_pos_v : a.cmp_pos_k) + (size_t)l * 32 * 64;
        const int col = (kv ? P_VC : P_KC) + g * 64; float s = 0.f;
        for (int ll = 0; ll < 32; ++ll) { const bf16_t* xr = proj + (size_t)(b * SEQ + 16 * c + ll) * LDP + col;
            for (int d8 = 0; d8 < 8; ++d8) { float xv[8]; ld8(xr + 8 * d8, xv);
#pragma unroll
                for (int d = 0; d < 8; ++d) s += (xv[d] + pe[ll * 64 + d8 * 8 + d]) * w1[(size_t)(ll * 64 + d8 * 8 + d) * 256 + j]; } }
        ch[i] = gelu_tanh(s); }
}
__device__ __forceinline__ void naive_prepB(const Ctx& C, const Args& a, int l, const float* ch, bf16_t* kcvc) {
    const int gt = C.bid * NTHR + C.tid, NT = C.G * NTHR; const int NO = 2 * NB * 127 * 2 * 64;
    for (int i = gt; i < 2 * NB * 128; i += NT) { const int kv = i / (NB * 128), b = (i / 128) % NB, e = i % 128; kcvc[((((size_t)kv * NB + b) * 128 + 127) * 2) * 64 + e] = 0; }
    for (int i = gt; i < NO; i += NT) { const int d = i & 63; int r = i >> 6; const int g = r & 1; r >>= 1; const int c = r % 127; r /= 127; const int b = r % NB; const int kv = r / NB;
        const float* w2 = (kv ? a.cmp_wv2 : a.cmp_wk2) + (size_t)l * 256 * 64; const float* hrow = ch + ((((size_t)kv * NB + b) * 127 + c) * 2 + g) * 256;
        float v = 0.f, vp = 0.f; const int dp = (d < 8) ? d + 8 : d - 8;
        for (int j = 0; j < 256; ++j) { const float hv = hrow[j]; v += hv * w2[j * 64 + d]; if (d < 16) vp += hv * w2[j * 64 + dp]; }
        if (kv == 0 && d < 16) { const int i8 = d & 7; const float inv = powf(500000.0f, -(float)(2 * i8) / 16.0f); const float ang = (float)a.pos[b * SEQ + 16 * c + 31] * inv; float sn, cs; sincosf(ang, &sn, &cs);
            v = (d < 8) ? (v * cs - vp * sn) : (v * cs + vp * sn); }
        kcvc[((((size_t)kv * NB + b) * 128 + c) * 2 + g) * 64 + d] = (bf16_t)f2bf(v); }
}

__device__ __forceinline__ void naive_fox(const Ctx& C, const bf16_t* proj, const float* cum, bf16_t* ys) {
    for (int blk = C.bid; blk < NB * 8 * 4; blk += C.G) { const int bh = blk >> 2, b = bh >> 3, h = bh & 7; const int t = (blk & 3) * 512 + C.tid;
        const size_t rowb = (size_t)b * SEQ; float q[64]; ldq64(q, proj + (rowb + t) * LDP + P_FQ + h * 64, 0.125f);
        const float ct = cum[(size_t)bh * SEQ + t]; float acc[64];
#pragma unroll
        for (int d = 0; d < 64; ++d) acc[d] = 0.f;
        OS st; st.m = -1e30f; st.l = 0.f; const int tmax = t | 63;
        for (int s = 0; s <= tmax; ++s) { const bf16_t* krow = proj + (rowb + s) * LDP + P_FK + h * 64; const bf16_t* vrow = proj + (rowb + s) * LDP + P_FV + h * 64;
            if (s <= t) { const float sc = dot64(q, krow) + ct - cum[(size_t)bh * SEQ + s]; OS_STEP(sc); } }
        const float il = 1.f / st.l; bf16_t* o = ys + ((size_t)3 * M + rowb + t) * 512 + h * 64;
#pragma unroll
        for (int d = 0; d < 64; d += 2) *(unsigned*)(o + d) = pk2(acc[d] * il, acc[d + 1] * il); }
}
__device__ __forceinline__ void naive_sb(const Ctx& C, const bf16_t* proj, bf16_t* ys) {
    for (int blk = C.bid; blk < NB * 8 * 4; blk += C.G) { const int bh = blk >> 2, b = bh >> 3, h = bh & 7; const int t = (blk & 3) * 512 + C.tid;
        const size_t rowb = (size_t)b * SEQ; float q[64]; ldq64(q, proj + (rowb + t) * LDP + P_SQ + h * 64, 0.125f);
        float acc[64];
#pragma unroll
        for (int d = 0; d < 64; ++d) acc[d] = 0.f;
        float R = 0.f; const int tmax = t | 63;
        for (int s = tmax - 1; s >= 0; --s) { const bf16_t* krow = proj + (rowb + s) * LDP + P_SK + h * 64; const bf16_t* vrow = proj + (rowb + s) * LDP + P_SV + h * 64;
            if (s < t) { const float z = dot64(q, krow); const float sp = softplusf_(z); const float av = __expf(z - sp - R); axpy64(acc, av, vrow); R += sp; } }
        bf16_t* o = ys + ((size_t)1 * M + rowb + t) * 512 + h * 64;
#pragma unroll
        for (int d = 0; d < 64; d += 2) *(unsigned*)(o + d) = pk2(acc[d], acc[d + 1]); }
}
__device__ __forceinline__ void naive_gla(const Ctx& C, const Args& a, int l, const bf16_t* proj, float* obuf, bf16_t* ys) {
    LAS float* red = (LAS float*)C.lds;
    for (int bh = C.bid; bh < NB * 4; bh += C.G) { const int b = bh >> 2, h = bh & 3; const int kk = C.tid >> 3, vs = C.tid & 7; const size_t rowb = (size_t)b * SEQ;
        float wa[16];
#pragma unroll
        for (int r = 0; r < 16; ++r) wa[r] = a.gla_w_alpha[(size_t)l * 16 * 256 + r * 256 + h * 64 + kk];
        const float ba = a.gla_b_alpha[l * 256 + h * 64 + kk];
        float stt[16];
#pragma unroll
        for (int i = 0; i < 16; ++i) stt[i] = 0.f;
        for (int t = 0; t < SEQ; ++t) { const bf16_t* pr = proj + (rowb + t) * LDP;
            float al[16]; { float t0[8], t1[8]; ld8(pr + P_GA, t0); ld8(pr + P_GA + 8, t1);
#pragma unroll
                for (int r = 0; r < 8; ++r) { al[r] = t0[r]; al[8 + r] = t1[r]; } }
            float xa = ba;
#pragma unroll
            for (int r = 0; r < 16; ++r) xa += al[r] * wa[r];
            const float dec = __expf(logsigmoidf_(xa) * (1.0f / 16.0f));
            const float kv = bf2f(pr[P_GK + h * 64 + kk]), qv = bf2f(pr[P_GQ + h * 64 + kk]) * 0.125f;
            float vv[16]; { float t0[8], t1[8]; ld8(pr + P_GV + h * 128 + vs * 16, t0); ld8(pr + P_GV + h * 128 + vs * 16 + 8, t1);
#pragma unroll
                for (int r = 0; r < 8; ++r) { vv[r] = t0[r]; vv[8 + r] = t1[r]; } }
            float po[16];
#pragma unroll
            for (int i = 0; i < 16; ++i) { stt[i] = dec * stt[i] + kv * vv[i]; po[i] = qv * stt[i]; }
#pragma unroll
            for (int i = 0; i < 16; ++i) { po[i] += __shfl_xor(po[i], 8); po[i] += __shfl_xor(po[i], 16); po[i] += __shfl_xor(po[i], 32); }
            LAS float* rb = red + (t & 1) * 1024 + C.wave * 128;
            if (C.lane < 8) {
#pragma unroll
                for (int i = 0; i < 16; ++i) rb[C.lane * 16 + i] = po[i]; }
            __syncthreads();
            if (C.tid < 128) { float s = 0.f;
#pragma unroll
                for (int w = 0; w < 8; ++w) s += red[(t & 1) * 1024 + w * 128 + C.tid];
                obuf[(rowb + t) * 512 + h * 128 + C.tid] = s; } }
        __syncthreads();
        for (int t = C.wave; t < SEQ; t += NWAVES) { const float* orow = obuf + (rowb + t) * 512 + h * 128; const float o0 = orow[C.lane], o1 = orow[C.lane + 64];
            const float ss = wave_sum(o0 * o0 + o1 * o1); const float r = rsqrtf(ss * (1.f / 128.f) + EPS);
            const bf16_t* gp = proj + (rowb + t) * LDP + P_GG + h * 128; const float g0 = bf2f(gp[C.lane]), g1 = bf2f(gp[C.lane + 64]);
            const float n0 = a.gla_norm[l * 128 + C.lane], n1 = a.gla_norm[l * 128 + C.lane + 64];
            bf16_t* yo = ys + ((size_t)2 * M + rowb + t) * 512 + h * 128;
            yo[C.lane] = (bf16_t)f2bf(o0 * r * n0 * (g0 * sigmoidf_(g0))); yo[C.lane + 64] = (bf16_t)f2bf(o1 * r * n1 * (g1 * sigmoidf_(g1))); }
        __syncthreads(); }
}
__device__ __forceinline__ void naive_nsa(const Ctx& C, const bf16_t* proj, const bf16_t* kcvc, float* yf, bf16_t* ys) {
    LAS float* imp = (LAS float*)C.lds;
    for (int blk = C.bid; blk < NB * 2 * 4; blk += C.G) { const int bg = blk >> 2, b = bg >> 1, g = bg & 1; const int t = (blk & 3) * 512 + C.tid; const size_t rowb = (size_t)b * SEQ;
        const bf16_t* prow = proj + (rowb + t) * LDP;
#pragma unroll
        for (int j = 0; j < 32; ++j) imp[j * 512 + C.tid] = 0.f;
        const int ncv = (t >= 31) ? ((t - 31) / 16 + 1) : 0; const int tw = t | 63; const int ncv_w = (tw >= 31) ? ((tw - 31) / 16 + 1) : 0;
        const bf16_t* kc = kcvc + (((size_t)0 * NB + b) * 128 * 2 + g) * 64; const bf16_t* vc = kcvc + (((size_t)1 * NB + b) * 128 * 2 + g) * 64;
        for (int hp = 0; hp < 4; ++hp) { const int h = g * 4 + hp; float q[64]; ldq64(q, prow + P_NQ + h * 64, 0.125f);
            float m = -1e30f, lsum = 0.f;
            for (int c = 0; c < ncv_w; ++c) if (c < ncv) { const float sc = dot64(q, kc + (size_t)c * 128); const float mn = fmaxf(m, sc); lsum = lsum * __expf(m - mn) + __expf(sc - mn); m = mn; }
            float acc[64];
#pragma unroll
            for (int d = 0; d < 64; ++d) acc[d] = 0.f;
            const float il = (ncv > 0) ? 1.f / lsum : 0.f;
            for (int c = 0; c < ncv_w; ++c) if (c < ncv) { const float sc = dot64(q, kc + (size_t)c * 128); const float p = __expf(sc - m) * il; axpy64(acc, p, vc + (size_t)c * 128);
                const int j = c >> 2, r = c & 3;
                if (r < 3) imp[j * 512 + C.tid] += p; else { imp[j * 512 + C.tid] += 0.5f * p; imp[(j + 1) * 512 + C.tid] += 0.5f * p; } }
            const float gc = sigmoidf_(bf2f(prow[P_NG + h * 3 + 0])); float* yo = yf + (rowb + t) * 512 + h * 64;
#pragma unroll
            for (int d = 0; d < 64; ++d) yo[d] = gc * acc[d]; }
        const int jt = t >> 6;
#pragma unroll
        for (int j = 0; j < 32; ++j) { float v = imp[j * 512 + C.tid]; if (j == 0 || j == jt) v = __builtin_inff(); else if (64 * j > t) v = -__builtin_inff(); imp[j * 512 + C.tid] = v; }
        unsigned sel = 0u;
        for (int j = 0; j < 32; ++j) { const float vj = imp[j * 512 + C.tid]; int rank = 0;
            for (int j2 = 0; j2 < 32; ++j2) { const float v2 = imp[j2 * 512 + C.tid]; rank += (v2 > vj || (v2 == vj && j2 < j)) ? 1 : 0; }
            if (rank < 8) sel |= (1u << j); }
        const int twmin = t & ~63;
        for (int hp = 0; hp < 4; ++hp) { const int h = g * 4 + hp; float q[64]; ldq64(q, prow + P_NQ + h * 64, 0.125f);
            float* yo = yf + (rowb + t) * 512 + h * 64;
            { float acc[64];
#pragma unroll
              for (int d = 0; d < 64; ++d) acc[d] = 0.f;
              OS st; st.m = -1e30f; st.l = 0.f;
              for (int s = 0; s <= tw; ++s) { if (s <= t && ((sel >> (s >> 6)) & 1u)) { const bf16_t* krow = proj + (rowb + s) * LDP + P_KS + g * 64; const bf16_t* vrow = proj + (rowb + s) * LDP + P_VS + g * 64;
                    const float sc = dot64(q, krow); OS_STEP(sc); } }
              const float gs = sigmoidf_(bf2f(prow[P_NG + h * 3 + 1])) / st.l;
#pragma unroll
              for (int d = 0; d < 64; ++d) yo[d] += gs * acc[d]; }
            { float acc[64];
#pragma unroll
              for (int d = 0; d < 64; ++d) acc[d] = 0.f;
              OS st; st.m = -1e30f; st.l = 0.f; const int slo = (twmin - 255) > 0 ? (twmin - 255) : 0;
              for (int s = slo; s <= tw; ++s) { if (s <= t && s > t - 256) { const bf16_t* krow = proj + (rowb + s) * LDP + P_KW + g * 64; const bf16_t* vrow = proj + (rowb + s) * LDP + P_VW + g * 64;
                    const float sc = dot64(q, krow); OS_STEP(sc); } }
              const float gw = sigmoidf_(bf2f(prow[P_NG + h * 3 + 2])) / st.l; bf16_t* o = ys + ((size_t)0 * M + rowb + t) * 512 + h * 64;
#pragma unroll
              for (int d = 0; d < 64; d += 2) *(unsigned*)(o + d) = pk2(yo[d] + gw * acc[d], yo[d + 1] + gw * acc[d + 1]); } }
        __syncthreads(); }
}

namespace att {
typedef float f32x16 __attribute__((ext_vector_type(16)));
typedef short s16x4 __attribute__((ext_vector_type(4)));
constexpr float LOG2E = 1.4426950408889634f;
constexpr float CS = 0.125f * LOG2E;
constexpr int SLOT = 16384;
constexpr int L_RING = 0, L_WSF = 65536, L_OST = 67584, L_X = 100352;
#define RING_WAIT() do { asm volatile("s_waitcnt vmcnt(4) lgkmcnt(0)" ::: "memory"); __builtin_amdgcn_s_barrier(); asm volatile("" ::: "memory"); } while (0)
#define RING_DRAIN() do { asm volatile("s_waitcnt vmcnt(0) lgkmcnt(0)" ::: "memory"); __builtin_amdgcn_s_barrier(); asm volatile("" ::: "memory"); } while (0)
__device__ __forceinline__ int crow(int r, int hi) { return (r & 3) + 8 * (r >> 2) + 4 * hi; }
__device__ __forceinline__ unsigned cvtpk(float lo, float hi) { unsigned r; asm volatile("v_cvt_pk_bf16_f32 %0, %1, %2" : "=v"(r) : "v"(lo), "v"(hi)); return r; }
__device__ __forceinline__ float swap_half(float v) { return __shfl_xor(v, 32); }

__device__ __forceinline__ void dma_kv(LAS unsigned char* slot, const bf16_t* kbase, const bf16_t* vbase, int pitch, int wid, int lane) {
    const bf16_t* ks = kbase + (size_t)lane * pitch + wid * 8;
    const bf16_t* vs = vbase + (size_t)(16 * (wid & 3) + (lane >> 2)) * pitch + (wid >> 2) * 32 + (lane & 3) * 8;
    __builtin_amdgcn_global_load_lds((const unsigned*)ks, (LAS unsigned*)(slot + wid * 1024), 16, 0, 0);
    __builtin_amdgcn_global_load_lds((const unsigned*)vs, (LAS unsigned*)(slot + 8192 + wid * 1024), 16, 0, 0);
}
template <int NB = 8>
__device__ __forceinline__ void qkt(f32x16& p0, f32x16& p1, const LAS unsigned char* kslot, const bf16x8 (&qr)[4], int r32, int hi) {
    const LAS unsigned char* kb = kslot + hi * 1024 + r32 * 16;
    const f32x16 z = {0.f, 0.f, 0.f, 0.f, 0.f, 0.f, 0.f, 0.f, 0.f, 0.f, 0.f, 0.f, 0.f, 0.f, 0.f, 0.f};
    p0 = z; p1 = z;
#pragma unroll
    for (int g = 0; g < 8 / NB; ++g) {
        bf16x8 kf[NB];
#pragma unroll
        for (int j = 0; j < NB / 2; ++j) { const int d0 = g * (NB / 2) + j; kf[2 * j] = *(const LAS bf16x8*)(kb + d0 * 2048); kf[2 * j + 1] = *(const LAS bf16x8*)(kb + d0 * 2048 + 512); }
        __builtin_amdgcn_sched_barrier(0);
#pragma unroll
        for (int j = 0; j < NB / 2; ++j) { const int d0 = g * (NB / 2) + j;
            p0 = __builtin_amdgcn_mfma_f32_32x32x16_bf16(kf[2 * j], qr[d0], p0, 0, 0, 0);
            p1 = __builtin_amdgcn_mfma_f32_32x32x16_bf16(kf[2 * j + 1], qr[d0], p1, 0, 0, 0); }
    }
}
typedef short v4i16_t __attribute__((ext_vector_type(4)));
__device__ __forceinline__ s16x4 vtr(const LAS unsigned char* p) { return __builtin_bit_cast(s16x4, __builtin_amdgcn_ds_read_tr16_b64_v4i16((LAS v4i16_t*)p)); }
__device__ __forceinline__ bf16x8 vfrag(const LAS unsigned char* vslot, int dh, int ks, int lane) {
    const int hi = lane >> 5;
    const LAS unsigned char* p = vslot + dh * 4096 + ks * 1024 + ((lane >> 4) & 1) * 32 + (lane & 3) * 8 + (4 * hi + ((lane & 15) >> 2)) * 64;
    const s16x4 lo = vtr(p), hh = vtr(p + 512);
    return (bf16x8){lo[0], lo[1], lo[2], lo[3], hh[0], hh[1], hh[2], hh[3]};
}
__device__ __forceinline__ void pack_p(const f32x16& p0, const f32x16& p1, bf16x8 (&pa)[4]) {
    u32x4 w;
    w.x = cvtpk(p0[0], p0[1]); w.y = cvtpk(p0[2], p0[3]); w.z = cvtpk(p0[4], p0[5]); w.w = cvtpk(p0[6], p0[7]); pa[0] = __builtin_bit_cast(bf16x8, w);
    w.x = cvtpk(p0[8], p0[9]); w.y = cvtpk(p0[10], p0[11]); w.z = cvtpk(p0[12], p0[13]); w.w = cvtpk(p0[14], p0[15]); pa[1] = __builtin_bit_cast(bf16x8, w);
    w.x = cvtpk(p1[0], p1[1]); w.y = cvtpk(p1[2], p1[3]); w.z = cvtpk(p1[4], p1[5]); w.w = cvtpk(p1[6], p1[7]); pa[2] = __builtin_bit_cast(bf16x8, w);
    w.x = cvtpk(p1[8], p1[9]); w.y = cvtpk(p1[10], p1[11]); w.z = cvtpk(p1[12], p1[13]); w.w = cvtpk(p1[14], p1[15]); pa[3] = __builtin_bit_cast(bf16x8, w);
}
__device__ __forceinline__ void pv(f32x16 (&o)[2], const LAS unsigned char* vslot, const bf16x8 (&pa)[4], int lane) {
    const int hi = lane >> 5;
    const unsigned vb = (unsigned)(uintptr_t)vslot + ((lane >> 4) & 1) * 32 + (lane & 3) * 8 + (4 * hi + ((lane & 15) >> 2)) * 64;
#define PV_HALF(D0) do { s16x4 l0, l1, l2, l3, h0, h1, h2, h3; \
        asm volatile("ds_read_b64_tr_b16 %0, %8 offset:%c9\n\tds_read_b64_tr_b16 %4, %8 offset:%c10\n\tds_read_b64_tr_b16 %1, %8 offset:%c11\n\tds_read_b64_tr_b16 %5, %8 offset:%c12\n\t" \
                     "ds_read_b64_tr_b16 %2, %8 offset:%c13\n\tds_read_b64_tr_b16 %6, %8 offset:%c14\n\tds_read_b64_tr_b16 %3, %8 offset:%c15\n\tds_read_b64_tr_b16 %7, %8 offset:%c16\n\ts_waitcnt lgkmcnt(0)" \
                     : "=&v"(l0), "=&v"(l1), "=&v"(l2), "=&v"(l3), "=&v"(h0), "=&v"(h1), "=&v"(h2), "=&v"(h3) \
                     : "v"(vb), "i"((D0) * 4096), "i"((D0) * 4096 + 512), "i"((D0) * 4096 + 1024), "i"((D0) * 4096 + 1536), "i"((D0) * 4096 + 2048), "i"((D0) * 4096 + 2560), "i"((D0) * 4096 + 3072), "i"((D0) * 4096 + 3584) : "memory"); \
        __builtin_amdgcn_sched_barrier(0); \
        o[D0] = __builtin_amdgcn_mfma_f32_32x32x16_bf16(pa[0], ((bf16x8){l0[0], l0[1], l0[2], l0[3], h0[0], h0[1], h0[2], h0[3]}), o[D0], 0, 0, 0); \
        o[D0] = __builtin_amdgcn_mfma_f32_32x32x16_bf16(pa[1], ((bf16x8){l1[0], l1[1], l1[2], l1[3], h1[0], h1[1], h1[2], h1[3]}), o[D0], 0, 0, 0); \
        o[D0] = __builtin_amdgcn_mfma_f32_32x32x16_bf16(pa[2], ((bf16x8){l2[0], l2[1], l2[2], l2[3], h2[0], h2[1], h2[2], h2[3]}), o[D0], 0, 0, 0); \
        o[D0] = __builtin_amdgcn_mfma_f32_32x32x16_bf16(pa[3], ((bf16x8){l3[0], l3[1], l3[2], l3[3], h3[0], h3[1], h3[2], h3[3]}), o[D0], 0, 0, 0); } while (0)
    PV_HALF(0); PV_HALF(1);
#undef PV_HALF
}
__device__ __forceinline__ float rowmax32(const f32x16& p0, const f32x16& p1) {
    float a = fmaxf(p0[0], p1[0]);
#pragma unroll
    for (int r = 1; r < 16; ++r) a = fmaxf(a, fmaxf(p0[r], p1[r]));
    return fmaxf(a, swap_half(a));
}
__device__ __forceinline__ void scale_rows(f32x16 (&o)[2], float f, LAS float* wsf, int r32, int hi) {
    if (hi == 0) wsf[r32] = f;
    asm volatile("s_waitcnt lgkmcnt(0)" ::: "memory");
#pragma unroll
    for (int g4 = 0; g4 < 4; ++g4) { const f32x4 fv = *(const LAS f32x4*)(wsf + 8 * g4 + 4 * hi);
#pragma unroll
        for (int j = 0; j < 4; ++j) { o[0][4 * g4 + j] *= fv[j]; o[1][4 * g4 + j] *= fv[j]; } }
    asm volatile("s_waitcnt lgkmcnt(0)" ::: "memory");
}
template <bool RAW>
__device__ __forceinline__ void softmax_tile(f32x16& p0, f32x16& p1, float& m, float& l, f32x16 (&o)[2], LAS float* wsf, int r32, int hi, bool lane_ok = true) {
    const float sc = RAW ? CS : 1.0f;
    float mx = rowmax32(p0, p1); if (!lane_ok) mx = -__builtin_inff();
    const float mnew = fmaxf(m, mx);
    if (__any(mnew > m)) { const float al = __builtin_amdgcn_exp2f((m - mnew) * sc); l *= al; scale_rows(o, al, wsf, r32, hi); }
    m = mnew;
    const float nm = lane_ok ? -m * sc : -__builtin_inff(); float s = 0.f;
#pragma unroll
    for (int r = 0; r < 16; ++r) { p0[r] = __builtin_amdgcn_exp2f(__builtin_fmaf(p0[r], sc, nm)); p1[r] = __builtin_amdgcn_exp2f(__builtin_fmaf(p1[r], sc, nm)); s += p0[r] + p1[r]; }
    l += s;
}
__device__ __forceinline__ void store_o(const f32x16 (&o)[2], LAS unsigned char* ost_w, bf16_t* dst, int pitch, int lane) {
    const int r32 = lane & 31, hi = lane >> 5;
    LAS bf16_t* stg = (LAS bf16_t*)ost_w;
#pragma unroll
    for (int r = 0; r < 16; ++r) { const int orow = crow(r, hi);
#pragma unroll
        for (int d0 = 0; d0 < 2; ++d0) stg[orow * 64 + d0 * 32 + r32] = (bf16_t)f2bf(o[d0][r]); }
    asm volatile("s_waitcnt lgkmcnt(0)" ::: "memory");
#pragma unroll
    for (int i = 0; i < 4; ++i) { const int row = i * 8 + (lane >> 3), ch = lane & 7; const u32x4 v = *(const LAS u32x4*)(stg + row * 64 + ch * 8); *(u32x4*)(dst + (size_t)row * pitch + ch * 8) = v; }
    asm volatile("s_waitcnt lgkmcnt(0)" ::: "memory");
}
__device__ __forceinline__ void load_q(bf16x8 (&qr)[4], const bf16_t* qrow, int hi) {
#pragma unroll
    for (int d0 = 0; d0 < 4; ++d0) qr[d0] = *(const bf16x8*)(qrow + d0 * 16 + hi * 8);
}

__device__ __forceinline__ void foxprep_unit(const Ctx& C, int b, int h, const bf16_t* proj, float bfh, float* cum, float* knm) {
    LAS unsigned char* lds = C.lds; const int lane = C.lane, wid = C.wave, tid = C.tid;
    LAS float* wtot = (LAS float*)(lds + L_X); LAS float* tmax = (LAS float*)(lds + L_X + 64);
    const size_t rowb = (size_t)b * SEQ; const int bh = b * 8 + h;
    float c4[4]; float run = 0.f; float nmax = 0.f;
#pragma unroll
    for (int i = 0; i < 4; ++i) { const int s = 4 * tid + i; const bf16_t* pr = proj + (rowb + s) * LDP;
        run += logsigmoidf_(bf2f(pr[P_FF + h]) + bfh); c4[i] = run;
        float n2 = 0.f;
#pragma unroll
        for (int c = 0; c < 8; ++c) { float kv[8]; ld8(pr + P_FK + h * 64 + 8 * c, kv);
#pragma unroll
            for (int j = 0; j < 8; ++j) n2 += kv[j] * kv[j]; }
        nmax = fmaxf(nmax, n2); }
    float incl = run;
#pragma unroll
    for (int o = 1; o < 64; o <<= 1) { const float t = __shfl_up(incl, o); if (lane >= o) incl += t; }
    if (lane == 63) wtot[wid] = incl;
    nmax = fmaxf(nmax, __shfl_xor(nmax, 1)); nmax = fmaxf(nmax, __shfl_xor(nmax, 2)); nmax = fmaxf(nmax, __shfl_xor(nmax, 4)); nmax = fmaxf(nmax, __shfl_xor(nmax, 8));
    if ((tid & 15) == 0) tmax[tid >> 4] = sqrtf(nmax);
    __syncthreads();
    float off = incl - run;
#pragma unroll
    for (int w = 0; w < 8; ++w) off += (w < wid) ? wtot[w] : 0.f;
#pragma unroll
    for (int i = 0; i < 4; ++i) cum[(size_t)bh * SEQ + 4 * tid + i] = off + c4[i];
    if (tid == 0) { float pm = 0.f; for (int t = 0; t < 32; ++t) { pm = fmaxf(pm, tmax[t]); knm[bh * 32 + t] = pm; } }
    __syncthreads();
}
template <int ABL>
__device__ __forceinline__ void fox_unit(const Ctx& C, int b, int h, int qb, const bf16_t* proj, const float* cum, const float* knm, bf16_t* ys) {
    LAS unsigned char* lds = C.lds; const int lane = C.lane, wid = C.wave, r32 = lane & 31, hi = lane >> 5, tid = C.tid;
    LAS float* cumL = (LAS float*)(lds + L_X);
    LAS float* pmL = (LAS float*)(lds + L_X + 8192);
    LAS unsigned* votes = (LAS unsigned*)(lds + L_X + 8192 + 128);
    LAS float* wsf = (LAS float*)(lds + L_WSF) + wid * 64;
    const size_t rowb = (size_t)b * SEQ; const int Q0 = qb * 256, NT = 4 * qb + 4, bh = b * 8 + h;
    const bf16_t* kb = proj + rowb * LDP + P_FK + h * 64; const bf16_t* vb = proj + rowb * LDP + P_FV + h * 64;
#define FOX_DMA(i_) do { const int tt_ = (NT - 1 - (i_)) > 0 ? (NT - 1 - (i_)) : 0; dma_kv(lds + L_RING + ((i_) & 3) * SLOT, kb + (size_t)tt_ * 64 * LDP, vb + (size_t)tt_ * 64 * LDP, LDP, wid, lane); } while (0)
    const float cref = cum[(size_t)bh * SEQ + Q0];
    { const f32x4 c4 = *(const f32x4*)(cum + (size_t)bh * SEQ + 4 * tid); f32x4 o4;
#pragma unroll
      for (int i = 0; i < 4; ++i) o4[i] = (cref - c4[i]) * LOG2E;
      *(LAS f32x4*)(cumL + 4 * tid) = o4; }
    if (tid < 32) pmL[tid] = knm[bh * 32 + tid];
    bf16x8 qr[4]; load_q(qr, proj + (rowb + Q0 + 32 * wid + r32) * LDP + P_FQ + h * 64, hi);
    float qn = 0.f;
#pragma unroll
    for (int d0 = 0; d0 < 4; ++d0)
#pragma unroll
        for (int j = 0; j < 8; ++j) { const float v = bf2f((unsigned short)qr[d0][j]); qn += v * v; }
    qn += swap_half(qn); const float qs = sqrtf(qn) * CS;
    f32x16 o[2];
#pragma unroll
    for (int r = 0; r < 16; ++r) { o[0][r] = 0.f; o[1][r] = 0.f; }
    float m = -1e30f, l = 0.f; bool done = false; const int my_last = 4 * qb + (wid >> 1); const int qidx = Q0 + 32 * wid + r32;
    __syncthreads();
    FOX_DMA(0); FOX_DMA(1); FOX_DMA(2);
    for (int it = 0; it < NT; ++it) {
        const int t = NT - 1 - it;
        RING_WAIT();
        if (it > 0) { unsigned all = 1u;
#pragma unroll
            for (int w = 0; w < 8; ++w) all &= votes[((it - 1) & 1) * 8 + w];
            if (all) break; }
        FOX_DMA(it + 3);
        LAS unsigned char* slot = lds + L_RING + (it & 3) * SLOT;
        if (t <= my_last && !done) {
            f32x16 p0, p1; qkt(p0, p1, slot, qr, r32, hi);
#pragma unroll
            for (int g4 = 0; g4 < 4; ++g4) { const f32x4 b0 = *(const LAS f32x4*)(cumL + 64 * t + 8 * g4 + 4 * hi), b1 = *(const LAS f32x4*)(cumL + 64 * t + 32 + 8 * g4 + 4 * hi);
#pragma unroll
                for (int j = 0; j < 4; ++j) { p0[4 * g4 + j] = __builtin_fmaf(p0[4 * g4 + j], CS, b0[j]); p1[4 * g4 + j] = __builtin_fmaf(p1[4 * g4 + j], CS, b1[j]); } }
            if (t == my_last) {
#pragma unroll
                for (int r = 0; r < 16; ++r) { const int kv = 64 * t + crow(r, hi); if (kv > qidx) p0[r] = -__builtin_inff(); if (kv + 32 > qidx) p1[r] = -__builtin_inff(); } }
            softmax_tile<false>(p0, p1, m, l, o, wsf, r32, hi);
            bf16x8 pa[4]; pack_p(p0, p1, pa);
            pv(o, slot + 8192, pa, lane);
            if (t > 0) { const float bound = qs * pmL[t - 1] + cumL[64 * t - 1]; done = __all(bound < m - 40.0f); }
        }
        if (lane == 0) votes[(it & 1) * 8 + wid] = (done || t == 0) ? 1u : 0u;
    }
    RING_DRAIN();
#undef FOX_DMA
    l += swap_half(l);
    scale_rows(o, 1.0f / l, wsf, r32, hi);
    store_o(o, lds + L_OST + wid * 4096, ys + ((size_t)3 * M + rowb + Q0 + 32 * wid) * 512 + h * 64, 512, lane);
    __syncthreads();
}

__device__ __forceinline__ void sb_unit(const Ctx& C, int b, int h, int qb, const bf16_t* proj, bf16_t* ys) {
    LAS unsigned char* lds = C.lds; const int lane = C.lane, wid = C.wave, r32 = lane & 31, hi = lane >> 5;
    LAS unsigned* votes = (LAS unsigned*)(lds + L_X);
    const size_t rowb = (size_t)b * SEQ; const int Q0 = qb * 256, NT = 4 * qb + 4;
    const bf16_t* kb = proj + rowb * LDP + P_SK + h * 64; const bf16_t* vb = proj + rowb * LDP + P_SV + h * 64;
#define SB_DMA(i_) do { const int tt_ = (NT - 1 - (i_)) > 0 ? (NT - 1 - (i_)) : 0; dma_kv(lds + L_RING + ((i_) & 3) * SLOT, kb + (size_t)tt_ * 64 * LDP, vb + (size_t)tt_ * 64 * LDP, LDP, wid, lane); } while (0)
    bf16x8 qr[4]; load_q(qr, proj + (rowb + Q0 + 32 * wid + r32) * LDP + P_SQ + h * 64, hi);
    bf16x8 ua[2], ones;
#pragma unroll
    for (int s = 0; s < 2; ++s)
#pragma unroll
        for (int e = 0; e < 8; ++e) ua[s][e] = ((16 * s + 8 * (e >> 2) + 4 * hi + (e & 3)) >= r32) ? (short)0x3F80 : (short)0;
#pragma unroll
    for (int e = 0; e < 8; ++e) ones[e] = (short)0x3F80;
    f32x16 o[2];
#pragma unroll
    for (int r = 0; r < 16; ++r) { o[0][r] = 0.f; o[1][r] = 0.f; }
    float R2 = 0.f; bool done = false; const int my_first = 4 * qb + (wid >> 1); const int qidx = Q0 + 32 * wid + r32;
    __syncthreads();
    SB_DMA(0); SB_DMA(1); SB_DMA(2);
    for (int it = 0; it < NT; ++it) {
        const int t = NT - 1 - it;
        RING_WAIT();
        if (it > 0) { unsigned all = 1u;
#pragma unroll
            for (int w = 0; w < 8; ++w) all &= votes[((it - 1) & 1) * 8 + w];
            if (all) break; }
        SB_DMA(it + 3);
        LAS unsigned char* slot = lds + L_RING + (it & 3) * SLOT;
        if (t <= my_first && !done) {
            f32x16 z0, z1; qkt(z0, z1, slot, qr, r32, hi);
            f32x16 sp0, sp1;
#pragma unroll
            for (int r = 0; r < 16; ++r) { z0[r] *= CS; z1[r] *= CS;
                sp0[r] = __builtin_amdgcn_logf(1.0f + __builtin_amdgcn_exp2f(fminf(z0[r], 100.f))); sp1[r] = __builtin_amdgcn_logf(1.0f + __builtin_amdgcn_exp2f(fminf(z1[r], 100.f))); }
            if (t == my_first) {
#pragma unroll
                for (int r = 0; r < 16; ++r) { const int kv = 64 * t + crow(r, hi); if (kv >= qidx) { sp0[r] = 0.f; z0[r] = -__builtin_inff(); } if (kv + 32 >= qidx) { sp1[r] = 0.f; z1[r] = -__builtin_inff(); } } }
            bf16x8 spa[4]; pack_p(sp0, sp1, spa);
            f32x16 S0, S1;
#pragma unroll
            for (int r = 0; r < 16; ++r) { S0[r] = R2; S1[r] = R2; }
            S0 = __builtin_amdgcn_mfma_f32_32x32x16_bf16(ua[0], spa[0], S0, 0, 0, 0); S0 = __builtin_amdgcn_mfma_f32_32x32x16_bf16(ua[1], spa[1], S0, 0, 0, 0);
            S0 = __builtin_amdgcn_mfma_f32_32x32x16_bf16(ones, spa[2], S0, 0, 0, 0); S0 = __builtin_amdgcn_mfma_f32_32x32x16_bf16(ones, spa[3], S0, 0, 0, 0);
            S1 = __builtin_amdgcn_mfma_f32_32x32x16_bf16(ua[0], spa[2], S1, 0, 0, 0); S1 = __builtin_amdgcn_mfma_f32_32x32x16_bf16(ua[1], spa[3], S1, 0, 0, 0);
            f32x16 a0, a1;
#pragma unroll
            for (int r = 0; r < 16; ++r) { a0[r] = __builtin_amdgcn_exp2f(z0[r] - S0[r]); a1[r] = __builtin_amdgcn_exp2f(z1[r] - S1[r]); }
            bf16x8 pa[4]; pack_p(a0, a1, pa);
            pv(o, slot + 8192, pa, lane);
            R2 = __shfl(S0[0], r32);
            done = __all(R2 > 126.0f);
        }
        if (lane == 0) votes[(it & 1) * 8 + wid] = done ? 1u : 0u;
    }
    RING_DRAIN();
#undef SB_DMA
    store_o(o, lds + L_OST + wid * 4096, ys + ((size_t)1 * M + rowb + Q0 + 32 * wid) * 512 + h * 64, 512, lane);
    __syncthreads();
}
}
namespace gla {
using att::f32x16; using att::crow; using att::cvtpk; using att::vfrag;
constexpr int G_LA = 0;
constexpr int G_SEG = 16640;
constexpr int G_WA = 18688;
constexpr int G_QP = 22784;
constexpr int G_KP = 30976;
constexpr int G_KPP = 39168;
constexpr int G_V = 47360;
__device__ __forceinline__ void prep_unit(const Ctx& C, const Args& a, int l, int b, int h, int c, const bf16_t* proj, bf16_t* gqp, float* gdec, float* gds, float* goi) {
    LAS unsigned char* lds = C.lds; const int tid = C.tid, lane = C.lane, wid = C.wave, r32 = lane & 31, hi = lane >> 5;
    LAS float* LA = (LAS float*)(lds + G_LA); LAS float* SEG = (LAS float*)(lds + G_SEG); LAS float* WA = (LAS float*)(lds + G_WA);
    const size_t rowb = (size_t)b * SEQ; const int T0 = 64 * c; const int unit = (b * 4 + h) * 32 + c;
    for (int i = tid; i < 1024; i += NTHR) WA[i] = a.gla_w_alpha[(size_t)l * 16 * 256 + (i >> 6) * 256 + h * 64 + (i & 63)];
    __syncthreads();
    {
        const int t = tid >> 3, k0 = (tid & 7) * 8; const bf16_t* pr = proj + (rowb + T0 + t) * LDP;
        float al[16]; { float t0[8], t1[8]; ld8(pr + P_GA, t0); ld8(pr + P_GA + 8, t1);
#pragma unroll
            for (int r = 0; r < 8; ++r) { al[r] = t0[r]; al[8 + r] = t1[r]; } }
#pragma unroll
        for (int i = 0; i < 8; ++i) { float x = a.gla_b_alpha[l * 256 + h * 64 + k0 + i];
#pragma unroll
            for (int r = 0; r < 16; ++r) x += al[r] * WA[r * 64 + k0 + i];
            LA[t * 65 + k0 + i] = logsigmoidf_(x) * (1.0f / 16.0f); }
    }
    __syncthreads();
    {
        const int k = tid & 63, seg = tid >> 6; float v[8]; float run = 0.f;
#pragma unroll
        for (int i = 0; i < 8; ++i) { run += LA[(8 * seg + i) * 65 + k]; v[i] = run; }
        SEG[seg * 64 + k] = run;
        __syncthreads();
        float off = 0.f;
#pragma unroll
        for (int s = 0; s < 8; ++s) off += (s < seg) ? SEG[s * 64 + k] : 0.f;
#pragma unroll
        for (int i = 0; i < 8; ++i) LA[(8 * seg + i) * 65 + k] = v[i] + off;
    }
    __syncthreads();
    {
        const int t = tid >> 3, ks = tid & 7, k0 = ks * 8; const bf16_t* pr = proj + (rowb + T0 + t) * LDP;
        float qv[8], kv[8]; ld8(pr + P_GQ + h * 64 + k0, qv); ld8(pr + P_GK + h * 64 + k0, kv);
        float qp[8], kp[8], kpp[8];
#pragma unroll
        for (int i = 0; i < 8; ++i) { const float bb = LA[t * 65 + k0 + i], bl = LA[63 * 65 + k0 + i]; qp[i] = qv[i] * 0.125f * __expf(bb); kp[i] = kv[i] * __expf(-bb); kpp[i] = kv[i] * __expf(bl - bb);
            if (t == 63) gdec[(size_t)unit * 64 + k0 + i] = __expf(bl); }
        u32x4 w; w.x = pk2(qp[0], qp[1]); w.y = pk2(qp[2], qp[3]); w.z = pk2(qp[4], qp[5]); w.w = pk2(qp[6], qp[7]);
        *(LAS u32x4*)(lds + G_QP + ks * 1024 + t * 16) = w; *(u32x4*)(gqp + (rowb + T0 + t) * 256 + h * 64 + k0) = w;
        w.x = pk2(kp[0], kp[1]); w.y = pk2(kp[2], kp[3]); w.z = pk2(kp[4], kp[5]); w.w = pk2(kp[6], kp[7]);
        *(LAS u32x4*)(lds + G_KP + ks * 1024 + t * 16) = w;
        w.x = pk2(kpp[0], kpp[1]); w.y = pk2(kpp[2], kpp[3]); w.z = pk2(kpp[4], kpp[5]); w.w = pk2(kpp[6], kpp[7]);
        *(LAS u32x4*)(lds + G_KPP + (ks >> 2) * 4096 + t * 64 + (ks & 3) * 16) = w;
        const int vs = tid & 7; const u32x4 v0 = *(const u32x4*)(pr + P_GV + h * 128 + vs * 16), v1 = *(const u32x4*)(pr + P_GV + h * 128 + vs * 16 + 8);
        const int vbk = vs >> 1; LAS unsigned char* vp = lds + G_V + (vbk >> 1) * 8192 + (vbk & 1) * 4096 + t * 64 + (vs & 1) * 32;
        *(LAS u32x4*)vp = v0; *(LAS u32x4*)(vp + 16) = v1;
    }
    __syncthreads();
    {
        const int tb = wid & 1, vb = wid >> 1;
        bf16x8 qf[4];
#pragma unroll
        for (int d0 = 0; d0 < 4; ++d0) qf[d0] = *(const LAS bf16x8*)(lds + G_QP + (2 * d0 + hi) * 1024 + (32 * tb + r32) * 16);
        f32x16 o;
#pragma unroll
        for (int r = 0; r < 16; ++r) o[r] = 0.f;
        for (int sb = 0; sb <= tb; ++sb) {
            f32x16 s;
#pragma unroll
            for (int r = 0; r < 16; ++r) s[r] = 0.f;
#pragma unroll
            for (int d0 = 0; d0 < 4; ++d0) { const bf16x8 kf = *(const LAS bf16x8*)(lds + G_KP + (2 * d0 + hi) * 1024 + (32 * sb + r32) * 16); s = __builtin_amdgcn_mfma_f32_32x32x16_bf16(kf, qf[d0], s, 0, 0, 0); }
            if (sb == tb) {
#pragma unroll
                for (int r = 0; r < 16; ++r) if (crow(r, hi) > r32) s[r] = 0.f; }
            u32x4 w; bf16x8 pa0, pa1;
            w.x = cvtpk(s[0], s[1]); w.y = cvtpk(s[2], s[3]); w.z = cvtpk(s[4], s[5]); w.w = cvtpk(s[6], s[7]); pa0 = __builtin_bit_cast(bf16x8, w);
            w.x = cvtpk(s[8], s[9]); w.y = cvtpk(s[10], s[11]); w.z = cvtpk(s[12], s[13]); w.w = cvtpk(s[14], s[15]); pa1 = __builtin_bit_cast(bf16x8, w);
            const LAS unsigned char* vimg = lds + G_V + (vb >> 1) * 8192;
            o = __builtin_amdgcn_mfma_f32_32x32x16_bf16(pa0, vfrag(vimg, vb & 1, 2 * sb, lane), o, 0, 0, 0);
            o = __builtin_amdgcn_mfma_f32_32x32x16_bf16(pa1, vfrag(vimg, vb & 1, 2 * sb + 1, lane), o, 0, 0, 0);
        }
        float* op = goi + (rowb + T0 + 32 * tb) * 512 + h * 128 + vb * 32 + r32;
#pragma unroll
        for (int r = 0; r < 16; ++r) op[(size_t)crow(r, hi) * 512] = o[r];
        const int kb = wid & 1; f32x16 d;
#pragma unroll
        for (int r = 0; r < 16; ++r) d[r] = 0.f;
        const LAS unsigned char* vimg = lds + G_V + (vb >> 1) * 8192;
#pragma unroll
        for (int ks = 0; ks < 4; ++ks) d = __builtin_amdgcn_mfma_f32_32x32x16_bf16(vfrag(vimg, vb & 1, ks, lane), vfrag(lds + G_KPP, kb, ks, lane), d, 0, 0, 0);
        float* dp = gds + (size_t)unit * 8192 + (size_t)(32 * vb) * 64 + 32 * kb + r32;
#pragma unroll
        for (int r = 0; r < 16; ++r) dp[crow(r, hi) * 64] = d[r];
    }
    __syncthreads();
}

__device__ __forceinline__ void scan_unit(const Ctx& C, int b, int h, int e, const float* gdec, const float* gds, bf16_t* sall) {
    const int tid = C.tid; const int v = 16 * e + (tid >> 5), k2 = (tid & 31) * 2; const int bh = b * 4 + h;
    f32x2 ds[32], dc[32];
#pragma unroll
    for (int c = 0; c < 32; ++c) { const size_t unit = (size_t)bh * 32 + c; ds[c] = *(const f32x2*)(gds + unit * 8192 + v * 64 + k2); dc[c] = *(const f32x2*)(gdec + unit * 64 + k2); }
    float s0 = 0.f, s1 = 0.f;
#pragma unroll
    for (int c = 0; c < 32; ++c) { const size_t unit = (size_t)bh * 32 + c; *(unsigned*)(sall + (unit * 128 + v) * 64 + k2) = pk2(s0, s1); s0 = dc[c].x * s0 + ds[c].x; s1 = dc[c].y * s1 + ds[c].y; }
}
__device__ __forceinline__ void out_unit(const Ctx& C, const Args& a, int l, int b, int h, int cg, const bf16_t* proj, const bf16_t* gqp, const bf16_t* sall, const float* goi, bf16_t* ys) {
    const int lane = C.lane, wid = C.wave, r32 = lane & 31, hi = lane >> 5;
    const int c = 4 * cg + (wid >> 1), tb = wid & 1; const size_t unit = (size_t)(b * 4 + h) * 32 + c; const size_t tok = (size_t)b * SEQ + 64 * c + 32 * tb + r32;
    bf16x8 qf[4];
#pragma unroll
    for (int s = 0; s < 4; ++s) qf[s] = *(const bf16x8*)(gqp + tok * 256 + h * 64 + 16 * s + 8 * hi);
    f32x16 acc[4];
#pragma unroll
    for (int vb = 0; vb < 4; ++vb) {
#pragma unroll
        for (int g4 = 0; g4 < 4; ++g4) { const f32x4 o4 = *(const f32x4*)(goi + tok * 512 + h * 128 + 32 * vb + 8 * g4 + 4 * hi);
#pragma unroll
            for (int j = 0; j < 4; ++j) acc[vb][4 * g4 + j] = o4[j]; }
#pragma unroll
        for (int s = 0; s < 4; ++s) { const bf16x8 af = *(const bf16x8*)(sall + (unit * 128 + 32 * vb + r32) * 64 + 16 * s + 8 * hi); acc[vb] = __builtin_amdgcn_mfma_f32_32x32x16_bf16(af, qf[s], acc[vb], 0, 0, 0); }
    }
    float ssq = 0.f;
#pragma unroll
    for (int vb = 0; vb < 4; ++vb)
#pragma unroll
        for (int r = 0; r < 16; ++r) ssq += acc[vb][r] * acc[vb][r];
    ssq += att::swap_half(ssq);
    const float rstd = rsqrtf(ssq * (1.0f / 128.0f) + EPS);
#pragma unroll
    for (int vb = 0; vb < 4; ++vb) { bf16_t* yo = ys + ((size_t)2 * M + tok) * 512 + h * 128 + 32 * vb + 4 * hi;
#pragma unroll
        for (int g4 = 0; g4 < 4; ++g4) { const u32x2 gt = *(const u32x2*)(proj + tok * LDP + P_GG + h * 128 + 32 * vb + 8 * g4 + 4 * hi); const f32x4 ng = *(const f32x4*)(a.gla_norm + l * 128 + 32 * vb + 8 * g4 + 4 * hi);
            const float g0 = bflo(gt.x), g1 = bfhi(gt.x), g2 = bflo(gt.y), g3 = bfhi(gt.y);
            u32x2 w; w.x = cvtpk(acc[vb][4 * g4] * rstd * ng[0] * g0 * sigmoidf_(g0), acc[vb][4 * g4 + 1] * rstd * ng[1] * g1 * sigmoidf_(g1));
            w.y = cvtpk(acc[vb][4 * g4 + 2] * rstd * ng[2] * g2 * sigmoidf_(g2), acc[vb][4 * g4 + 3] * rstd * ng[3] * g3 * sigmoidf_(g3));
            *(u32x2*)(yo + 8 * g4) = w; } }
}
}
namespace nsa {
using namespace att;
constexpr int N_GT = 67584, N_SELW = 70656, N_LIST = 70656 + 256, N_IMPS = 71168, N_IMPM = 79616, N_OST = N_IMPM;
__device__ __forceinline__ void nsa_unit(const Ctx& C, int b, int g, int qt, const bf16_t* proj, const bf16_t* kcvc, bf16_t* ys) {
    LAS unsigned char* lds = C.lds; const int tid = C.tid, lane = C.lane, wid = C.wave, r32 = lane & 31, hi = lane >> 5;
    const int hp = wid & 3, qs = wid >> 2, h = 4 * g + hp; const size_t rowb = (size_t)b * SEQ; const int T0 = 64 * qt, jd = qt;
    const int qidx = 32 * qs + r32, qtok = T0 + qidx;
    LAS float* wsf = (LAS float*)(lds + L_WSF) + wid * 64; LAS float* GT = (LAS float*)(lds + N_GT) + wid * 96;
    LAS unsigned* SELW = (LAS unsigned*)(lds + N_SELW); LAS unsigned* LIST = (LAS unsigned*)(lds + N_LIST);
    LAS float* IMPS = (LAS float*)(lds + N_IMPS); LAS float* IMPM = (LAS float*)(lds + N_IMPM) + wid * 1056;
    const bf16_t* kc = kcvc + (((size_t)0 * NB + b) * 128 * 2 + g) * 64; const bf16_t* vc = kcvc + (((size_t)1 * NB + b) * 128 * 2 + g) * 64;
    const int ncmax = (T0 + 63 >= 31) ? ((T0 + 63 - 31) / 16 + 1) : 0;
    const int nct = (ncmax + 63) >> 6;
    if (nct > 0) dma_kv(lds + L_RING, kc, vc, 128, wid, lane);
    if (nct > 1) dma_kv(lds + L_RING + SLOT, kc + 64 * 128, vc + 64 * 128, 128, wid, lane);
    const bf16_t* prow = proj + (rowb + qtok) * LDP;
    bf16x8 qr[4]; load_q(qr, prow + P_NQ + h * 64, hi);
    if (hi == 0) {
#pragma unroll
        for (int i = 0; i < 3; ++i) GT[i * 32 + r32] = sigmoidf_(bf2f(prow[P_NG + h * 3 + i])); }
    asm volatile("s_waitcnt vmcnt(0)" ::: "memory");
    __syncthreads();
    f32x16 yacc[2];
#pragma unroll
    for (int r = 0; r < 16; ++r) { yacc[0][r] = 0.f; yacc[1][r] = 0.f; }
    {
        const int ncv = (qtok >= 31) ? ((qtok - 31) / 16 + 1) : 0;
        f32x16 p[4];
#pragma unroll
        for (int i = 0; i < 4; ++i)
#pragma unroll
            for (int r = 0; r < 16; ++r) p[i][r] = -__builtin_inff();
        if (nct > 0) qkt<4>(p[0], p[1], lds + L_RING, qr, r32, hi);
        if (nct > 1) qkt<4>(p[2], p[3], lds + L_RING + SLOT, qr, r32, hi);
#pragma unroll
        for (int i = 0; i < 4; ++i)
#pragma unroll
            for (int r = 0; r < 16; ++r) if (32 * i + crow(r, hi) >= ncv) p[i][r] = -__builtin_inff();
        float mx = fmaxf(rowmax32(p[0], p[1]), rowmax32(p[2], p[3]));
        const float msafe = (mx == -__builtin_inff()) ? 0.f : mx; const float nm = -msafe * CS; float s = 0.f;
#pragma unroll
        for (int i = 0; i < 4; ++i)
#pragma unroll
            for (int r = 0; r < 16; ++r) { p[i][r] = __builtin_amdgcn_exp2f(__builtin_fmaf(p[i][r], CS, nm)); s += p[i][r]; }
        s += swap_half(s);
        const float il = (s > 0.f) ? 1.0f / s : 0.f;
#pragma unroll
        for (int i = 0; i < 4; ++i)
#pragma unroll
            for (int r = 0; r < 16; ++r) p[i][r] *= il;
        float prevc = 0.f;
#pragma unroll
        for (int i = 0; i < 4; ++i)
#pragma unroll
            for (int g4 = 0; g4 < 4; ++g4) { const int j = 8 * i + 2 * g4 + hi; const float c3 = 0.5f * p[i][4 * g4 + 3]; const float pc = swap_half(c3);
                IMPM[r32 * 33 + j] = p[i][4 * g4] + p[i][4 * g4 + 1] + p[i][4 * g4 + 2] + c3 + (hi ? pc : prevc); prevc = pc; }
        f32x16 oc[2];
#pragma unroll
        for (int r = 0; r < 16; ++r) { oc[0][r] = 0.f; oc[1][r] = 0.f; }
        bf16x8 pa[4];
        if (nct > 0) { pack_p(p[0], p[1], pa); pv(oc, lds + L_RING + 8192, pa, lane); }
        if (nct > 1) { pack_p(p[2], p[3], pa); pv(oc, lds + L_RING + SLOT + 8192, pa, lane); }
#pragma unroll
        for (int g4 = 0; g4 < 4; ++g4) { const f32x4 gv = *(const LAS f32x4*)(GT + 0 * 32 + 8 * g4 + 4 * hi);
#pragma unroll
            for (int j = 0; j < 4; ++j) { yacc[0][4 * g4 + j] = oc[0][4 * g4 + j] * gv[j]; yacc[1][4 * g4 + j] = oc[1][4 * g4 + j] * gv[j]; } }
    }
    __syncthreads();
    {
        const int q = tid >> 3, part = tid & 7, qsq = q >> 5, rq = q & 31, t = T0 + q;
#pragma unroll
        for (int jj = 0; jj < 4; ++jj) { const int j = 4 * part + jj; float v = 0.f;
#pragma unroll
            for (int hh = 0; hh < 4; ++hh) { const LAS float* pm = (const LAS float*)(lds + N_IMPM) + (qsq * 4 + hh) * 1056 + rq * 33; v += pm[j]; }
            if (j == 0 || j == (t >> 6)) v = __builtin_inff(); else if (64 * j > t) v = -__builtin_inff();
            IMPS[q * 33 + j] = v; }
        __syncthreads();
        unsigned bits = 0u;
#pragma unroll
        for (int jj = 0; jj < 4; ++jj) { const int j = 4 * part + jj; const float vj = IMPS[q * 33 + j]; int rank = 0;
#pragma unroll 8
            for (int j2 = 0; j2 < 32; ++j2) { const float v2 = IMPS[q * 33 + j2]; rank += (v2 > vj || (v2 == vj && j2 < j)) ? 1 : 0; }
            if (rank < 8) bits |= 1u << j; }
        bits |= __shfl_xor(bits, 1); bits |= __shfl_xor(bits, 2); bits |= __shfl_xor(bits, 4);
        if (part == 0) SELW[q] = bits;
        __syncthreads();
        if (wid == 0) {
            unsigned un = SELW[lane];
#pragma unroll
            for (int o = 1; o < 64; o <<= 1) un |= __shfl_xor(un, o);
            if (lane == 0) { int n = 0; for (int j = 0; j <= jd; ++j) if ((un >> j) & 1u) LIST[1 + n++] = (unsigned)j;
                for (int j = (jd - 4 > 0 ? jd - 4 : 0); j <= jd; ++j) LIST[1 + n++] = 0x100u | (unsigned)j;
                LIST[0] = (unsigned)n; }
        }
        __syncthreads();
    }
    {
        const int n = (int)LIST[0]; const unsigned selq = SELW[qidx];
        const bf16_t* ksb = proj + rowb * LDP + P_KS + g * 64; const bf16_t* vsb = proj + rowb * LDP + P_VS + g * 64;
        const bf16_t* kwb = proj + rowb * LDP + P_KW + g * 64; const bf16_t* vwb = proj + rowb * LDP + P_VW + g * 64;
        f32x16 o[2];
#pragma unroll
        for (int r = 0; r < 16; ++r) { o[0][r] = 0.f; o[1][r] = 0.f; }
        float m = -1e30f, l = 0.f; int mode = 0;
        { const unsigned e0 = LIST[1]; const int j0 = e0 & 0xff; const bool w0 = (e0 >> 8) != 0; dma_kv(lds + L_RING, (w0 ? kwb : ksb) + (size_t)j0 * 64 * LDP, (w0 ? vwb : vsb) + (size_t)j0 * 64 * LDP, LDP, wid, lane); }
        asm volatile("s_waitcnt vmcnt(0)" ::: "memory");
        __syncthreads();
        for (int i = 0; i < n; ++i) {
            const unsigned e = LIST[1 + i]; const int j = e & 0xff; const int md = e >> 8;
            LAS unsigned char* slot = lds + L_RING + (i & 1) * SLOT;
            if (i + 1 < n) { const unsigned e1 = LIST[2 + i]; const int j1 = e1 & 0xff; const bool w1 = (e1 >> 8) != 0;
                dma_kv(lds + L_RING + ((i + 1) & 1) * SLOT, (w1 ? kwb : ksb) + (size_t)j1 * 64 * LDP, (w1 ? vwb : vsb) + (size_t)j1 * 64 * LDP, LDP, wid, lane); }
            if (md != mode) {
                l += swap_half(l);
                const float f = GT[1 * 32 + r32] / l;
                scale_rows(o, f, wsf, r32, hi);
#pragma unroll
                for (int r = 0; r < 16; ++r) { yacc[0][r] += o[0][r]; yacc[1][r] += o[1][r]; o[0][r] = 0.f; o[1][r] = 0.f; }
                m = -1e30f; l = 0.f; mode = md;
            }
            const bool allowed = (md != 0) || (((selq >> j) & 1u) != 0u);
            if (__any(allowed)) {
                f32x16 p0, p1; qkt<4>(p0, p1, slot, qr, r32, hi);
                const bool diag = (j == jd), first = (md != 0) && (j == jd - 4);
                if (diag) {
#pragma unroll
                    for (int r = 0; r < 16; ++r) { const int k0 = crow(r, hi); if (k0 > qidx) p0[r] = -__builtin_inff(); if (k0 + 32 > qidx) p1[r] = -__builtin_inff(); } }
                if (first) {
#pragma unroll
                    for (int r = 0; r < 16; ++r) { const int k0 = crow(r, hi); if (k0 <= qidx) p0[r] = -__builtin_inff(); if (k0 + 32 <= qidx) p1[r] = -__builtin_inff(); } }
                softmax_tile<true>(p0, p1, m, l, o, wsf, r32, hi, allowed);
                bf16x8 pa[4]; pack_p(p0, p1, pa);
                pv(o, slot + 8192, pa, lane);
            }
            asm volatile("s_waitcnt vmcnt(0)" ::: "memory");
            __syncthreads();
        }
        l += swap_half(l);
        const float f = GT[2 * 32 + r32] / l;
        scale_rows(o, f, wsf, r32, hi);
#pragma unroll
        for (int r = 0; r < 16; ++r) { yacc[0][r] += o[0][r]; yacc[1][r] += o[1][r]; }
    }
    store_o(yacc, lds + N_OST + wid * 4096, ys + ((size_t)0 * M + rowb + T0 + 32 * qs) * 512 + h * 64, 512, lane);
    __syncthreads();
}
}
namespace cmpx {
using att::f32x16; using att::crow;
constexpr int C_HID = 0;
__device__ __forceinline__ void cmp_unit(const Ctx& C, const Args& a, int kv, int b, int g, int chalf, const bf16_t* proj, const bf16_t* w1t, const bf16_t* w2t, const float* bias1, bf16_t* kcvc) {
    LAS unsigned char* lds = C.lds; const int lane = C.lane, wid = C.wave, r32 = lane & 31, hi = lane >> 5;
    const size_t rowb = (size_t)b * SEQ;
    {
        const int mb = wid & 1, nb = wid >> 1; const int c = 64 * chalf + 32 * mb + r32, cl = c < 126 ? c : 126;
        const bf16_t* ap = proj + (rowb + 16 * cl) * LDP + (kv ? P_VC : P_KC) + g * 64 + 8 * hi;
        const bf16_t* b0p = w1t + (size_t)kv * 256 * 2048 + (size_t)(64 * nb + r32) * 2048 + 8 * hi; const bf16_t* b1p = b0p + 32 * 2048;
        f32x16 acc0, acc1;
#pragma unroll
        for (int r = 0; r < 16; ++r) { acc0[r] = 0.f; acc1[r] = 0.f; }
        bf16x8 af[4], bf0[4], bf1[4];
#pragma unroll
        for (int j = 0; j < 4; ++j) { af[j] = *(const bf16x8*)(ap + 16 * j); bf0[j] = *(const bf16x8*)(b0p + 16 * j); bf1[j] = *(const bf16x8*)(b1p + 16 * j); }
        for (int ll = 0; ll < 32; ++ll) {
            bf16x8 an[4], bn0[4], bn1[4]; const int ln = ll < 31 ? ll + 1 : 31;
#pragma unroll
            for (int j = 0; j < 4; ++j) { an[j] = *(const bf16x8*)(ap + (size_t)ln * LDP + 16 * j); bn0[j] = *(const bf16x8*)(b0p + 64 * ln + 16 * j); bn1[j] = *(const bf16x8*)(b1p + 64 * ln + 16 * j); }
#pragma unroll
            for (int j = 0; j < 4; ++j) { acc0 = __builtin_amdgcn_mfma_f32_32x32x16_bf16(af[j], bf0[j], acc0, 0, 0, 0); acc1 = __builtin_amdgcn_mfma_f32_32x32x16_bf16(af[j], bf1[j], acc1, 0, 0, 0); }
#pragma unroll
            for (int j = 0; j < 4; ++j) { af[j] = an[j]; bf0[j] = bn0[j]; bf1[j] = bn1[j]; }
        }
        const float bs0 = bias1[kv * 256 + 64 * nb + r32], bs1 = bias1[kv * 256 + 64 * nb + 32 + r32];
        LAS bf16_t* hid = (LAS bf16_t*)(lds + C_HID);
#pragma unroll
        for (int r = 0; r < 16; ++r) { const int row = 32 * mb + crow(r, hi);
            hid[row * 264 + 64 * nb + r32] = (bf16_t)f2bf(gelu_tanh(acc0[r] + bs0)); hid[row * 264 + 64 * nb + 32 + r32] = (bf16_t)f2bf(gelu_tanh(acc1[r] + bs1)); }
    }
    __syncthreads();
    if (wid < 4) {
        const int mb = wid & 1, db = wid >> 1;
        f32x16 acc;
#pragma unroll
        for (int r = 0; r < 16; ++r) acc[r] = 0.f;
        const bf16_t* bp = w2t + (size_t)kv * 64 * 256 + (size_t)(32 * db + r32) * 256 + 8 * hi;
#pragma unroll
        for (int s = 0; s < 16; ++s) { const bf16x8 af = *(const LAS bf16x8*)(lds + C_HID + (32 * mb + r32) * 528 + 32 * s + 16 * hi); const bf16x8 bfr = *(const bf16x8*)(bp + 16 * s);
            acc = __builtin_amdgcn_mfma_f32_32x32x16_bf16(af, bfr, acc, 0, 0, 0); }
        const bool rope = (kv == 0) && (db == 0);
        const float inv = powf(500000.0f, -(float)(2 * (r32 & 7)) / 16.0f);
#pragma unroll
        for (int r = 0; r < 16; ++r) { const int cidx = 64 * chalf + 32 * mb + crow(r, hi); float v = acc[r];
            if (rope) { const float vp = __shfl_xor(v, 8); const int cc = cidx < 126 ? cidx : 126; const float ang = (float)a.pos[b * SEQ + 16 * cc + 31] * inv; float sn, cs; sincosf(ang, &sn, &cs);
                if (r32 < 8) v = v * cs - vp * sn; else if (r32 < 16) v = v * cs + vp * sn; }
            kcvc[((((size_t)kv * NB + b) * 128 + cidx) * 2 + g) * 64 + 32 * db + r32] = (cidx < 127) ? (bf16_t)f2bf(v) : (bf16_t)0; }
    }
    __syncthreads();
}
__device__ __forceinline__ void rope_unit(const Ctx& C, const Args& a, int u, bf16_t* proj) {
    for (int i = C.tid; i < 256 * 12; i += NTHR) { const int tok = 256 * u + i / 12, j = i % 12; const int col = j < 8 ? P_NQ + j * 64 : (j < 10 ? P_KS + (j - 8) * 64 : P_KW + (j - 10) * 64);
        rope_rotate(proj + (size_t)tok * LDP + col, a.pos[tok]); }
}
}

#ifndef OPT_FOX
#define OPT_FOX 1
#endif
#ifndef OPT_SB
#define OPT_SB 1
#endif
#ifndef OPT_GLA
#define OPT_GLA 1
#endif
#ifndef OPT_NSA
#define OPT_NSA 1
#endif
#ifndef OPT_PREP
#define OPT_PREP 1
#endif
#ifndef FOX_ABL
#define FOX_ABL 0
#endif
constexpr int CW_Q = 8192;
#define QLOOP(cntptr, total, ...) do { LAS unsigned* qs_ = (LAS unsigned*)(lds + MISC_OFF + 64); unsigned nxt_ = 0u; \
    if (C.tid == 0) nxt_ = atomicAdd((cntptr), 1u); \
    for (;;) { if (C.tid == 0) *qs_ = nxt_; __syncthreads(); const unsigned u = *qs_; if (u >= (unsigned)(total)) break; \
        if (C.tid == 0) nxt_ = atomicAdd((cntptr), 1u); { __VA_ARGS__; } __syncthreads(); } __syncthreads(); } while (0)

template <bool ROPE, int SUB>
__device__ __forceinline__ void phase_C(LAS unsigned char* lds, int wave_s, const Args& a, int l, unsigned* ctl, bf16_t* proj, bf16_t* ys, bf16_t* gqp, float* gdec, float* gds, float* goi) {
    unsigned* qc = ctl + CW_Q + (l * 16) * 64;
    if (SUB & 1)
    { const Ctx C = make_ctx(lds, wave_s); const bf16_t* w1t = (const bf16_t*)(a.ws + WS_CW1); const bf16_t* w2t = (const bf16_t*)(a.ws + WS_KC + 512 * 1024); const float* bias1 = (const float*)(a.ws + WS_KC + 576 * 1024); bf16_t* kcvc = (bf16_t*)(a.ws + WS_KC);
      QLOOP(qc + 0 * 64, 64, { const int chalf = u & 1, g = (u >> 1) & 1, b = (u >> 2) & 7, kv = (int)(u >> 5); cmpx::cmp_unit(C, a, kv, b, g, chalf, proj, w1t, w2t, bias1, kcvc); }); }
    if (SUB & 2)
    { const Ctx C = make_ctx(lds, wave_s); QLOOP(qc + 1 * 64, 64, { att::foxprep_unit(C, (int)(u >> 3), (int)(u & 7), proj, a.fox_b_f[l * 8 + (u & 7)], (float*)(a.ws + WS_CUM), (float*)(a.ws + WS_CUM + 524288)); }); }
    if (SUB & 4)
    { const Ctx C = make_ctx(lds, wave_s); QLOOP(qc + 2 * 64, 1024, { const int c = u & 31, bh = u >> 5; gla::prep_unit(C, a, l, bh >> 2, bh & 3, c, proj, gqp, gdec, gds, goi); }); }
    if (SUB & 8)
    { const Ctx C = make_ctx(lds, wave_s); QLOOP(qc + 3 * 64, 512, { const int qb = 7 - (int)(u >> 6), bh = u & 63; att::sb_unit(C, bh >> 3, bh & 7, qb, proj, ys); }); }
    if (ROPE) { const Ctx C = make_ctx(lds, wave_s); QLOOP(qc + 4 * 64, 64, { cmpx::rope_unit(C, a, (int)u, proj); }); }
}
template <int SUB>
__device__ __forceinline__ void phase_D(LAS unsigned char* lds, int wave_s, const Args& a, int l, unsigned* ctl, bf16_t* proj, bf16_t* ys, const bf16_t* kcvc, bf16_t* gqp, float* gdec, float* gds, float* goi) {
    unsigned* qc = ctl + CW_Q + (l * 16 + 8) * 64;
    if (SUB & 16)
    { const Ctx C = make_ctx(lds, wave_s); QLOOP(qc + 0 * 64, 256, { gla::scan_unit(C, (int)(u >> 5), (int)((u >> 3) & 3), (int)(u & 7), gdec, gds, (bf16_t*)(a.ws + WS_HB)); }); }
    if (SUB & 32)
    { const Ctx C = make_ctx(lds, wave_s); QLOOP(qc + 1 * 64, 512, { const int qt = 31 - (int)(u >> 4), bg = u & 15; nsa::nsa_unit(C, bg >> 1, bg & 1, qt, proj, kcvc, ys); }); }
    if (SUB & 64)
    { const Ctx C = make_ctx(lds, wave_s); QLOOP(qc + 2 * 64, 512, { const int qb = 7 - (int)(u >> 6), bh = u & 63; att::fox_unit<0>(C, bh >> 3, bh & 7, qb, proj, (const float*)(a.ws + WS_CUM), (const float*)(a.ws + WS_CUM + 524288), ys); }); }
}
__device__ __forceinline__ void phase_E(LAS unsigned char* lds, int wave_s, const Args& a, int l, bf16_t* proj, bf16_t* ys, const bf16_t* gqp, const float* goi) {
    const Ctx C = make_ctx(lds, wave_s);
    for (int u = C.bid; u < 256; u += C.G) gla::out_unit(C, a, l, u >> 5, (u >> 3) & 3, u & 7, proj, gqp, (const bf16_t*)(a.ws + WS_HB), goi, ys);
}

__device__ __forceinline__ const Args* args_reload() {
#if defined(__HIP_DEVICE_COMPILE__)
    auto p_ = __builtin_amdgcn_kernarg_segment_ptr(); asm volatile("" : "+s"(p_)); return (const Args*)p_;
#else
    return nullptr;
#endif
}
#define ARGS_RELOAD() args_reload()
__global__ void __launch_bounds__(NTHR, 2) hybrid_fwd(Args a0) {
    extern __shared__ __attribute__((aligned(16))) unsigned char lds_raw[];
    LAS unsigned char* lds = (LAS unsigned char*)lds_raw;
    volatile LAS unsigned* MISC = (volatile LAS unsigned*)(lds + MISC_OFF);
    const int wave_s = __builtin_amdgcn_readfirstlane((int)threadIdx.x >> 6);
    if (threadIdx.x < 64) MISC[threadIdx.x] = 0u;
    __syncthreads();
#if MK_ONE_LAUNCH
    XcdBarrier bar = xcd_barrier_post((unsigned*)(a0.ws + WS_CTL) + CW_BAR, MISC + 8);
#define GRID_BAR() xcd_barrier(bar, wave_s == 0 && lane_id() == 0)
#else
#define GRID_BAR() do {} while (0)
#endif
#ifndef PH_MASK
#define PH_MASK 0xFFFF
#endif
    const int l_lo = a0.l_lo, l_hi = a0.l_hi, p_lo = a0.p_lo, p_hi = a0.p_hi, do_final = a0.do_final;
#define IN(k) (((PH_MASK >> (k)) & 1) && p_lo <= (k) && (k) < p_hi)
#define WSP(T, off) ((T*)(a.ws + (off)))
#ifndef REP_MASK
#define REP_MASK 0
#endif
#define REP(k) ((REP_MASK >> (k)) & 1)
#define PH0() do { const Args a = *ARGS_RELOAD(); unsigned char* ws = a.ws; const Ctx C = make_ctx(lds, wave_s); int base = 0; \
            transpose_matrix<true>(C, a.w_in + (size_t)l * DM * DIN, DM, DIN, LDP, WSP(bf16_t, WS_WIN), base); \
            for (int z = 0; z < 4; ++z) transpose_matrix<false>(C, a.w_branch + ((size_t)l * 4 + z) * 512 * DM, 512, DM, DM, WSP(bf16_t, WS_WB) + (size_t)z * DM * 512, base); \
            transpose_matrix<false>(C, a.w_out + (size_t)l * DM * DM, DM, DM, DM, WSP(bf16_t, WS_WO), base); \
            transpose_matrix<false>(C, a.w_ff1 + (size_t)l * DM * DFF, DM, DFF, DFF, WSP(bf16_t, WS_WF1), base); \
            transpose_matrix<false>(C, a.w_ff2 + (size_t)l * DFF * DM, DFF, DM, DM, WSP(bf16_t, WS_WF2), base); \
            transpose_matrix<false>(C, a.cmp_wk1 + (size_t)l * 2048 * 256, 2048, 256, 256, (bf16_t*)(ws + WS_CW1), base); \
            transpose_matrix<false>(C, a.cmp_wv1 + (size_t)l * 2048 * 256, 2048, 256, 256, (bf16_t*)(ws + WS_CW1) + 256 * 2048, base); \
            transpose_matrix<false>(C, a.cmp_wk2 + (size_t)l * 256 * 64, 256, 64, 64, (bf16_t*)(ws + WS_KC + 512 * 1024), base); \
            transpose_matrix<false>(C, a.cmp_wv2 + (size_t)l * 256 * 64, 256, 64, 64, (bf16_t*)(ws + WS_KC + 512 * 1024) + 64 * 256, base); \
            for (int o = C.gw; o < 512; o += C.NGW) { const int kv = o >> 8, n = o & 255; const float* w1 = (kv ? a.cmp_wv1 : a.cmp_wk1) + (size_t)l * 2048 * 256; const float* pe = (kv ? a.cmp_pos_v : a.cmp_pos_k) + (size_t)l * 2048; \
                float s = 0.f; for (int k = C.lane; k < 2048; k += 64) s += pe[k] * w1[(size_t)k * 256 + n]; s = wave_sum(s); if (C.lane == 0) ((float*)(ws + WS_KC + 576 * 1024))[o] = s; } \
            if (l == 0) xg_rows_phase(C, a.x, a.norm_mix, WSP(bf16_t, WS_HB), WSP(float, WS_CH + 2 * MiB)); \
            else for (int m = C.bid * NTHR + C.tid; m < M; m += C.G * NTHR) { const f32x4* p = (const f32x4*)(WSP(float, WS_CH) + (size_t)m * 16); float t = 0.f; \
                     _Pragma("unroll") for (int q = 0; q < 4; ++q) { const f32x4 v = p[q]; t += (v[0] + v[1]) + (v[2] + v[3]); } WSP(float, WS_CH + 2 * MiB)[m] = rsqrtf(t * (1.0f / DM) + EPS); } \
            GRID_BAR(); } while (0)
#define PH1() do { const Args a = *ARGS_RELOAD(); \
            pg8::Gemm g{WSP(bf16_t, WS_HB), WSP(bf16_t, WS_WIN), DM, DM, DM, 0, 0}; pg8::StaticOrder S; S.init(M, LDP, gridDim.x, blockIdx.x); \
            pg8::EpiBf16<0> E{WSP(bf16_t, WS_PROJ), LDP, WSP(float, WS_CH + 2 * MiB)}; pg8::gemm_phase(lds, g, S, E, wave_s); GRID_BAR(); } while (0)
#ifndef REP_SUB
#define REP_SUB 0xF
#endif
#ifndef FOX_ABL
#define FOX_ABL 0
#endif
#define PH1N() do { const Args a = *ARGS_RELOAD(); \
            pg8::Gemm g{WSP(bf16_t, WS_HB), WSP(bf16_t, WS_WIN), DM, DM, DM, 0, 0}; pg8::StaticOrder S; S.init(M, LDP, gridDim.x, blockIdx.x); \
            pg8::EpiNull E{}; pg8::gemm_phase(lds, g, S, E, wave_s); GRID_BAR(); } while (0)
#define PH2(QOFF, ROPE) do { const Args a = *ARGS_RELOAD(); phase_C<ROPE, (ROPE) ? 0xF : (REP_SUB)>(lds, wave_s, a, l, WSP(unsigned, WS_CTL) + (QOFF), WSP(bf16_t, WS_PROJ), WSP(bf16_t, WS_YS), WSP(bf16_t, WS_GQP), WSP(float, WS_GKP), WSP(float, WS_GDS), WSP(float, WS_GOI)); GRID_BAR(); } while (0)
#define PH3(QOFF) do { const Args a = *ARGS_RELOAD(); phase_D<((QOFF) != 0) ? (REP_SUB) : 0x70>(lds, wave_s, a, l, WSP(unsigned, WS_CTL) + (QOFF), WSP(bf16_t, WS_PROJ), WSP(bf16_t, WS_YS), WSP(bf16_t, WS_KC), WSP(bf16_t, WS_GQP), WSP(float, WS_GKP), WSP(float, WS_GDS), WSP(float, WS_GOI)); GRID_BAR(); } while (0)
#define PH4() do { const Args a = *ARGS_RELOAD(); phase_E(lds, wave_s, a, l, WSP(bf16_t, WS_PROJ), WSP(bf16_t, WS_YS), WSP(bf16_t, WS_GQP), WSP(float, WS_GOI)); GRID_BAR(); } while (0)
#define PH5() do { const Args a = *ARGS_RELOAD(); \
            pg8::Gemm g{WSP(bf16_t, WS_YS), WSP(bf16_t, WS_WB), 512, 512, 512, (size_t)M * 512, (size_t)DM * 512}; pg8::ZOrder S; S.init(M, 2 * DM, gridDim.x, blockIdx.x); S.NZ = 4; \
            pg8::EpiGate E{WSP(bf16_t, WS_PROJ), a.b_gate + (size_t)l * 4 * DM, WSP(bf16_t, WS_MIX)}; pg8::gemm_phase(lds, g, S, E, wave_s); GRID_BAR(); } while (0)
#define PH6(DUMMY) do { const Args a = *ARGS_RELOAD(); \
            pg8::Gemm g{WSP(bf16_t, WS_MIX), WSP(bf16_t, WS_WO), DM, DM, DM, 0, 0}; pg8::StaticOrder S; S.init(M, DM, gridDim.x, blockIdx.x); \
            pg8::EpiRes E{(l == 0) ? a.x : a.out, (DUMMY) ? WSP(float, WS_MIXF) : a.out, DM, a.norm_ff + l * DM, WSP(bf16_t, WS_HB), WSP(float, WS_CH + 1 * MiB)}; pg8::gemm_phase(lds, g, S, E, wave_s); GRID_BAR(); } while (0)
#define PH8() do { const Args a = *ARGS_RELOAD(); \
            pg8::Gemm g{WSP(bf16_t, WS_HB), WSP(bf16_t, WS_WF1), DM, DM, DM, 0, 0}; pg8::StaticOrder S; S.init(M, DFF, gridDim.x, blockIdx.x); \
            pg8::EpiBf16<1> E{WSP(bf16_t, WS_HID), DFF, WSP(float, WS_CH + 1 * MiB)}; pg8::gemm_phase(lds, g, S, E, wave_s); GRID_BAR(); } while (0)
#define PH9(DUMMY) do { const Args a = *ARGS_RELOAD(); \
            pg8::Gemm g{WSP(bf16_t, WS_HID), WSP(bf16_t, WS_WF2), DFF, DFF, DFF, 0, 0}; pg8::StaticOrder S; S.init(M, DM, gridDim.x, blockIdx.x); \
            pg8::EpiRes E{a.out, (DUMMY) ? WSP(float, WS_MIXF) : a.out, DM, a.norm_mix + (l + 1 < NL ? l + 1 : l) * DM, WSP(bf16_t, WS_HB), WSP(float, WS_CH)}; pg8::gemm_phase(lds, g, S, E, wave_s); GRID_BAR(); } while (0)
    for (int l = l_lo; l < l_hi; ++l) {
        if (IN(0)) { PH0(); if (REP(0)) PH0(); }
        if (IN(1)) { PH1(); if (REP(1)) PH1(); if (REP(11)) PH1N(); }
        if (IN(2)) { if (REP(2)) PH2(64 * 1024, false); PH2(0, true); }
        if (IN(3)) { if (REP(3)) PH3(64 * 1024); PH3(0); }
        if (IN(4)) { PH4(); if (REP(4)) PH4(); }
        if (IN(5)) { PH5(); if (REP(5)) PH5(); }
        if (IN(6)) { if (REP(6)) PH6(true); PH6(false); }
        if (IN(8)) { PH8(); if (REP(8)) PH8(); }
        if (IN(9)) { if (REP(9)) PH9(true); PH9(false); }
    }
    if (do_final) { const Args a = *ARGS_RELOAD(); const Ctx C = make_ctx(lds, wave_s); final_norm_phase(C, a.out, a.norm_final); }
#undef IN
#undef WSP
}

#define NAIVE_CTX() extern __shared__ __attribute__((aligned(16))) unsigned char lds_raw[]; Ctx C; C.lds = (LAS unsigned char*)lds_raw; C.tid = threadIdx.x; C.lane = C.tid & 63; \
    C.wave = __builtin_amdgcn_readfirstlane(C.tid >> 6); C.G = gridDim.x; C.bid = blockIdx.x; C.gw = C.bid * NWAVES + C.wave; C.NGW = C.G * NWAVES; unsigned char* ws = a.ws; \
    bf16_t* ys = (bf16_t*)(ws + WS_YS); bf16_t* proj = (bf16_t*)(ws + WS_PROJ); float* cum = (float*)(ws + WS_CUM); float* ch = (float*)(ws + WS_CH); bf16_t* kcvc = (bf16_t*)(ws + WS_KC); \
    float* gds = (float*)(ws + WS_GDS); float* goi = (float*)(ws + WS_GOI); (void)ys; (void)proj; (void)cum; (void)ch; (void)kcvc; (void)gds; (void)goi;
__global__ void __launch_bounds__(NTHR, 2) k_prepA(Args a) { NAIVE_CTX(); naive_prepA(C, a, a.l_lo, proj, cum, ch); }
__global__ void __launch_bounds__(NTHR, 2) k_prepB(Args a) { NAIVE_CTX(); naive_prepB(C, a, a.l_lo, ch, kcvc); }
__global__ void __launch_bounds__(NTHR, 2) k_gla(Args a) { NAIVE_CTX(); naive_gla(C, a, a.l_lo, proj, goi, ys); }
__global__ void __launch_bounds__(NTHR, 2) k_nsa(Args a) { NAIVE_CTX(); naive_nsa(C, proj, kcvc, (float*)(ws + WS_MIX), ys); }
__global__ void __launch_bounds__(NTHR, 2) k_fox(Args a) { NAIVE_CTX(); naive_fox(C, proj, cum, ys); }
__global__ void __launch_bounds__(NTHR, 2) k_sb(Args a) { NAIVE_CTX(); naive_sb(C, proj, ys); }

extern "C" void kernel_launch(void* const* d_in, const int* in_sizes, int n_in, void* d_out, int out_size, void* d_ws, size_t ws_size, hipStream_t stream) {
    static int grid = 0;
    if (grid == 0) {
        if (n_in != 21 || in_sizes[0] != M * DM || out_size != M * DM || ws_size < WS_END) { fprintf(stderr, "kernel_launch: shape/ws mismatch (n_in %d, ws %zu, need %zu)\n", n_in, ws_size, (size_t)WS_END); grid = -1; return; }
        int dev = 0, cus = 0, per_cu = 0;
        if (hipGetDevice(&dev) != hipSuccess || hipDeviceGetAttribute(&cus, hipDeviceAttributeMultiprocessorCount, dev) != hipSuccess) { grid = -1; return; }
        if (hipFuncSetAttribute((const void*)hybrid_fwd, hipFuncAttributeMaxDynamicSharedMemorySize, LDS_BYTES) != hipSuccess) { grid = -1; return; }
        if (hipOccupancyMaxActiveBlocksPerMultiprocessor(&per_cu, (const void*)hybrid_fwd, NTHR, LDS_BYTES) != hipSuccess || per_cu < 1) { fprintf(stderr, "kernel_launch: occupancy query says %d\n", per_cu); }
        (void)hipGetLastError();
        grid = cus;
    }
    if (grid < 0) return;
    (void)hipMemsetAsync((char*)d_ws + WS_CTL, 0, CTL_BYTES, stream);
    Args a{};
    a.x = (const float*)d_in[0]; a.pos = (const int*)d_in[1]; a.norm_mix = (const float*)d_in[2]; a.w_in = (const float*)d_in[3]; a.b_gate = (const float*)d_in[4];
    a.cmp_pos_k = (const float*)d_in[5]; a.cmp_pos_v = (const float*)d_in[6]; a.cmp_wk1 = (const float*)d_in[7]; a.cmp_wk2 = (const float*)d_in[8]; a.cmp_wv1 = (const float*)d_in[9]; a.cmp_wv2 = (const float*)d_in[10];
    a.gla_w_alpha = (const float*)d_in[11]; a.gla_b_alpha = (const float*)d_in[12]; a.gla_norm = (const float*)d_in[13]; a.fox_b_f = (const float*)d_in[14];
    a.w_branch = (const float*)d_in[15]; a.w_out = (const float*)d_in[16]; a.norm_ff = (const float*)d_in[17]; a.w_ff1 = (const float*)d_in[18]; a.w_ff2 = (const float*)d_in[19]; a.norm_final = (const float*)d_in[20];
    a.out = (float*)d_out; a.ws = (unsigned char*)d_ws; a.pad = 0;
#if MK_ONE_LAUNCH
    a.l_lo = 0; a.l_hi = NL; a.p_lo = 0; a.p_hi = 10; a.do_final = 1;
    hipLaunchKernelGGL(hybrid_fwd, dim3(grid), dim3(NTHR), LDS_BYTES, stream, a);
#else
    for (int l = 0; l < NL; ++l)
        for (int p = 0; p < 10; ++p) { a.l_lo = l; a.l_hi = l + 1; a.p_lo = p; a.p_hi = p + 1; a.do_final = 0;
            if (p == 2 && !OPT_PREP) { hipLaunchKernelGGL(k_prepA, dim3(grid), dim3(NTHR), 0, stream, a); hipLaunchKernelGGL(k_prepB, dim3(grid), dim3(NTHR), 0, stream, a); }
            if (p == 3) {
                if (!OPT_GLA) hipLaunchKernelGGL(k_gla, dim3(32), dim3(NTHR), 8192, stream, a);
                if (!OPT_NSA) hipLaunchKernelGGL(k_nsa, dim3(64), dim3(NTHR), 65536, stream, a);
                if (!OPT_FOX) hipLaunchKernelGGL(k_fox, dim3(grid), dim3(NTHR), 0, stream, a);
                if (!OPT_SB) hipLaunchKernelGGL(k_sb, dim3(grid), dim3(NTHR), 0, stream, a);
            }
            hipLaunchKernelGGL(hybrid_fwd, dim3(grid), dim3(NTHR), LDS_BYTES, stream, a); }
    a.l_lo = 0; a.l_hi = 0; a.p_lo = 0; a.p_hi = 0; a.do_final = 1;
    hipLaunchKernelGGL(hybrid_fwd, dim3(grid), dim3(NTHR), LDS_BYTES, stream, a);
#endif
}
```
